# Optimizing an MI355X kernel written in HIP

```python
import math
import jax, jax.numpy as jnp
from jax import lax
import numpy as np

D_MODEL = 1024
BATCH = 2
SEQ = 8192
DEPTH = 4

GRID_W = 64
CTX_LEN = 256
LRU_WIDTH = 256
LRU_BLOCKS = 4
LRU_BLOCK = LRU_WIDTH // LRU_BLOCKS
CONV_W = 4
RG_C = 8.0
GQA_HEADS = 8
GQA_KV_HEADS = 2
GQA_HEAD_DIM = 64
DIFF_HEADS = 4
DIFF_QK_DIM = 32
DIFF_V_DIM = 64
MIX_WIDTH = LRU_WIDTH + GQA_HEADS * GQA_HEAD_DIM + DIFF_HEADS * DIFF_V_DIM
SPLIT_SIZES = (LRU_WIDTH, LRU_WIDTH, GQA_HEADS * GQA_HEAD_DIM, GQA_KV_HEADS * GQA_HEAD_DIM,
               GQA_KV_HEADS * GQA_HEAD_DIM, DIFF_HEADS * 2 * DIFF_QK_DIM, DIFF_HEADS * 2 * DIFF_QK_DIM,
               DIFF_HEADS * DIFF_V_DIM)
IN_WIDTH = sum(SPLIT_SIZES)
N_EXPERTS = 16
N_GROUPS = 4
EXPERTS_PER_GROUP = N_EXPERTS // N_GROUPS
TOP_K = 2
EXPERT_FF = 512
MOE_BLOCK = 128
Q_BLOCK = 128
ROPE_THETA = 10000.0
EPS = 1e-6
DEEPNORM_ALPHA = (2.0 * DEPTH) ** 0.25
DEEPNORM_BETA = (8.0 * DEPTH) ** -0.25

kernel_name = 'hybrid_diffusion_prefix_trunk'


def layer_norm(x, g, b):
    x32 = x.astype(jnp.float32)
    mu = jnp.mean(x32, axis=-1, keepdims=True)
    var = jnp.mean(jnp.square(x32 - mu), axis=-1, keepdims=True)
    return ((x32 - mu) * lax.rsqrt(var + EPS) * g + b).astype(x.dtype)


def rms_norm(x, g):
    x32 = x.astype(jnp.float32)
    return (x32 * lax.rsqrt(jnp.mean(x32 * x32, axis=-1, keepdims=True) + EPS) * g).astype(x.dtype)


def axial_rope_tables(n_tokens, dim):
    rows = n_tokens // GRID_W
    row = jnp.repeat(jnp.arange(rows, dtype=jnp.float32), GRID_W)
    col = jnp.tile(jnp.arange(GRID_W, dtype=jnp.float32), rows)
    n_freq = dim // 4
    inv = ROPE_THETA ** (-jnp.arange(n_freq, dtype=jnp.float32) / n_freq)
    ang = jnp.concatenate([row[:, None] * inv, col[:, None] * inv], axis=-1)
    return jnp.cos(ang), jnp.sin(ang)


def apply_rope(x, rope):
    cos, sin = rope
    xp = x.reshape(x.shape[:-1] + (x.shape[-1] // 2, 2)).astype(jnp.float32)
    x0, x1 = xp[..., 0], xp[..., 1]
    out = jnp.stack([x0 * cos - x1 * sin, x0 * sin + x1 * cos], axis=-1)
    return out.reshape(x.shape).astype(x.dtype)


def split_heads(z, n_heads, dim):
    b, s, _ = z.shape
    return z.reshape(b, s, n_heads, dim).transpose(0, 2, 1, 3)


def merge_heads(o):
    b, h, s, d = o.shape
    return o.transpose(0, 2, 1, 3).reshape(b, s, h * d)


def centred_dwconv(x, w, b):
    s = x.shape[1]
    left = (CONV_W - 1) // 2
    xp = jnp.pad(x, ((0, 0), (left, CONV_W - 1 - left), (0, 0)))
    y = b
    for k in range(CONV_W):
        y = y + xp[:, k:k + s] * w[k]
    return y


def linear_scan(a, b, h0, reverse):
    if h0 is not None:
        edge = -1 if reverse else 0
        b = b.at[:, edge].add(a[:, edge] * h0)
    def combine(l, r):
        return l[0] * r[0], r[0] * l[1] + r[1]
    _, h = lax.associative_scan(combine, (a, b), axis=1, reverse=reverse)
    return h


def rglru_scan(u, w_a, b_a, w_x, b_x, lam, h0, reverse):
    bsz, s, w = u.shape
    ub = u.reshape(bsz, s, LRU_BLOCKS, LRU_BLOCK)
    r = jax.nn.sigmoid(jnp.einsum('bsnc,ncd->bsnd', ub, w_a).reshape(bsz, s, w) + b_a)
    i = jax.nn.sigmoid(jnp.einsum('bsnc,ncd->bsnd', ub, w_x).reshape(bsz, s, w) + b_x)
    log_a = (-RG_C * r.astype(jnp.float32)) * jax.nn.softplus(-lam.astype(jnp.float32))
    a = jnp.exp(log_a)
    mult = jnp.sqrt(-jnp.expm1(2.0 * log_a))
    return linear_scan(a, mult * (i * u).astype(jnp.float32), h0, reverse)


def gqa_heads(zq, zk, zv, q_g, k_g, rope):
    q = rms_norm(split_heads(zq, GQA_HEADS, GQA_HEAD_DIM), q_g)
    k = rms_norm(split_heads(zk, GQA_KV_HEADS, GQA_HEAD_DIM), k_g)
    v = split_heads(zv, GQA_KV_HEADS, GQA_HEAD_DIM)
    if rope is not None:
        q = apply_rope(q, rope)
        k = apply_rope(k, rope)
    return q, k, v


def gqa_attend(q, k, v):
    bsz, h, sq, dh = q.shape
    kvh = k.shape[1]
    g = h // kvh
    nblk = sq // Q_BLOCK
    qb = jnp.moveaxis(q.reshape(bsz, kvh, g, nblk, Q_BLOCK, dh), 3, 0)
    scale = dh ** -0.5
    def body(qblk):
        s = jnp.einsum('bkgqd,bksd->bkgqs', qblk, k).astype(jnp.float32) * scale
        p = jax.nn.softmax(s, axis=-1).astype(v.dtype)
        return jnp.einsum('bkgqs,bksd->bkgqd', p, v)
    o = lax.map(body, qb)
    return jnp.moveaxis(o, 0, 3).reshape(bsz, h, sq, dh)


def diff_heads(zq, zk, zv, rope):
    bsz, s, _ = zq.shape
    q = zq.reshape(bsz, s, DIFF_HEADS, 2, DIFF_QK_DIM).transpose(0, 2, 3, 1, 4)
    k = zk.reshape(bsz, s, DIFF_HEADS, 2, DIFF_QK_DIM).transpose(0, 2, 3, 1, 4)
    v = split_heads(zv, DIFF_HEADS, DIFF_V_DIM)
    if rope is not None:
        q = apply_rope(q, rope)
        k = apply_rope(k, rope)
    return q, k, v


def diff_attend(q, k, v, lam):
    bsz, h, _, sq, dq = q.shape
    dv = v.shape[-1]
    nblk = sq // Q_BLOCK
    qb = jnp.moveaxis(q.reshape(bsz, h, 2, nblk, Q_BLOCK, dq), 3, 0)
    scale = dq ** -0.5
    def body(qblk):
        s = jnp.einsum('bhmqd,bhmsd->bhmqs', qblk, k).astype(jnp.float32) * scale
        p = jax.nn.softmax(s, axis=-1)
        w = (p[:, :, 0] - lam * p[:, :, 1]).astype(v.dtype)
        return jnp.einsum('bhqs,bhsd->bhqd', w, v)
    o = lax.map(body, qb)
    return jnp.moveaxis(o, 0, 2).reshape(bsz, h, sq, dv)


def token_mixer(h_lat, h_ctx, w_in, conv_w, conv_b, rg_wa, rg_ba, rg_wx, rg_bx, rg_lam,
                q_norm_g, k_norm_g, diff_lambda, diff_subln_g, w_out, rope_g, rope_d, lam_init, need_ctx):
    points = np.cumsum(SPLIT_SIZES)[:-1].tolist()
    ax_l, ag_l, gq_l, gk_l, gv_l, dq_l, dk_l, dv_l = jnp.split(h_lat @ w_in, points, axis=-1)
    ax_c, ag_c, gq_c, gk_c, gv_c, dq_c, dk_c, dv_c = jnp.split(h_ctx @ w_in, points, axis=-1)

    u_l = centred_dwconv(ax_l, conv_w, conv_b)
    u_c = centred_dwconv(ax_c, conv_w, conv_b)
    h_l = jnp.zeros(u_l.shape, jnp.float32)
    h_c = jnp.zeros(u_c.shape, jnp.float32)
    for d, rev in enumerate((False, True)):
        hc = rglru_scan(u_c, rg_wa[d], rg_ba[d], rg_wx[d], rg_bx[d], rg_lam[d], None, rev)
        h0 = hc[:, 0] if rev else hc[:, -1]
        h_l = h_l + rglru_scan(u_l, rg_wa[d], rg_ba[d], rg_wx[d], rg_bx[d], rg_lam[d], h0, rev)
        if need_ctx:
            h_c = h_c + hc
    ya_l = jax.nn.gelu(ag_l) * h_l.astype(ag_l.dtype)

    q_l, k_l, v_l = gqa_heads(gq_l, gk_l, gv_l, q_norm_g, k_norm_g, rope_g)
    q_c, k_c, v_c = gqa_heads(gq_c, gk_c, gv_c, q_norm_g, k_norm_g, None)
    yb_l = merge_heads(gqa_attend(q_l, jnp.concatenate([k_c, k_l], axis=2), jnp.concatenate([v_c, v_l], axis=2)))

    dl = diff_lambda.astype(jnp.float32)
    lam = jnp.exp(jnp.sum(dl[0] * dl[1])) - jnp.exp(jnp.sum(dl[2] * dl[3])) + lam_init
    dq_h, dk_h, dv_h = diff_heads(dq_l, dk_l, dv_l, rope_d)
    cq_h, ck_h, cv_h = diff_heads(dq_c, dk_c, dv_c, None)
    oc_l = diff_attend(dq_h, jnp.concatenate([ck_h, dk_h], axis=3), jnp.concatenate([cv_h, dv_h], axis=2), lam)
    yc_l = merge_heads(rms_norm(oc_l, diff_subln_g) * (1.0 - lam_init))

    out_l = jnp.concatenate([ya_l, yb_l, yc_l], axis=-1) @ w_out
    if not need_ctx:
        return out_l, None
    ya_c = jax.nn.gelu(ag_c) * h_c.astype(ag_c.dtype)
    yb_c = merge_heads(gqa_attend(q_c, k_c, v_c))
    yc_c = merge_heads(rms_norm(diff_attend(cq_h, ck_h, cv_h, lam), diff_subln_g) * (1.0 - lam_init))
    out_c = jnp.concatenate([ya_c, yb_c, yc_c], axis=-1) @ w_out
    return out_l, out_c


def route(h, router_w, router_b):
    t = h.shape[0]
    probs = jax.nn.softmax((h @ router_w).astype(jnp.float32), axis=-1)
    sel = (probs + router_b.astype(jnp.float32)).reshape(t, N_GROUPS, EXPERTS_PER_GROUP)
    grp_score = jnp.sum(lax.top_k(sel, TOP_K)[0], axis=-1)
    g_idx = jnp.argmax(grp_score, axis=-1)
    in_grp = jnp.take_along_axis(sel, g_idx[:, None, None], axis=1)[:, 0]
    _, local = lax.top_k(in_grp, TOP_K)
    experts = g_idx[:, None] * EXPERTS_PER_GROUP + local
    w = jnp.take_along_axis(probs, experts, axis=1)
    return experts, w / jnp.sum(w, axis=-1, keepdims=True)


def moe_ffn(h, router_w, router_b, w_gate, w_up, w_down):
    t, d = h.shape
    experts, gates = route(h, router_w, router_b)
    n_assign = t * TOP_K
    flat_e = experts.reshape(n_assign)
    flat_tok = jnp.repeat(jnp.arange(t, dtype=jnp.int32), TOP_K)
    flat_g = gates.reshape(n_assign)
    order = jnp.argsort(flat_e)
    sorted_e = flat_e[order]
    counts = jnp.bincount(flat_e, length=N_EXPERTS)
    padded = (counts + MOE_BLOCK - 1) // MOE_BLOCK * MOE_BLOCK
    start = jnp.cumsum(counts) - counts
    pend = jnp.cumsum(padded)
    pstart = pend - padded
    dest = pstart[sorted_e] + jnp.arange(n_assign, dtype=jnp.int32) - start[sorted_e]
    n_rows = ((n_assign + MOE_BLOCK - 1) // MOE_BLOCK + N_EXPERTS) * MOE_BLOCK
    n_blk = n_rows // MOE_BLOCK
    row_tok = jnp.zeros((n_rows,), jnp.int32).at[dest].set(flat_tok[order])
    row_gate = jnp.zeros((n_rows,), h.dtype).at[dest].set(flat_g[order].astype(h.dtype))
    blk_expert = jnp.clip(jnp.searchsorted(pend, jnp.arange(n_blk) * MOE_BLOCK, side='right'), 0, N_EXPERTS - 1)
    xs = h[row_tok].reshape(n_blk, MOE_BLOCK, d)
    def expert_block(args):
        xb, e = args
        return (jax.nn.silu(xb @ w_gate[e]) * (xb @ w_up[e])) @ w_down[e]
    ys = lax.map(expert_block, (xs, blk_expert)).reshape(n_rows, d)
    return jnp.zeros_like(h).at[row_tok].add(ys * row_gate[:, None])


def setup_inputs(seed: int = 0) -> dict:
    key = jax.random.key(seed)
    ks = jax.random.split(key, 32)
    f32 = jnp.float32
    D = D_MODEL
    def nrm(k, shape, scale):
        return jax.random.normal(k, shape, f32) * scale
    a0 = jax.random.uniform(ks[14], (DEPTH, 2, LRU_WIDTH), f32, 0.9, 0.999)
    s0 = a0 ** (1.0 / RG_C)
    return {
        'x': nrm(ks[0], (BATCH, SEQ, D), 1.0),
        'c': nrm(ks[1], (BATCH, D), 1.0),
        'ctx': nrm(ks[2], (BATCH, CTX_LEN, D), 1.0),
        'c_ctx': nrm(ks[3], (D,), 1.0),
        'ada_w': nrm(ks[4], (DEPTH, D, 6 * D), D ** -0.5),
        'ada_b': nrm(ks[5], (DEPTH, 6 * D), 0.02),
        'w_in': nrm(ks[6], (DEPTH, D, IN_WIDTH), D ** -0.5),
        'conv_w': nrm(ks[7], (DEPTH, CONV_W, LRU_WIDTH), CONV_W ** -0.5),
        'conv_b': nrm(ks[8], (DEPTH, LRU_WIDTH), 0.02),
        'rg_wa': nrm(ks[9], (DEPTH, 2, LRU_BLOCKS, LRU_BLOCK, LRU_BLOCK), LRU_BLOCK ** -0.5),
        'rg_ba': nrm(ks[10], (DEPTH, 2, LRU_WIDTH), 0.02),
        'rg_wx': nrm(ks[11], (DEPTH, 2, LRU_BLOCKS, LRU_BLOCK, LRU_BLOCK), LRU_BLOCK ** -0.5),
        'rg_bx': nrm(ks[12], (DEPTH, 2, LRU_WIDTH), 0.02),
        'rg_lam': jnp.log(s0) - jnp.log1p(-s0),
        'q_norm_g': 1.0 + nrm(ks[15], (DEPTH, GQA_HEAD_DIM), 0.02),
        'k_norm_g': 1.0 + nrm(ks[16], (DEPTH, GQA_HEAD_DIM), 0.02),
        'diff_lambda': nrm(ks[17], (DEPTH, 4, DIFF_QK_DIM), 0.1),
        'diff_subln_g': 1.0 + nrm(ks[18], (DEPTH, DIFF_V_DIM), 0.02),
        'w_out': nrm(ks[19], (DEPTH, MIX_WIDTH, D), MIX_WIDTH ** -0.5 * DEEPNORM_BETA),
        'ln1_g': 1.0 + nrm(ks[20], (DEPTH, D), 0.02),
        'ln1_b': nrm(ks[21], (DEPTH, D), 0.02),
        'ln2_g': 1.0 + nrm(ks[22], (DEPTH, D), 0.02),
        'ln2_b': nrm(ks[23], (DEPTH, D), 0.02),
        'router_w': nrm(ks[24], (D, N_EXPERTS), D ** -0.5),
        'router_b': nrm(ks[25], (N_EXPERTS,), 0.01),
        'exp_w_gate': nrm(ks[26], (DEPTH, N_EXPERTS, D, EXPERT_FF), D ** -0.5),
        'exp_w_up': nrm(ks[27], (DEPTH, N_EXPERTS, D, EXPERT_FF), D ** -0.5),
        'exp_w_down': nrm(ks[28], (DEPTH, N_EXPERTS, EXPERT_FF, D), EXPERT_FF ** -0.5 * DEEPNORM_BETA),
    }


def reference(x, c, ctx, c_ctx, ada_w, ada_b, w_in, conv_w, conv_b, rg_wa, rg_ba, rg_wx, rg_bx, rg_lam,
              q_norm_g, k_norm_g, diff_lambda, diff_subln_g, w_out, ln1_g, ln1_b, ln2_g, ln2_b,
              router_w, router_b, exp_w_gate, exp_w_up, exp_w_down):
    bsz, s, d = x.shape
    rope_g = axial_rope_tables(s, GQA_HEAD_DIM)
    rope_d = axial_rope_tables(s, DIFF_QK_DIM)
    silu_c = jax.nn.silu(c)
    silu_cc = jax.nn.silu(c_ctx)
    for li in range(DEPTH):
        need_ctx = li < DEPTH - 1
        lam_init = 0.8 - 0.6 * math.exp(-0.3 * li)
        mod_l = (silu_c @ ada_w[li] + ada_b[li])[:, None, :]
        mod_c = silu_cc @ ada_w[li] + ada_b[li]
        sh1, sc1, g1, sh2, sc2, g2 = jnp.split(mod_l, 6, axis=-1)
        csh1, csc1, cg1, csh2, csc2, cg2 = jnp.split(mod_c, 6, axis=-1)

        y_l, y_c = token_mixer(x * (1.0 + sc1) + sh1, ctx * (1.0 + csc1) + csh1, w_in[li], conv_w[li], conv_b[li],
                               rg_wa[li], rg_ba[li], rg_wx[li], rg_bx[li], rg_lam[li], q_norm_g[li], k_norm_g[li],
                               diff_lambda[li], diff_subln_g[li], w_out[li], rope_g, rope_d, lam_init, need_ctx)
        x = layer_norm(DEEPNORM_ALPHA * x + g1 * y_l, ln1_g[li], ln1_b[li])
        h_l = x * (1.0 + sc2) + sh2
        if need_ctx:
            ctx = layer_norm(DEEPNORM_ALPHA * ctx + cg1 * y_c, ln1_g[li], ln1_b[li])
            h_c = ctx * (1.0 + csc2) + csh2
            n_lat = bsz * s
            f = moe_ffn(jnp.concatenate([h_l.reshape(n_lat, d), h_c.reshape(-1, d)], axis=0), router_w, router_b,
                        exp_w_gate[li], exp_w_up[li], exp_w_down[li])
            f_l = f[:n_lat].reshape(bsz, s, d)
            ctx = layer_norm(DEEPNORM_ALPHA * ctx + cg2 * f[n_lat:].reshape(ctx.shape), ln2_g[li], ln2_b[li])
        else:
            f_l = moe_ffn(h_l.reshape(bsz * s, d), router_w, router_b, exp_w_gate[li], exp_w_up[li],
                          exp_w_down[li]).reshape(bsz, s, d)
        x = layer_norm(DEEPNORM_ALPHA * x + g2 * f_l, ln2_g[li], ln2_b[li])
    return x
```

```cpp
#include <hip/hip_runtime.h>
#include <cstdio>
#include <stdint.h>
#include <math.h>
#include <string.h>

#ifdef CPU_TEST
#define HD inline
#define UNROLL
#else
#define HD __host__ __device__ __forceinline__
#define UNROLL _Pragma("unroll")
#endif

#ifndef D_MODEL
#define D_MODEL 1024
#define BATCH 2
#define SEQ 8192
#define DEPTH 4
#define GRID_W 64
#define CTX_LEN 256
#define LRU_W 256
#define GQA_H 8
#define GQA_KV 2
#define DIFF_H 4
#define EXP_FF 512
#endif
#define LRU_BLK (LRU_W / 4)
#define N_EXP 16
#define OFF_AX 0
#define OFF_AG (LRU_W)
#define OFF_GQ (2 * LRU_W)
#define OFF_GK (OFF_GQ + GQA_H * 64)
#define OFF_GV (OFF_GK + GQA_KV * 64)
#define OFF_DQ (OFF_GV + GQA_KV * 64)
#define OFF_DK (OFF_DQ + DIFF_H * 64)
#define OFF_DV (OFF_DK + DIFF_H * 64)
#define IN_W (OFF_DV + DIFF_H * 64)
#define MIX_W (LRU_W + GQA_H * 64 + DIFF_H * 64)
#define NLAT (BATCH * SEQ)
#define NCTX (BATCH * CTX_LEN)
#define NROW (NLAT + NCTX)
#define SKEY (CTX_LEN + SEQ)
#define NVH (GQA_H + 2 * DIFF_H)
#define NKH (GQA_KV + 2 * DIFF_H)
#define NVV (GQA_KV + DIFF_H)
#define QP (NVH * 64)
#define KP (NKH * 64)
#define VP (NVV * 64)
#define ODP (2 * DIFF_H * 64)
#define GUB (EXP_FF < 128 ? EXP_FF : 128)
#define MOE_TM 256
#define MOE_ROWS (2 * NROW + N_EXP * MOE_TM)
#define DN_ALPHA 1.681792830507429f
#define LOG2E 1.4426950408889634f
#define QS_G (0.125f * LOG2E)
#define QS_D (0.17677669529663687f * LOG2E)

#ifdef EXACT_TEST
typedef float bf16_t;
HD float bf2f(bf16_t h) { return h; }
HD bf16_t f2bf(float f) { return f; }
#else
typedef unsigned short bf16_t;
HD float bf2f(bf16_t h) { unsigned u = ((unsigned)h) << 16; float f; memcpy(&f, &u, 4); return f; }
HD bf16_t f2bf(float f) { unsigned u; memcpy(&u, &f, 4); return (bf16_t)((u + 0x7fffu + ((u >> 16) & 1u)) >> 16); }
#endif

struct P {
    const float *x, *c, *ctx, *c_ctx, *ada_w, *ada_b, *w_in, *conv_w, *conv_b, *rg_wa, *rg_ba, *rg_wx, *rg_bx, *rg_lam,
        *q_norm_g, *k_norm_g, *diff_lambda, *diff_subln_g, *w_out, *ln1_g, *ln1_b, *ln2_g, *ln2_b, *router_w, *router_b,
        *exp_w_gate, *exp_w_up, *exp_w_down;
    float* out;
    unsigned* ctl;
    int* cnt;
    float* MOD;
    bf16_t* WB[2];
    float* XR;
    bf16_t* H;
    float* Z;
    float *LA, *LB, *HS;
    float* YO;
    bf16_t* FO;
    bf16_t *ZQ, *ZK, *ZV;
    float *AX, *GA;
    bf16_t* Y;
    bf16_t* OD;
    float* TG;
    int* SLOTTOK;
    bf16_t* HM;
    int pad_[2];
};
#define WB_WIN(wb) (wb)
#define WB_WOUT(wb) ((wb) + (size_t)IN_W * D_MODEL)
#define WB_WGU(wb) (WB_WOUT(wb) + (size_t)D_MODEL * MIX_W)
#define WB_WD(wb) (WB_WGU(wb) + (size_t)N_EXP * 2 * EXP_FF * D_MODEL)
#define WB_ELEMS ((size_t)IN_W * D_MODEL + (size_t)D_MODEL * MIX_W + (size_t)N_EXP * 3 * EXP_FF * D_MODEL)

HD float sigmoidf_(float x) { return 1.f / (1.f + expf(-x)); }
HD float siluf_(float x) { return x / (1.f + expf(-x)); }
HD float gelu_tanhf_(float x) { return 0.5f * x * (1.f + tanhf(0.7978845608028654f * (x + 0.044715f * x * x * x))); }
HD float softplusf_(float x) { return x > 20.f ? x : log1pf(expf(x)); }

HD int row_who(int r) { return r < NLAT ? r / SEQ : BATCH; }
HD int row_kidx(int r) { if (r < NLAT) { int b = r / SEQ, t = r % SEQ; return b * SKEY + CTX_LEN + t; } int q = r - NLAT; int b = q / CTX_LEN, j = q % CTX_LEN; return b * SKEY + j; }
HD int gu_row(int half, int j) { return (j / GUB) * 2 * GUB + half * GUB + (j % GUB); }

HD long n_cvt() { return (long)WB_ELEMS; }
HD void st_cvt(const P& p, int l, long gid) {
    bf16_t* wb = p.WB[l & 1];
    size_t i = (size_t)gid;
    const size_t n_in = (size_t)IN_W * D_MODEL, n_out = (size_t)D_MODEL * MIX_W, n_gu = (size_t)N_EXP * 2 * EXP_FF * D_MODEL;
    if (i < n_in) { int n = (int)(i / D_MODEL), k = (int)(i % D_MODEL); wb[i] = f2bf(p.w_in[((size_t)l * D_MODEL + k) * IN_W + n]); return; }
    i -= n_in;
    if (i < n_out) { int n = (int)(i / MIX_W), k = (int)(i % MIX_W); WB_WOUT(wb)[i] = f2bf(p.w_out[((size_t)l * MIX_W + k) * D_MODEL + n]); return; }
    i -= n_out;
    if (i < n_gu) {
        int e = (int)(i / ((size_t)2 * EXP_FF * D_MODEL)); size_t q = i % ((size_t)2 * EXP_FF * D_MODEL); int r = (int)(q / D_MODEL), k = (int)(q % D_MODEL);
        int t = r / (2 * GUB), w = r % (2 * GUB), half = w / GUB, cc = w % GUB, j = t * GUB + cc;
        const float* src = half ? p.exp_w_up : p.exp_w_gate;
        WB_WGU(wb)[i] = f2bf(src[(((size_t)l * N_EXP + e) * D_MODEL + k) * EXP_FF + j]); return; }
    i -= n_gu;
    { int e = (int)(i / ((size_t)D_MODEL * EXP_FF)); size_t q = i % ((size_t)D_MODEL * EXP_FF); int n = (int)(q / EXP_FF), k = (int)(q % EXP_FF);
      WB_WD(wb)[i] = f2bf(p.exp_w_down[(((size_t)l * N_EXP + e) * EXP_FF + k) * D_MODEL + n]); }
}

HD long n_ada() { return (long)DEPTH * 6 * D_MODEL; }
HD void st_ada(const P& p, long gid) {
    int l = (int)(gid / (6 * D_MODEL)), col = (int)(gid % (6 * D_MODEL));
    float acc[BATCH + 1]; UNROLL for (int w = 0; w <= BATCH; ++w) acc[w] = 0.f;
    const float* W = p.ada_w + (size_t)l * D_MODEL * 6 * D_MODEL + col;
    for (int k = 0; k < D_MODEL; ++k) { float wv = W[(size_t)k * 6 * D_MODEL];
        for (int b = 0; b < BATCH; ++b) acc[b] += siluf_(p.c[b * D_MODEL + k]) * wv;
        acc[BATCH] += siluf_(p.c_ctx[k]) * wv; }
    float bias = p.ada_b[l * 6 * D_MODEL + col];
    UNROLL for (int w = 0; w <= BATCH; ++w) p.MOD[((size_t)l * 3 + w) * 6 * D_MODEL + col] = acc[w] + bias;
}
HD const float* modp(const P& p, int l, int who, int chunk) { return p.MOD + ((size_t)l * 3 + who) * 6 * D_MODEL + chunk * D_MODEL; }

HD long n_mod0() { return (long)NROW * D_MODEL; }
HD void st_mod0(const P& p, long gid) {
    int r = (int)(gid / D_MODEL), cc = (int)(gid % D_MODEL); int who = row_who(r);
    float v = r < NLAT ? p.x[(size_t)r * D_MODEL + cc] : p.ctx[(size_t)(r - NLAT) * D_MODEL + cc];
    p.XR[gid] = v;
    p.H[gid] = f2bf(v * (1.f + modp(p, 0, who, 1)[cc]) + modp(p, 0, who, 0)[cc]);
}

HD void dot4x4(const bf16_t* const a[4], const bf16_t* const b[4], int K, float acc[4][4]) {
    UNROLL for (int i = 0; i < 4; ++i) UNROLL for (int j = 0; j < 4; ++j) acc[i][j] = 0.f;
    for (int k = 0; k < K; k += 4) {
        float av[4][4], bv[4][4];
        UNROLL for (int i = 0; i < 4; ++i) UNROLL for (int q = 0; q < 4; ++q) { av[i][q] = bf2f(a[i][k + q]); bv[i][q] = bf2f(b[i][k + q]); }
        UNROLL for (int i = 0; i < 4; ++i) UNROLL for (int j = 0; j < 4; ++j) UNROLL for (int q = 0; q < 4; ++q) acc[i][j] += av[i][q] * bv[j][q];
    }
}
HD long n_gemm_in() { return (long)(NROW / 4) * (IN_W / 4); }
HD void st_gemm_in(const P& p, int l, long gid) {
    int m0 = (int)(gid / (IN_W / 4)) * 4, n0 = (int)(gid % (IN_W / 4)) * 4;
    const bf16_t* wb = WB_WIN(p.WB[l & 1]); const bf16_t *a[4], *b[4];
    UNROLL for (int i = 0; i < 4; ++i) { a[i] = p.H + (size_t)(m0 + i) * D_MODEL; b[i] = wb + (size_t)(n0 + i) * D_MODEL; }
    float acc[4][4]; dot4x4(a, b, D_MODEL, acc);
    UNROLL for (int i = 0; i < 4; ++i) UNROLL for (int j = 0; j < 4; ++j) p.Z[(size_t)(m0 + i) * IN_W + n0 + j] = acc[i][j];
}
HD long n_gemm_out() { return (long)(NROW / 4) * (D_MODEL / 4); }
HD void st_gemm_out(const P& p, int l, long gid) {
    int m0 = (int)(gid / (D_MODEL / 4)) * 4, n0 = (int)(gid % (D_MODEL / 4)) * 4;
    const bf16_t* wb = WB_WOUT(p.WB[l & 1]); const bf16_t *a[4], *b[4];
    UNROLL for (int i = 0; i < 4; ++i) { a[i] = p.Y + (size_t)(m0 + i) * MIX_W; b[i] = wb + (size_t)(n0 + i) * MIX_W; }
    float acc[4][4]; dot4x4(a, b, MIX_W, acc);
    UNROLL for (int i = 0; i < 4; ++i) UNROLL for (int j = 0; j < 4; ++j) p.YO[(size_t)(m0 + i) * D_MODEL + n0 + j] = acc[i][j];
}

HD void rope_cs(int t, int i, int nfreq, float& cs, float& sn) {
    int rowp = t / GRID_W, colp = t % GRID_W;
    float pos = (float)(i < nfreq ? rowp : colp); int j = i % nfreq;
    float inv = exp2f(-(float)j / (float)nfreq * 13.287712379549449f);
    float ang = pos * inv;
#if defined(__HIP_DEVICE_COMPILE__)
    cs = __cosf(ang); sn = __sinf(ang);
#else
    cs = cosf(ang); sn = sinf(ang);
#endif
}
HD long n_post() { return (long)NROW * (IN_W / 64); }
HD void st_post(const P& p, int l, long gid) {
    int r = (int)(gid / (IN_W / 64)), job = (int)(gid % (IN_W / 64)); int c0 = job * 64;
    const float* z = p.Z + (size_t)r * IN_W + c0;
    bool lat = r < NLAT; int t = lat ? r % SEQ : 0; int kidx = row_kidx(r);
    float v[64]; UNROLL for (int d = 0; d < 64; ++d) v[d] = z[d];
    if (c0 < OFF_AG) { UNROLL for (int d = 0; d < 64; ++d) p.AX[(size_t)r * LRU_W + c0 + d] = v[d]; return; }
    if (c0 < OFF_GQ) { UNROLL for (int d = 0; d < 64; ++d) p.GA[(size_t)r * LRU_W + (c0 - OFF_AG) + d] = gelu_tanhf_(v[d]); return; }
    if (c0 < OFF_GV) {
        bool isq = c0 < OFF_GK; int h = isq ? (c0 - OFF_GQ) / 64 : (c0 - OFF_GK) / 64;
        const float* g = (isq ? p.q_norm_g : p.k_norm_g) + l * 64;
        float ss = 0.f; UNROLL for (int d = 0; d < 64; ++d) ss += v[d] * v[d];
        float rs = 1.0f / sqrtf(ss / 64.f + 1e-6f);
        UNROLL for (int d = 0; d < 64; ++d) v[d] = v[d] * rs * g[d];
        if (lat) UNROLL for (int i = 0; i < 32; ++i) { float cs, sn; rope_cs(t, i, 16, cs, sn); float x0 = v[2 * i], x1 = v[2 * i + 1]; v[2 * i] = x0 * cs - x1 * sn; v[2 * i + 1] = x0 * sn + x1 * cs; }
        if (isq) { UNROLL for (int d = 0; d < 64; ++d) p.ZQ[(size_t)r * QP + h * 64 + d] = f2bf(v[d] * QS_G); }
        else { UNROLL for (int d = 0; d < 64; ++d) p.ZK[(size_t)kidx * KP + h * 64 + d] = f2bf(v[d]); }
        return; }
    if (c0 < OFF_DQ) { int h = (c0 - OFF_GV) / 64; UNROLL for (int d = 0; d < 64; ++d) p.ZV[(size_t)kidx * VP + h * 64 + d] = f2bf(v[d]); return; }
    if (c0 < OFF_DV) {
        bool isq = c0 < OFF_DK; int h = isq ? (c0 - OFF_DQ) / 64 : (c0 - OFF_DK) / 64;
        UNROLL for (int m = 0; m < 2; ++m) {
            float* w = v + m * 32;
            if (lat) UNROLL for (int i = 0; i < 16; ++i) { float cs, sn; rope_cs(t, i, 8, cs, sn); float x0 = w[2 * i], x1 = w[2 * i + 1]; w[2 * i] = x0 * cs - x1 * sn; w[2 * i + 1] = x0 * sn + x1 * cs; }
            if (isq) { bf16_t* o = p.ZQ + (size_t)r * QP + (GQA_H + 2 * h + m) * 64; UNROLL for (int d = 0; d < 32; ++d) { o[d] = f2bf(w[d] * QS_D); o[32 + d] = 0; } }
            else { bf16_t* o = p.ZK + (size_t)kidx * KP + (GQA_KV + 2 * h + m) * 64; UNROLL for (int d = 0; d < 32; ++d) { o[d] = f2bf(w[d]); o[32 + d] = 0; } }
        }
        return; }
    { int h = (c0 - OFF_DV) / 64; UNROLL for (int d = 0; d < 64; ++d) p.ZV[(size_t)kidx * VP + (GQA_KV + h) * 64 + d] = f2bf(v[d]); }
}

HD float conv_u(const P& p, int l, int r, int ch) {
    int base, pos, len;
    if (r < NLAT) { base = (r / SEQ) * SEQ; pos = r % SEQ; len = SEQ; } else { int q = r - NLAT; base = NLAT + (q / CTX_LEN) * CTX_LEN; pos = q % CTX_LEN; len = CTX_LEN; }
    float y = p.conv_b[l * LRU_W + ch];
    UNROLL for (int k = 0; k < 4; ++k) { int pp = pos + k - 1; if (pp >= 0 && pp < len) y += p.AX[(size_t)(base + pp) * LRU_W + ch] * p.conv_w[(l * 4 + k) * LRU_W + ch]; }
    return y;
}
HD long n_lru_ab() { return (long)NROW * 2 * LRU_W; }
HD void st_lru_ab(const P& p, int l, long gid) {
    int r = (int)(gid / (2 * LRU_W)), dir = (int)((gid / LRU_W) % 2), ch = (int)(gid % LRU_W);
    int n = ch / LRU_BLK, d = ch % LRU_BLK;
    const float* wa = p.rg_wa + ((size_t)(l * 2 + dir) * 4 + n) * LRU_BLK * LRU_BLK;
    const float* wx = p.rg_wx + ((size_t)(l * 2 + dir) * 4 + n) * LRU_BLK * LRU_BLK;
    float sa = 0.f, sx = 0.f, uc = 0.f;
    for (int c = 0; c < LRU_BLK; ++c) { float u = conv_u(p, l, r, n * LRU_BLK + c); if (c == d) uc = u; sa += u * wa[c * LRU_BLK + d]; sx += u * wx[c * LRU_BLK + d]; }
    float rg = sigmoidf_(sa + p.rg_ba[(l * 2 + dir) * LRU_W + ch]), ig = sigmoidf_(sx + p.rg_bx[(l * 2 + dir) * LRU_W + ch]);
    float log_a = -8.0f * rg * softplusf_(-p.rg_lam[(l * 2 + dir) * LRU_W + ch]);
    float a = expf(log_a), mult = sqrtf(-expm1f(2.f * log_a));
    p.LA[gid] = a; p.LB[gid] = mult * (ig * uc);
}
HD long n_lru_scan() { return (long)BATCH * 2 * LRU_W; }
HD void st_lru_scan(const P& p, long gid) {
    int b = (int)(gid / (2 * LRU_W)), dir = (int)((gid / LRU_W) % 2), ch = (int)(gid % LRU_W);
    float h = 0.f;
    for (int s = 0; s < SKEY; ++s) {
        int r;
        if (dir == 0) r = s < CTX_LEN ? NLAT + b * CTX_LEN + s : b * SEQ + (s - CTX_LEN);
        else r = s < CTX_LEN ? NLAT + b * CTX_LEN + (CTX_LEN - 1 - s) : b * SEQ + (SEQ - 1 - (s - CTX_LEN));
        size_t i = ((size_t)r * 2 + dir) * LRU_W + ch;
        h = p.LA[i] * h + p.LB[i]; p.HS[i] = h;
    }
}

HD long n_att() { return (long)NROW * NVH; }
HD void st_att(const P& p, long gid) {
    int vh = (int)(gid / NROW), r = (int)(gid % NROW);
    int b = r < NLAT ? r / SEQ : (r - NLAT) / CTX_LEN; int nk = r < NLAT ? SKEY : CTX_LEN;
    int kh = vh < GQA_H ? vh / (GQA_H / GQA_KV) : GQA_KV + (vh - GQA_H);
    int vv = vh < GQA_H ? vh / (GQA_H / GQA_KV) : GQA_KV + (vh - GQA_H) / 2;
    float q[64], o[64]; UNROLL for (int d = 0; d < 64; ++d) { q[d] = bf2f(p.ZQ[(size_t)r * QP + vh * 64 + d]); o[d] = 0.f; }
    float m = -1e30f, lsum = 0.f;
    const bf16_t* K = p.ZK + (size_t)b * SKEY * KP + kh * 64; const bf16_t* V = p.ZV + (size_t)b * SKEY * VP + vv * 64;
    for (int j = 0; j < nk; ++j) {
        float s = 0.f; UNROLL for (int d = 0; d < 64; ++d) s += q[d] * bf2f(K[(size_t)j * KP + d]);
        if (s > m) { float f = exp2f(m - s); lsum *= f; UNROLL for (int d = 0; d < 64; ++d) o[d] *= f; m = s; }
        float pr = exp2f(s - m); lsum += pr;
        UNROLL for (int d = 0; d < 64; ++d) o[d] += pr * bf2f(V[(size_t)j * VP + d]);
    }
    float inv = 1.f / lsum;
    if (vh < GQA_H) { UNROLL for (int d = 0; d < 64; ++d) p.Y[(size_t)r * MIX_W + LRU_W + vh * 64 + d] = f2bf(o[d] * inv); }
    else { UNROLL for (int d = 0; d < 64; ++d) p.OD[(size_t)r * ODP + (vh - GQA_H) * 64 + d] = f2bf(o[d] * inv); }
}

HD float diff_lam(const P& p, int l) {
    const float* dl = p.diff_lambda + l * 4 * 32; float s0 = 0.f, s1 = 0.f;
    UNROLL for (int i = 0; i < 32; ++i) { s0 += dl[i] * dl[32 + i]; s1 += dl[64 + i] * dl[96 + i]; }
    float lam_init = 0.8f - 0.6f * expf(-0.3f * (float)l);
    return expf(s0) - expf(s1) + lam_init;
}
HD long n_yasm() { return (long)NROW * (LRU_W / 64 + DIFF_H); }
HD void st_yasm(const P& p, int l, long gid) {
    const int NJ = LRU_W / 64 + DIFF_H; int r = (int)(gid / NJ), job = (int)(gid % NJ);
    if (job < LRU_W / 64) {
        UNROLL for (int d = 0; d < 64; ++d) { int ch = job * 64 + d;
            float h = p.HS[((size_t)r * 2 + 0) * LRU_W + ch] + p.HS[((size_t)r * 2 + 1) * LRU_W + ch];
            p.Y[(size_t)r * MIX_W + ch] = f2bf(p.GA[(size_t)r * LRU_W + ch] * h); }
        return; }
    int h = job - LRU_W / 64; float lam = diff_lam(p, l); float lam_init = 0.8f - 0.6f * expf(-0.3f * (float)l);
    float o[64], ss = 0.f;
    UNROLL for (int d = 0; d < 64; ++d) { o[d] = bf2f(p.OD[(size_t)r * ODP + (2 * h) * 64 + d]) - lam * bf2f(p.OD[(size_t)r * ODP + (2 * h + 1) * 64 + d]); ss += o[d] * o[d]; }
    float rs = 1.0f / sqrtf(ss / 64.f + 1e-6f);
    UNROLL for (int d = 0; d < 64; ++d) p.Y[(size_t)r * MIX_W + LRU_W + GQA_H * 64 + h * 64 + d] = f2bf(o[d] * rs * p.diff_subln_g[l * 64 + d] * (1.f - lam_init));
}

#ifdef CPU_TEST
HD int atomic_inc(int* p_) { int v; _Pragma("omp atomic capture") { v = *p_; *p_ += 1; } return v; }
#else
__device__ __forceinline__ int atomic_inc(int* p_) { return atomicAdd(p_, 1); }
#endif
HD void route_select(const float (&lg)[N_EXP], const float* router_b, int& e1, int& e2, float& gw1, float& gw2) {
    float mx = lg[0]; UNROLL for (int e = 1; e < N_EXP; ++e) mx = fmaxf(mx, lg[e]);
    float pr[N_EXP], sum = 0.f; UNROLL for (int e = 0; e < N_EXP; ++e) { pr[e] = expf(lg[e] - mx); sum += pr[e]; }
    float inv = 1.f / sum;
    UNROLL for (int e = 0; e < N_EXP; ++e) pr[e] *= inv;
    float bs = -1e30f; e1 = 0; e2 = 1; float bp1 = 0.f, bp2 = 0.f;
    UNROLL for (int g = 0; g < 4; ++g) {
        float s1 = -1e30f, p1 = 0.f; int i1 = 0;
        UNROLL for (int i = 0; i < 4; ++i) { float sv = pr[g * 4 + i] + router_b[g * 4 + i]; if (sv > s1) { s1 = sv; i1 = i; p1 = pr[g * 4 + i]; } }
        float s2 = -1e30f, p2 = 0.f; int i2 = 0;
        UNROLL for (int i = 0; i < 4; ++i) { float sv = pr[g * 4 + i] + router_b[g * 4 + i]; if (i != i1 && sv > s2) { s2 = sv; i2 = i; p2 = pr[g * 4 + i]; } }
        float sc = s1 + s2;
        if (sc > bs) { bs = sc; e1 = g * 4 + i1; e2 = g * 4 + i2; bp1 = p1; bp2 = p2; } }
    float ws = bp1 + bp2; gw1 = bp1 / ws; gw2 = bp2 / ws;
}
HD long n_lnroute() { return (long)NROW; }
HD void st_lnroute(const P& p, int l, long gid) {
    int r = (int)gid, who = row_who(r);
    float* xr = p.XR + (size_t)r * D_MODEL; const float* yo = p.YO + (size_t)r * D_MODEL;
    const float *g1 = modp(p, l, who, 2), *sh2 = modp(p, l, who, 3), *sc2 = modp(p, l, who, 4);
    float mu = 0.f; for (int c = 0; c < D_MODEL; ++c) mu += DN_ALPHA * xr[c] + g1[c] * yo[c];
    mu /= D_MODEL; float var = 0.f;
    for (int c = 0; c < D_MODEL; ++c) { float t = DN_ALPHA * xr[c] + g1[c] * yo[c] - mu; var += t * t; }
    float rstd = 1.0f / sqrtf(var / D_MODEL + 1e-6f);
    float lg[N_EXP]; UNROLL for (int e = 0; e < N_EXP; ++e) lg[e] = 0.f;
    for (int c = 0; c < D_MODEL; ++c) {
        float t = DN_ALPHA * xr[c] + g1[c] * yo[c];
        float x1 = (t - mu) * rstd * p.ln1_g[l * D_MODEL + c] + p.ln1_b[l * D_MODEL + c];
        xr[c] = x1; float h2 = x1 * (1.f + sc2[c]) + sh2[c]; p.H[(size_t)r * D_MODEL + c] = f2bf(h2);
        UNROLL for (int e = 0; e < N_EXP; ++e) lg[e] += h2 * p.router_w[c * N_EXP + e]; }
    int e1, e2; float gw1, gw2; route_select(lg, p.router_b, e1, e2, gw1, gw2);
    p.TG[r * 2 + 0] = gw1; p.TG[r * 2 + 1] = gw2;
    int s1 = atomic_inc(p.cnt + l * N_EXP + e1); p.SLOTTOK[(size_t)e1 * NROW + s1] = r * 2 + 0;
    int s2 = atomic_inc(p.cnt + l * N_EXP + e2); p.SLOTTOK[(size_t)e2 * NROW + s2] = r * 2 + 1;
}

HD bool moe_row(const P& p, int l, int i, int& e, int& tok2) {
    int off = 0;
    UNROLL for (int q = 0; q < N_EXP; ++q) { int c = p.cnt[l * N_EXP + q]; int pc = (c + MOE_TM - 1) / MOE_TM * MOE_TM;
        if (i < off + pc) { e = q; int s = i - off; if (s >= c) return false; tok2 = p.SLOTTOK[(size_t)q * NROW + s]; return true; }
        off += pc; }
    return false;
}
HD long n_moe_up() { return (long)MOE_ROWS * (EXP_FF / 4); }
HD void st_moe_up(const P& p, int l, long gid) {
    int i = (int)(gid / (EXP_FF / 4)), j0 = (int)(gid % (EXP_FF / 4)) * 4; int e, tok2;
    if (!moe_row(p, l, i, e, tok2)) return;
    const bf16_t* a = p.H + (size_t)(tok2 >> 1) * D_MODEL; const bf16_t* W = WB_WGU(p.WB[l & 1]) + (size_t)e * 2 * EXP_FF * D_MODEL;
    for (int j = j0; j < j0 + 4; ++j) {
        const bf16_t* wg = W + (size_t)gu_row(0, j) * D_MODEL; const bf16_t* wu = W + (size_t)gu_row(1, j) * D_MODEL;
        float g = 0.f, u = 0.f; for (int k = 0; k < D_MODEL; ++k) { float av = bf2f(a[k]); g += av * bf2f(wg[k]); u += av * bf2f(wu[k]); }
        p.HM[(size_t)i * EXP_FF + j] = f2bf(siluf_(g) * u); }
}
HD long n_moe_down() { return (long)MOE_ROWS * (D_MODEL / 4); }
HD void st_moe_down(const P& p, int l, long gid) {
    int i = (int)(gid / (D_MODEL / 4)), n0 = (int)(gid % (D_MODEL / 4)) * 4; int e, tok2;
    if (!moe_row(p, l, i, e, tok2)) return;
    const bf16_t* a = p.HM + (size_t)i * EXP_FF; const bf16_t* W = WB_WD(p.WB[l & 1]) + (size_t)e * D_MODEL * EXP_FF;
    float gate = p.TG[tok2];
    for (int n = n0; n < n0 + 4; ++n) { const bf16_t* w = W + (size_t)n * EXP_FF; float acc = 0.f; for (int k = 0; k < EXP_FF; ++k) acc += bf2f(a[k]) * bf2f(w[k]);
        p.FO[(size_t)tok2 * D_MODEL + n] = f2bf(acc * gate); }
}

HD long n_lnfinal() { return (long)NROW; }
HD void st_lnfinal(const P& p, int l, long gid) {
    int r = (int)gid, who = row_who(r);
    float* xr = p.XR + (size_t)r * D_MODEL; const bf16_t* f0 = p.FO + (size_t)(r * 2) * D_MODEL; const bf16_t* f1 = f0 + D_MODEL;
    const float* g2 = modp(p, l, who, 5);
    float mu = 0.f; for (int c = 0; c < D_MODEL; ++c) mu += DN_ALPHA * xr[c] + g2[c] * (bf2f(f0[c]) + bf2f(f1[c]));
    mu /= D_MODEL; float var = 0.f;
    for (int c = 0; c < D_MODEL; ++c) { float t = DN_ALPHA * xr[c] + g2[c] * (bf2f(f0[c]) + bf2f(f1[c])) - mu; var += t * t; }
    float rstd = 1.0f / sqrtf(var / D_MODEL + 1e-6f);
    for (int c = 0; c < D_MODEL; ++c) {
        float t = DN_ALPHA * xr[c] + g2[c] * (bf2f(f0[c]) + bf2f(f1[c]));
        float x2 = (t - mu) * rstd * p.ln2_g[l * D_MODEL + c] + p.ln2_b[l * D_MODEL + c];
        xr[c] = x2;
        if (l + 1 < DEPTH) p.H[(size_t)r * D_MODEL + c] = f2bf(x2 * (1.f + modp(p, l + 1, who, 1)[c]) + modp(p, l + 1, who, 0)[c]);
        else if (r < NLAT) p.out[(size_t)r * D_MODEL + c] = x2; }
}
#define NPH_PRE 2
#define NPH_LAYER 11
#define NPH_TOTAL (NPH_PRE + DEPTH * NPH_LAYER)

#define RUN_PHASE(IDX, N, CALL) do { if ((IDX) >= ph_lo && (IDX) < ph_hi) { FOR_GID(N) { CALL; } PHASE_END(); } } while (0)

#define PHASE_PROGRAM(p, ph_lo, ph_hi) do { \
    RUN_PHASE(0, n_ada(), st_ada(p, gid)); \
    RUN_PHASE(1, n_mod0(), st_mod0(p, gid)); \
    for (int l = 0; l < DEPTH; ++l) { const int pb = NPH_PRE + l * NPH_LAYER; \
        RUN_PHASE(pb + 0, n_cvt(), st_cvt(p, l, gid)); \
        RUN_PHASE(pb + 1, n_gemm_in(), st_gemm_in(p, l, gid)); \
        RUN_PHASE(pb + 2, n_post(), st_post(p, l, gid)); \
        RUN_PHASE(pb + 3, n_lru_ab(), st_lru_ab(p, l, gid)); \
        RUN_PHASE(pb + 4, n_lru_scan() + n_att(), { if (gid < n_lru_scan()) st_lru_scan(p, gid); else st_att(p, gid - n_lru_scan()); }); \
        RUN_PHASE(pb + 5, n_yasm(), st_yasm(p, l, gid)); \
        RUN_PHASE(pb + 6, n_gemm_out(), st_gemm_out(p, l, gid)); \
        RUN_PHASE(pb + 7, n_lnroute(), st_lnroute(p, l, gid)); \
        RUN_PHASE(pb + 8, n_moe_up(), st_moe_up(p, l, gid)); \
        RUN_PHASE(pb + 9, n_moe_down(), st_moe_down(p, l, gid)); \
        RUN_PHASE(pb + 10, n_lnfinal(), st_lnfinal(p, l, gid)); \
    } } while (0)

struct WsMap { size_t ctl, mod, wb0, wb1, xr, h, u, zq, zk, zv, ax, ga, y, od, tg, slottok, hm, total; };
static inline size_t al256(size_t v) { return (v + 255) & ~(size_t)255; }
static inline WsMap ws_map() {
    WsMap m; size_t o = 0;
    m.ctl = o; o += al256(1 << 20);
    m.mod = o; o += al256((size_t)DEPTH * 3 * 6 * D_MODEL * 4);
    m.wb0 = o; o += al256(WB_ELEMS * sizeof(bf16_t));
    m.wb1 = o; o += al256(WB_ELEMS * sizeof(bf16_t));
    m.xr = o; o += al256((size_t)NROW * D_MODEL * 4);
    m.h = o; o += al256((size_t)NROW * D_MODEL * sizeof(bf16_t));
    size_t usz = (size_t)NROW * IN_W * 4; size_t u2 = (size_t)NROW * 2 * LRU_W * 4 * 3; if (u2 > usz) usz = u2; size_t u3 = (size_t)NROW * D_MODEL * 4 + (size_t)NROW * 2 * D_MODEL * sizeof(bf16_t); if (u3 > usz) usz = u3;
    m.u = o; o += al256(usz);
    m.zq = o; o += al256((size_t)NROW * QP * sizeof(bf16_t));
    m.zk = o; o += al256((size_t)BATCH * SKEY * KP * sizeof(bf16_t));
    m.zv = o; o += al256((size_t)BATCH * SKEY * VP * sizeof(bf16_t));
    m.ax = o; o += al256((size_t)NROW * LRU_W * 4);
    m.ga = o; o += al256((size_t)NROW * LRU_W * 4);
    m.y = o; o += al256((size_t)NROW * MIX_W * sizeof(bf16_t));
    m.od = o; o += al256((size_t)NROW * ODP * sizeof(bf16_t));
    m.tg = o; o += al256((size_t)NROW * 2 * 4);
    m.slottok = o; o += al256((size_t)N_EXP * NROW * 4);
    m.hm = o; o += al256((size_t)MOE_ROWS * EXP_FF * sizeof(bf16_t));
    m.total = o; return m;
}
#define CTL_CNT_WORD 8192
static inline void fill_ws(P& p, unsigned char* ws) {
    WsMap m = ws_map();
    p.ctl = (unsigned*)(ws + m.ctl); p.cnt = (int*)(p.ctl + CTL_CNT_WORD);
    p.MOD = (float*)(ws + m.mod); p.WB[0] = (bf16_t*)(ws + m.wb0); p.WB[1] = (bf16_t*)(ws + m.wb1);
    p.XR = (float*)(ws + m.xr); p.H = (bf16_t*)(ws + m.h);
    p.Z = (float*)(ws + m.u);
    p.LA = (float*)(ws + m.u); p.LB = p.LA + (size_t)NROW * 2 * LRU_W; p.HS = p.LB + (size_t)NROW * 2 * LRU_W;
    p.YO = (float*)(ws + m.u); p.FO = (bf16_t*)(ws + m.u + (size_t)NROW * D_MODEL * 4);
    p.ZQ = (bf16_t*)(ws + m.zq); p.ZK = (bf16_t*)(ws + m.zk); p.ZV = (bf16_t*)(ws + m.zv);
    p.AX = (float*)(ws + m.ax); p.GA = (float*)(ws + m.ga); p.Y = (bf16_t*)(ws + m.y); p.OD = (bf16_t*)(ws + m.od);
    p.TG = (float*)(ws + m.tg); p.SLOTTOK = (int*)(ws + m.slottok); p.HM = (bf16_t*)(ws + m.hm); p.pad_[0] = 0; p.pad_[1] = 0;
}
static inline void fill_inputs(P& p, void* const* d_in, void* d_out) {
    const float** f = (const float**)d_in;
    p.x = f[0]; p.c = f[1]; p.ctx = f[2]; p.c_ctx = f[3]; p.ada_w = f[4]; p.ada_b = f[5]; p.w_in = f[6]; p.conv_w = f[7]; p.conv_b = f[8];
    p.rg_wa = f[9]; p.rg_ba = f[10]; p.rg_wx = f[11]; p.rg_bx = f[12]; p.rg_lam = f[13]; p.q_norm_g = f[14]; p.k_norm_g = f[15];
    p.diff_lambda = f[16]; p.diff_subln_g = f[17]; p.w_out = f[18]; p.ln1_g = f[19]; p.ln1_b = f[20]; p.ln2_g = f[21]; p.ln2_b = f[22];
    p.router_w = f[23]; p.router_b = f[24]; p.exp_w_gate = f[25]; p.exp_w_up = f[26]; p.exp_w_down = f[27]; p.out = (float*)d_out;
}
template <int ST> __global__ void __launch_bounds__(256) k_stage(P p, int l) {
    const long g0 = (long)blockIdx.x * 256L + threadIdx.x, gs = (long)gridDim.x * 256L;
#define LOOP(N, CALL) for (long gid = g0; gid < (long)(N); gid += gs) { CALL; }
    if constexpr (ST == 0) LOOP(n_ada(), st_ada(p, gid))
    if constexpr (ST == 1) LOOP(n_mod0(), st_mod0(p, gid))
    if constexpr (ST == 2) LOOP(n_cvt(), st_cvt(p, l, gid))
    if constexpr (ST == 3) LOOP(n_gemm_in(), st_gemm_in(p, l, gid))
    if constexpr (ST == 4) LOOP(n_post(), st_post(p, l, gid))
    if constexpr (ST == 5) LOOP(n_lru_ab(), st_lru_ab(p, l, gid))
    if constexpr (ST == 6) LOOP(n_lru_scan(), st_lru_scan(p, gid))
    if constexpr (ST == 7) LOOP(n_att(), st_att(p, gid))
    if constexpr (ST == 8) LOOP(n_yasm(), st_yasm(p, l, gid))
    if constexpr (ST == 9) LOOP(n_gemm_out(), st_gemm_out(p, l, gid))
    if constexpr (ST == 10) LOOP(n_lnroute(), st_lnroute(p, l, gid))
    if constexpr (ST == 11) LOOP(n_moe_up(), st_moe_up(p, l, gid))
    if constexpr (ST == 12) LOOP(n_moe_down(), st_moe_down(p, l, gid))
    if constexpr (ST == 13) LOOP(n_lnfinal(), st_lnfinal(p, l, gid))
#undef LOOP
}
static inline int grid_for(long n) { long b = (n + 255) / 256; return (int)(b > 8192 ? 8192 : (b < 1 ? 1 : b)); }
#define LAUNCH(ST, N, L) k_stage<ST><<<dim3(grid_for(N)), dim3(256), 0, stream>>>(p, L)
extern "C" void kernel_launch(void* const* d_in, const int* in_sizes, int n_in, void* d_out, int out_size, void* d_ws, size_t ws_size, hipStream_t stream) {
    (void)in_sizes; (void)n_in; (void)out_size;
    WsMap m = ws_map();
    if (ws_size < m.total) { fprintf(stderr, "ws too small: %zu < %zu\n", ws_size, m.total); return; }
    P p; memset(&p, 0, sizeof(p)); fill_inputs(p, d_in, d_out); fill_ws(p, (unsigned char*)d_ws);
    hipMemsetAsync(p.ctl, 0, 1 << 20, stream);
    LAUNCH(0, n_ada(), 0); LAUNCH(1, n_mod0(), 0);
    for (int l = 0; l < DEPTH; ++l) {
        LAUNCH(2, n_cvt(), l); LAUNCH(3, n_gemm_in(), l); LAUNCH(4, n_post(), l); LAUNCH(5, n_lru_ab(), l); LAUNCH(6, n_lru_scan(), l); LAUNCH(7, n_att(), l);
        LAUNCH(8, n_yasm(), l); LAUNCH(9, n_gemm_out(), l); LAUNCH(10, n_lnroute(), l); LAUNCH(11, n_moe_up(), l); LAUNCH(12, n_moe_down(), l); LAUNCH(13, n_lnfinal(), l);
    }
}
```

```cpp
#include <hip/hip_runtime.h>
#include <cstdio>
#include <stdint.h>
#include <math.h>
#include <string.h>

#ifdef CPU_TEST
#define HD inline
#define UNROLL
#else
#define HD __host__ __device__ __forceinline__
#define UNROLL _Pragma("unroll")
#endif
#if defined(__HIP_DEVICE_COMPILE__)
#define LAUNDER_V(x) asm volatile("" : "+v"(x))
#else
#define LAUNDER_V(x) do {} while (0)
#endif

#ifndef D_MODEL
#define D_MODEL 1024
#define BATCH 2
#define SEQ 8192
#define DEPTH 4
#define GRID_W 64
#define CTX_LEN 256
#define LRU_W 256
#define GQA_H 8
#define GQA_KV 2
#define DIFF_H 4
#define EXP_FF 512
#endif
#define LRU_BLK (LRU_W / 4)
#define N_EXP 16
#define CNT_STRIDE 32
#define CNT_IDX(l, e) ((((l) * N_EXP) + (e)) * CNT_STRIDE)
#define OFF_AX 0
#define OFF_AG (LRU_W)
#define OFF_GQ (2 * LRU_W)
#define OFF_GK (OFF_GQ + GQA_H * 64)
#define OFF_GV (OFF_GK + GQA_KV * 64)
#define OFF_DQ (OFF_GV + GQA_KV * 64)
#define OFF_DK (OFF_DQ + DIFF_H * 64)
#define OFF_DV (OFF_DK + DIFF_H * 64)
#define IN_W (OFF_DV + DIFF_H * 64)
#define MIX_W (LRU_W + GQA_H * 64 + DIFF_H * 64)
#define NLAT (BATCH * SEQ)
#define NCTX (BATCH * CTX_LEN)
#define NROW (NLAT + NCTX)
#define SKEY (CTX_LEN + SEQ)
#define NVH (GQA_H + 2 * DIFF_H)
#define NKH (GQA_KV + 2 * DIFF_H)
#define NVV (GQA_KV + DIFF_H)
#define QP (NVH * 64)
#define KP (NKH * 64)
#define VP (NVV * 64)
#define ODP MIX_W
#define GUB (EXP_FF < 128 ? EXP_FF : 128)
#define MOE_TM 256
#define MOE_ROWS (2 * NROW + N_EXP * MOE_TM)
#define DN_ALPHA 1.681792830507429f
#define LOG2E 1.4426950408889634f
#define QS_G (0.125f * LOG2E)
#define QS_D (0.17677669529663687f * LOG2E)

#ifdef EXACT_TEST
typedef float bf16_t;
HD float bf2f(bf16_t h) { return h; }
HD bf16_t f2bf(float f) { return f; }
#else
typedef unsigned short bf16_t;
HD float bf2f(bf16_t h) { unsigned u = ((unsigned)h) << 16; float f; memcpy(&f, &u, 4); return f; }
HD bf16_t f2bf(float f) { unsigned u; memcpy(&u, &f, 4); return (bf16_t)((u + 0x7fffu + ((u >> 16) & 1u)) >> 16); }
#endif

struct P {
    const float *x, *c, *ctx, *c_ctx, *ada_w, *ada_b, *w_in, *conv_w, *conv_b, *rg_wa, *rg_ba, *rg_wx, *rg_bx, *rg_lam,
        *q_norm_g, *k_norm_g, *diff_lambda, *diff_subln_g, *w_out, *ln1_g, *ln1_b, *ln2_g, *ln2_b, *router_w, *router_b,
        *exp_w_gate, *exp_w_up, *exp_w_down;
    float* out;
    unsigned* ctl;
    int* cnt;
    float* MOD;
    bf16_t* WB[2];
    float* XR;
    bf16_t* H;
    float* Z;
    float *LA, *LB, *HS;
    float* YO;
    bf16_t* FO;
    bf16_t *ZQ, *ZK, *ZV;
    float *AX, *GA;
    bf16_t* Y;
    bf16_t* OD;
    float* TG;
    int* SLOTTOK;
    bf16_t* HM;
    float* XRo; bf16_t* Ho; float* TGo; int* SLOTTOKo; int* cnto;
    int pad_[2];
};
#define WB_WIN(wb) (wb)
#define WB_WOUT(wb) ((wb) + (size_t)IN_W * D_MODEL)
#define WB_WGU(wb) (WB_WOUT(wb) + (size_t)D_MODEL * MIX_W)
#define WB_WD(wb) (WB_WGU(wb) + (size_t)N_EXP * 2 * EXP_FF * D_MODEL)
#define WB_ELEMS ((size_t)IN_W * D_MODEL + (size_t)D_MODEL * MIX_W + (size_t)N_EXP * 3 * EXP_FF * D_MODEL)

HD float sigmoidf_(float x) { return 1.f / (1.f + expf(-x)); }
HD float siluf_(float x) { return x / (1.f + expf(-x)); }
HD float gelu_tanhf_(float x) { return 0.5f * x * (1.f + tanhf(0.7978845608028654f * (x + 0.044715f * x * x * x))); }
HD float softplusf_(float x) { return x > 20.f ? x : log1pf(expf(x)); }

HD int row_who(int r) { return r < NLAT ? r / SEQ : BATCH; }
HD int row_kidx(int r) { if (r < NLAT) { int b = r / SEQ, t = r % SEQ; return b * SKEY + CTX_LEN + t; } int q = r - NLAT; int b = q / CTX_LEN, j = q % CTX_LEN; return b * SKEY + j; }
HD int gu_row(int half, int j) { return (j / GUB) * 2 * GUB + half * GUB + (j % GUB); }

HD long n_cvt() { return (long)WB_ELEMS; }
HD void st_cvt(const P& p, int l, long gid) {
    bf16_t* wb = p.WB[l & 1];
    size_t i = (size_t)gid;
    const size_t n_in = (size_t)IN_W * D_MODEL, n_out = (size_t)D_MODEL * MIX_W, n_gu = (size_t)N_EXP * 2 * EXP_FF * D_MODEL;
    if (i < n_in) { int n = (int)(i / D_MODEL), k = (int)(i % D_MODEL); wb[i] = f2bf(p.w_in[((size_t)l * D_MODEL + k) * IN_W + n]); return; }
    i -= n_in;
    if (i < n_out) { int n = (int)(i / MIX_W), k = (int)(i % MIX_W); WB_WOUT(wb)[i] = f2bf(p.w_out[((size_t)l * MIX_W + k) * D_MODEL + n]); return; }
    i -= n_out;
    if (i < n_gu) {
        int e = (int)(i / ((size_t)2 * EXP_FF * D_MODEL)); size_t q = i % ((size_t)2 * EXP_FF * D_MODEL); int r = (int)(q / D_MODEL), k = (int)(q % D_MODEL);
        int t = r / (2 * GUB), w = r % (2 * GUB), half = w / GUB, cc = w % GUB, j = t * GUB + cc;
        const float* src = half ? p.exp_w_up : p.exp_w_gate;
        WB_WGU(wb)[i] = f2bf(src[(((size_t)l * N_EXP + e) * D_MODEL + k) * EXP_FF + j]); return; }
    i -= n_gu;
    { int e = (int)(i / ((size_t)D_MODEL * EXP_FF)); size_t q = i % ((size_t)D_MODEL * EXP_FF); int n = (int)(q / EXP_FF), k = (int)(q % EXP_FF);
      WB_WD(wb)[i] = f2bf(p.exp_w_down[(((size_t)l * N_EXP + e) * EXP_FF + k) * D_MODEL + n]); }
}

HD long n_ada() { return (long)DEPTH * 6 * D_MODEL; }
HD void st_ada(const P& p, long gid) {
    int l = (int)(gid / (6 * D_MODEL)), col = (int)(gid % (6 * D_MODEL));
    float acc[BATCH + 1]; UNROLL for (int w = 0; w <= BATCH; ++w) acc[w] = 0.f;
    const float* W = p.ada_w + (size_t)l * D_MODEL * 6 * D_MODEL + col;
    for (int k = 0; k < D_MODEL; ++k) { float wv = W[(size_t)k * 6 * D_MODEL];
        for (int b = 0; b < BATCH; ++b) acc[b] += siluf_(p.c[b * D_MODEL + k]) * wv;
        acc[BATCH] += siluf_(p.c_ctx[k]) * wv; }
    float bias = p.ada_b[l * 6 * D_MODEL + col];
    UNROLL for (int w = 0; w <= BATCH; ++w) p.MOD[((size_t)l * 3 + w) * 6 * D_MODEL + col] = acc[w] + bias;
}
HD const float* modp(const P& p, int l, int who, int chunk) { return p.MOD + ((size_t)l * 3 + who) * 6 * D_MODEL + chunk * D_MODEL; }

HD long n_mod0() { return (long)NROW * D_MODEL; }
HD void st_mod0(const P& p, long gid) {
    int r = (int)(gid / D_MODEL), cc = (int)(gid % D_MODEL); int who = row_who(r);
    float v = r < NLAT ? p.x[(size_t)r * D_MODEL + cc] : p.ctx[(size_t)(r - NLAT) * D_MODEL + cc];
    p.XR[gid] = v;
    p.H[gid] = f2bf(v * (1.f + modp(p, 0, who, 1)[cc]) + modp(p, 0, who, 0)[cc]);
}

HD void dot4x4(const bf16_t* const a[4], const bf16_t* const b[4], int K, float acc[4][4]) {
    UNROLL for (int i = 0; i < 4; ++i) UNROLL for (int j = 0; j < 4; ++j) acc[i][j] = 0.f;
    for (int k = 0; k < K; k += 4) {
        float av[4][4], bv[4][4];
        UNROLL for (int i = 0; i < 4; ++i) UNROLL for (int q = 0; q < 4; ++q) { av[i][q] = bf2f(a[i][k + q]); bv[i][q] = bf2f(b[i][k + q]); }
        UNROLL for (int i = 0; i < 4; ++i) UNROLL for (int j = 0; j < 4; ++j) UNROLL for (int q = 0; q < 4; ++q) acc[i][j] += av[i][q] * bv[j][q];
    }
}
HD long n_gemm_in() { return (long)(NROW / 4) * (IN_W / 4); }
HD void st_gemm_in(const P& p, int l, long gid) {
    int m0 = (int)(gid / (IN_W / 4)) * 4, n0 = (int)(gid % (IN_W / 4)) * 4;
    const bf16_t* wb = WB_WIN(p.WB[l & 1]); const bf16_t *a[4], *b[4];
    UNROLL for (int i = 0; i < 4; ++i) { a[i] = p.H + (size_t)(m0 + i) * D_MODEL; b[i] = wb + (size_t)(n0 + i) * D_MODEL; }
    float acc[4][4]; dot4x4(a, b, D_MODEL, acc);
    UNROLL for (int i = 0; i < 4; ++i) UNROLL for (int j = 0; j < 4; ++j) p.Z[(size_t)(m0 + i) * IN_W + n0 + j] = acc[i][j];
}
HD long n_gemm_out() { return (long)(NROW / 4) * (D_MODEL / 4); }
HD void st_gemm_out(const P& p, int l, long gid) {
    int m0 = (int)(gid / (D_MODEL / 4)) * 4, n0 = (int)(gid % (D_MODEL / 4)) * 4;
    const bf16_t* wb = WB_WOUT(p.WB[l & 1]); const bf16_t *a[4], *b[4];
    UNROLL for (int i = 0; i < 4; ++i) { a[i] = p.Y + (size_t)(m0 + i) * MIX_W; b[i] = wb + (size_t)(n0 + i) * MIX_W; }
    float acc[4][4]; dot4x4(a, b, MIX_W, acc);
    UNROLL for (int i = 0; i < 4; ++i) UNROLL for (int j = 0; j < 4; ++j) p.YO[(size_t)(m0 + i) * D_MODEL + n0 + j] = acc[i][j];
}

HD void rope_cs(int t, int i, int nfreq, float& cs, float& sn) {
    int rowp = t / GRID_W, colp = t % GRID_W;
    float pos = (float)(i < nfreq ? rowp : colp); int j = i % nfreq;
    float inv = exp2f(-(float)j / (float)nfreq * 13.287712379549449f);
    float ang = pos * inv;
#if defined(__HIP_DEVICE_COMPILE__)
    cs = __cosf(ang); sn = __sinf(ang);
#else
    cs = cosf(ang); sn = sinf(ang);
#endif
}
HD long n_post() { return (long)NROW * (IN_W / 64); }
HD void st_post(const P& p, int l, long gid) {
    int r = (int)(gid / (IN_W / 64)), job = (int)(gid % (IN_W / 64)); int c0 = job * 64;
    const float* z = p.Z + (size_t)r * IN_W + c0;
    bool lat = r < NLAT; int t = lat ? r % SEQ : 0; int kidx = row_kidx(r);
    float v[64]; UNROLL for (int d = 0; d < 64; ++d) v[d] = z[d];
    unsigned zz_ = 0; LAUNDER_V(zz_); const bf16_t zz = (bf16_t)zz_;
    if (c0 < OFF_AG) { UNROLL for (int d = 0; d < 64; ++d) p.AX[(size_t)r * LRU_W + c0 + d] = v[d]; return; }
    if (c0 < OFF_GQ) { UNROLL for (int d = 0; d < 64; ++d) p.GA[(size_t)r * LRU_W + (c0 - OFF_AG) + d] = gelu_tanhf_(v[d]); return; }
    if (c0 < OFF_GV) {
        bool isq = c0 < OFF_GK; int h = isq ? (c0 - OFF_GQ) / 64 : (c0 - OFF_GK) / 64;
        const float* g = (isq ? p.q_norm_g : p.k_norm_g) + l * 64;
        float ss = 0.f; UNROLL for (int d = 0; d < 64; ++d) ss += v[d] * v[d];
        float rs = 1.0f / sqrtf(ss / 64.f + 1e-6f);
        UNROLL for (int d = 0; d < 64; ++d) v[d] = v[d] * rs * g[d];
        if (lat) UNROLL for (int i = 0; i < 32; ++i) { float cs, sn; rope_cs(t, i, 16, cs, sn); float x0 = v[2 * i], x1 = v[2 * i + 1]; v[2 * i] = x0 * cs - x1 * sn; v[2 * i + 1] = x0 * sn + x1 * cs; }
        if (isq) { UNROLL for (int d = 0; d < 64; ++d) p.ZQ[(size_t)r * QP + h * 64 + d] = f2bf(v[d] * QS_G); }
        else { UNROLL for (int d = 0; d < 64; ++d) p.ZK[(size_t)kidx * KP + h * 64 + d] = f2bf(v[d]); }
        return; }
    if (c0 < OFF_DQ) { int h = (c0 - OFF_GV) / 64; UNROLL for (int d = 0; d < 64; ++d) p.ZV[(size_t)kidx * VP + h * 64 + d] = f2bf(v[d]); return; }
    if (c0 < OFF_DV) {
        bool isq = c0 < OFF_DK; int h = isq ? (c0 - OFF_DQ) / 64 : (c0 - OFF_DK) / 64;
        UNROLL for (int m = 0; m < 2; ++m) {
            float* w = v + m * 32;
            if (lat) UNROLL for (int i = 0; i < 16; ++i) { float cs, sn; rope_cs(t, i, 8, cs, sn); float x0 = w[2 * i], x1 = w[2 * i + 1]; w[2 * i] = x0 * cs - x1 * sn; w[2 * i + 1] = x0 * sn + x1 * cs; }
            if (isq) { bf16_t* o = p.ZQ + (size_t)r * QP + (GQA_H + 2 * h + m) * 64; UNROLL for (int d = 0; d < 32; ++d) { o[d] = f2bf(w[d] * QS_D); o[32 + d] = zz; } }
            else { bf16_t* o = p.ZK + (size_t)kidx * KP + (GQA_KV + 2 * h + m) * 64; UNROLL for (int d = 0; d < 32; ++d) { o[d] = f2bf(w[d]); o[32 + d] = zz; } }
        }
        return; }
    { int h = (c0 - OFF_DV) / 64; UNROLL for (int d = 0; d < 64; ++d) p.ZV[(size_t)kidx * VP + (GQA_KV + h) * 64 + d] = f2bf(v[d]); }
}

HD float conv_u(const P& p, int l, int r, int ch) {
    int base, pos, len;
    if (r < NLAT) { base = (r / SEQ) * SEQ; pos = r % SEQ; len = SEQ; } else { int q = r - NLAT; base = NLAT + (q / CTX_LEN) * CTX_LEN; pos = q % CTX_LEN; len = CTX_LEN; }
    float y = p.conv_b[l * LRU_W + ch];
    UNROLL for (int k = 0; k < 4; ++k) { int pp = pos + k - 1; if (pp >= 0 && pp < len) y += p.AX[(size_t)(base + pp) * LRU_W + ch] * p.conv_w[(l * 4 + k) * LRU_W + ch]; }
    return y;
}
HD long n_lru_ab() { return (long)NROW * 2 * LRU_W; }
HD void st_lru_ab(const P& p, int l, long gid) {
    int r = (int)(gid / (2 * LRU_W)), dir = (int)((gid / LRU_W) % 2), ch = (int)(gid % LRU_W);
    int n = ch / LRU_BLK, d = ch % LRU_BLK;
    const float* wa = p.rg_wa + ((size_t)(l * 2 + dir) * 4 + n) * LRU_BLK * LRU_BLK;
    const float* wx = p.rg_wx + ((size_t)(l * 2 + dir) * 4 + n) * LRU_BLK * LRU_BLK;
    float sa = 0.f, sx = 0.f, uc = 0.f;
    for (int c = 0; c < LRU_BLK; ++c) { float u = conv_u(p, l, r, n * LRU_BLK + c); if (c == d) uc = u; sa += u * wa[c * LRU_BLK + d]; sx += u * wx[c * LRU_BLK + d]; }
    float rg = sigmoidf_(sa + p.rg_ba[(l * 2 + dir) * LRU_W + ch]), ig = sigmoidf_(sx + p.rg_bx[(l * 2 + dir) * LRU_W + ch]);
    float log_a = -8.0f * rg * softplusf_(-p.rg_lam[(l * 2 + dir) * LRU_W + ch]);
    float a = expf(log_a), mult = sqrtf(-expm1f(2.f * log_a));
    p.LA[gid] = a; p.LB[gid] = mult * (ig * uc);
}
HD long n_lru_scan() { return (long)BATCH * 2 * LRU_W; }
HD void st_lru_scan(const P& p, long gid) {
    int b = (int)(gid / (2 * LRU_W)), dir = (int)((gid / LRU_W) % 2), ch = (int)(gid % LRU_W);
    float h = 0.f;
    for (int s = 0; s < SKEY; ++s) {
        int r;
        if (dir == 0) r = s < CTX_LEN ? NLAT + b * CTX_LEN + s : b * SEQ + (s - CTX_LEN);
        else r = s < CTX_LEN ? NLAT + b * CTX_LEN + (CTX_LEN - 1 - s) : b * SEQ + (SEQ - 1 - (s - CTX_LEN));
        size_t i = ((size_t)r * 2 + dir) * LRU_W + ch;
        h = p.LA[i] * h + p.LB[i]; p.HS[i] = h;
    }
}

HD long n_att() { return (long)NROW * NVH; }
HD void st_att(const P& p, long gid) {
    int vh = (int)(gid / NROW), r = (int)(gid % NROW);
    int b = r < NLAT ? r / SEQ : (r - NLAT) / CTX_LEN; int nk = r < NLAT ? SKEY : CTX_LEN;
    int kh = vh < GQA_H ? vh / (GQA_H / GQA_KV) : GQA_KV + (vh - GQA_H);
    int vv = vh < GQA_H ? vh / (GQA_H / GQA_KV) : GQA_KV + (vh - GQA_H) / 2;
    float q[64], o[64]; UNROLL for (int d = 0; d < 64; ++d) { q[d] = bf2f(p.ZQ[(size_t)r * QP + vh * 64 + d]); o[d] = 0.f; }
    float m = -1e30f, lsum = 0.f;
    const bf16_t* K = p.ZK + (size_t)b * SKEY * KP + kh * 64; const bf16_t* V = p.ZV + (size_t)b * SKEY * VP + vv * 64;
    for (int j = 0; j < nk; ++j) {
        float s = 0.f; UNROLL for (int d = 0; d < 64; ++d) s += q[d] * bf2f(K[(size_t)j * KP + d]);
        if (s > m) { float f = exp2f(m - s); lsum *= f; UNROLL for (int d = 0; d < 64; ++d) o[d] *= f; m = s; }
        float pr = exp2f(s - m); lsum += pr;
        UNROLL for (int d = 0; d < 64; ++d) o[d] += pr * bf2f(V[(size_t)j * VP + d]);
    }
    float inv = 1.f / lsum;
    if (vh < GQA_H) { UNROLL for (int d = 0; d < 64; ++d) p.Y[(size_t)r * MIX_W + LRU_W + vh * 64 + d] = f2bf(o[d] * inv); }
    else { UNROLL for (int d = 0; d < 64; ++d) p.OD[(size_t)r * ODP + (vh - GQA_H) * 64 + d] = f2bf(o[d] * inv); }
}

HD float diff_lam(const P& p, int l) {
    const float* dl = p.diff_lambda + l * 4 * 32; float s0 = 0.f, s1 = 0.f;
    UNROLL for (int i = 0; i < 32; ++i) { s0 += dl[i] * dl[32 + i]; s1 += dl[64 + i] * dl[96 + i]; }
    float lam_init = 0.8f - 0.6f * expf(-0.3f * (float)l);
    return expf(s0) - expf(s1) + lam_init;
}
HD long n_yasm() { return (long)NROW * (LRU_W / 64 + DIFF_H); }
HD void st_yasm(const P& p, int l, long gid) {
    const int NJ = LRU_W / 64 + DIFF_H; int r = (int)(gid / NJ), job = (int)(gid % NJ);
    if (job < LRU_W / 64) {
        UNROLL for (int d = 0; d < 64; ++d) { int ch = job * 64 + d;
            float h = p.HS[((size_t)r * 2 + 0) * LRU_W + ch] + p.HS[((size_t)r * 2 + 1) * LRU_W + ch];
            p.Y[(size_t)r * MIX_W + ch] = f2bf(p.GA[(size_t)r * LRU_W + ch] * h); }
        return; }
    int h = job - LRU_W / 64; float lam = diff_lam(p, l); float lam_init = 0.8f - 0.6f * expf(-0.3f * (float)l);
    float o[64], ss = 0.f;
    UNROLL for (int d = 0; d < 64; ++d) { o[d] = bf2f(p.OD[(size_t)r * ODP + (2 * h) * 64 + d]) - lam * bf2f(p.OD[(size_t)r * ODP + (2 * h + 1) * 64 + d]); ss += o[d] * o[d]; }
    float rs = 1.0f / sqrtf(ss / 64.f + 1e-6f);
    UNROLL for (int d = 0; d < 64; ++d) p.Y[(size_t)r * MIX_W + LRU_W + GQA_H * 64 + h * 64 + d] = f2bf(o[d] * rs * p.diff_subln_g[l * 64 + d] * (1.f - lam_init));
}

#ifdef CPU_TEST
HD int atomic_inc(int* p_) { int v; _Pragma("omp atomic capture") { v = *p_; *p_ += 1; } return v; }
#else
__device__ __forceinline__ int atomic_inc(int* p_) { return atomicAdd(p_, 1); }
#endif
HD void route_select(const float (&lg)[N_EXP], const float* router_b, int& e1, int& e2, float& gw1, float& gw2) {
    float mx = lg[0]; UNROLL for (int e = 1; e < N_EXP; ++e) mx = fmaxf(mx, lg[e]);
    float pr[N_EXP], sum = 0.f; UNROLL for (int e = 0; e < N_EXP; ++e) { pr[e] = expf(lg[e] - mx); sum += pr[e]; }
    float inv = 1.f / sum;
    UNROLL for (int e = 0; e < N_EXP; ++e) pr[e] *= inv;
    float bs = -1e30f; e1 = 0; e2 = 1; float bp1 = 0.f, bp2 = 0.f;
    UNROLL for (int g = 0; g < 4; ++g) {
        float s1 = -1e30f, p1 = 0.f; int i1 = 0;
        UNROLL for (int i = 0; i < 4; ++i) { float sv = pr[g * 4 + i] + router_b[g * 4 + i]; if (sv > s1) { s1 = sv; i1 = i; p1 = pr[g * 4 + i]; } }
        float s2 = -1e30f, p2 = 0.f; int i2 = 0;
        UNROLL for (int i = 0; i < 4; ++i) { float sv = pr[g * 4 + i] + router_b[g * 4 + i]; if (i != i1 && sv > s2) { s2 = sv; i2 = i; p2 = pr[g * 4 + i]; } }
        float sc = s1 + s2;
        if (sc > bs) { bs = sc; e1 = g * 4 + i1; e2 = g * 4 + i2; bp1 = p1; bp2 = p2; } }
    float ws = bp1 + bp2; gw1 = bp1 / ws; gw2 = bp2 / ws;
}
HD long n_lnroute() { return (long)NROW; }
HD void st_lnroute(const P& p, int l, long gid) {
    int r = (int)gid, who = row_who(r);
    float* xr = p.XR + (size_t)r * D_MODEL; const float* yo = p.YO + (size_t)r * D_MODEL;
    const float *g1 = modp(p, l, who, 2), *sh2 = modp(p, l, who, 3), *sc2 = modp(p, l, who, 4);
    float mu = 0.f; for (int c = 0; c < D_MODEL; ++c) mu += DN_ALPHA * xr[c] + g1[c] * yo[c];
    mu /= D_MODEL; float var = 0.f;
    for (int c = 0; c < D_MODEL; ++c) { float t = DN_ALPHA * xr[c] + g1[c] * yo[c] - mu; var += t * t; }
    float rstd = 1.0f / sqrtf(var / D_MODEL + 1e-6f);
    float lg[N_EXP]; UNROLL for (int e = 0; e < N_EXP; ++e) lg[e] = 0.f;
    for (int c = 0; c < D_MODEL; ++c) {
        float t = DN_ALPHA * xr[c] + g1[c] * yo[c];
        float x1 = (t - mu) * rstd * p.ln1_g[l * D_MODEL + c] + p.ln1_b[l * D_MODEL + c];
        xr[c] = x1; float h2 = x1 * (1.f + sc2[c]) + sh2[c]; p.H[(size_t)r * D_MODEL + c] = f2bf(h2);
        UNROLL for (int e = 0; e < N_EXP; ++e) lg[e] += h2 * p.router_w[c * N_EXP + e]; }
    int e1, e2; float gw1, gw2; route_select(lg, p.router_b, e1, e2, gw1, gw2);
    p.TG[r * 2 + 0] = gw1; p.TG[r * 2 + 1] = gw2;
    int s1 = atomic_inc(p.cnt + CNT_IDX(l, e1)); p.SLOTTOK[(size_t)e1 * NROW + s1] = r * 2 + 0;
    int s2 = atomic_inc(p.cnt + CNT_IDX(l, e2)); p.SLOTTOK[(size_t)e2 * NROW + s2] = r * 2 + 1;
}

HD bool moe_row(const P& p, int l, int i, int& e, int& tok2) {
    int off = 0;
    UNROLL for (int q = 0; q < N_EXP; ++q) { int c = p.cnt[CNT_IDX(l, q)]; int pc = (c + MOE_TM - 1) / MOE_TM * MOE_TM;
        if (i < off + pc) { e = q; int s = i - off; if (s >= c) return false; tok2 = p.SLOTTOK[(size_t)q * NROW + s]; return true; }
        off += pc; }
    return false;
}
HD long n_moe_up() { return (long)MOE_ROWS * (EXP_FF / 4); }
HD void st_moe_up(const P& p, int l, long gid) {
    int i = (int)(gid / (EXP_FF / 4)), j0 = (int)(gid % (EXP_FF / 4)) * 4; int e, tok2;
    if (!moe_row(p, l, i, e, tok2)) return;
    const bf16_t* a = p.H + (size_t)(tok2 >> 1) * D_MODEL; const bf16_t* W = WB_WGU(p.WB[l & 1]) + (size_t)e * 2 * EXP_FF * D_MODEL;
    for (int j = j0; j < j0 + 4; ++j) {
        const bf16_t* wg = W + (size_t)gu_row(0, j) * D_MODEL; const bf16_t* wu = W + (size_t)gu_row(1, j) * D_MODEL;
        float g = 0.f, u = 0.f; for (int k = 0; k < D_MODEL; ++k) { float av = bf2f(a[k]); g += av * bf2f(wg[k]); u += av * bf2f(wu[k]); }
        p.HM[(size_t)i * EXP_FF + j] = f2bf(siluf_(g) * u); }
}
HD long n_moe_down() { return (long)MOE_ROWS * (D_MODEL / 4); }
HD void st_moe_down(const P& p, int l, long gid) {
    int i = (int)(gid / (D_MODEL / 4)), n0 = (int)(gid % (D_MODEL / 4)) * 4; int e, tok2;
    if (!moe_row(p, l, i, e, tok2)) return;
    const bf16_t* a = p.HM + (size_t)i * EXP_FF; const bf16_t* W = WB_WD(p.WB[l & 1]) + (size_t)e * D_MODEL * EXP_FF;
    float gate = p.TG[tok2];
    for (int n = n0; n < n0 + 4; ++n) { const bf16_t* w = W + (size_t)n * EXP_FF; float acc = 0.f; for (int k = 0; k < EXP_FF; ++k) acc += bf2f(a[k]) * bf2f(w[k]);
        p.FO[(size_t)tok2 * D_MODEL + n] = f2bf(acc * gate); }
}

HD long n_lnfinal() { return (long)NROW; }
HD void st_lnfinal(const P& p, int l, long gid) {
    int r = (int)gid, who = row_who(r);
    float* xr = p.XR + (size_t)r * D_MODEL; const bf16_t* f0 = p.FO + (size_t)(r * 2) * D_MODEL; const bf16_t* f1 = f0 + D_MODEL;
    const float* g2 = modp(p, l, who, 5);
    float mu = 0.f; for (int c = 0; c < D_MODEL; ++c) mu += DN_ALPHA * xr[c] + g2[c] * (bf2f(f0[c]) + bf2f(f1[c]));
    mu /= D_MODEL; float var = 0.f;
    for (int c = 0; c < D_MODEL; ++c) { float t = DN_ALPHA * xr[c] + g2[c] * (bf2f(f0[c]) + bf2f(f1[c])) - mu; var += t * t; }
    float rstd = 1.0f / sqrtf(var / D_MODEL + 1e-6f);
    for (int c = 0; c < D_MODEL; ++c) {
        float t = DN_ALPHA * xr[c] + g2[c] * (bf2f(f0[c]) + bf2f(f1[c]));
        float x2 = (t - mu) * rstd * p.ln2_g[l * D_MODEL + c] + p.ln2_b[l * D_MODEL + c];
        xr[c] = x2;
        if (l + 1 < DEPTH) p.H[(size_t)r * D_MODEL + c] = f2bf(x2 * (1.f + modp(p, l + 1, who, 1)[c]) + modp(p, l + 1, who, 0)[c]);
        else if (r < NLAT) p.out[(size_t)r * D_MODEL + c] = x2; }
}
#define NPH_PRE 2
#define NPH_LAYER 11
#define NPH_TOTAL (NPH_PRE + DEPTH * NPH_LAYER)

#define RUN_PHASE(IDX, N, CALL) do { if ((IDX) >= ph_lo && (IDX) < ph_hi) { FOR_GID(N) { CALL; } PHASE_END(); } } while (0)

#define PHASE_PROGRAM(p, ph_lo, ph_hi) do { \
    RUN_PHASE(0, n_ada(), st_ada(p, gid)); \
    RUN_PHASE(1, n_mod0(), st_mod0(p, gid)); \
    for (int l = 0; l < DEPTH; ++l) { const int pb = NPH_PRE + l * NPH_LAYER; \
        RUN_PHASE(pb + 0, n_cvt(), st_cvt(p, l, gid)); \
        RUN_PHASE(pb + 1, n_gemm_in(), st_gemm_in(p, l, gid)); \
        RUN_PHASE(pb + 2, n_post(), st_post(p, l, gid)); \
        RUN_PHASE(pb + 3, n_lru_ab(), st_lru_ab(p, l, gid)); \
        RUN_PHASE(pb + 4, n_lru_scan() + n_att(), { if (gid < n_lru_scan()) st_lru_scan(p, gid); else st_att(p, gid - n_lru_scan()); }); \
        RUN_PHASE(pb + 5, n_yasm(), st_yasm(p, l, gid)); \
        RUN_PHASE(pb + 6, n_gemm_out(), st_gemm_out(p, l, gid)); \
        RUN_PHASE(pb + 7, n_lnroute(), st_lnroute(p, l, gid)); \
        RUN_PHASE(pb + 8, n_moe_up(), st_moe_up(p, l, gid)); \
        RUN_PHASE(pb + 9, n_moe_down(), st_moe_down(p, l, gid)); \
        RUN_PHASE(pb + 10, n_lnfinal(), st_lnfinal(p, l, gid)); \
    } } while (0)

struct WsMap { size_t ctl, mod, wb0, wb1, xr, h, u, zq, zk, zv, ax, ga, y, od, tg, slottok, hm, total; };
static inline size_t al256(size_t v) { return (v + 255) & ~(size_t)255; }
static inline WsMap ws_map() {
    WsMap m; size_t o = 0;
    m.ctl = o; o += al256(1 << 20);
    m.mod = o; o += al256((size_t)DEPTH * 3 * 6 * D_MODEL * 4);
    m.wb0 = o; o += al256(WB_ELEMS * sizeof(bf16_t));
    m.wb1 = o; o += al256(WB_ELEMS * sizeof(bf16_t));
    m.xr = o; o += al256((size_t)NROW * D_MODEL * 4);
    m.h = o; o += al256((size_t)NROW * D_MODEL * sizeof(bf16_t));
    size_t usz = (size_t)NROW * IN_W * 4; size_t u2 = (size_t)NROW * 2 * LRU_W * 4 * 3; if (u2 > usz) usz = u2; size_t u3 = (size_t)NROW * D_MODEL * 4 + (size_t)NROW * 2 * D_MODEL * sizeof(bf16_t); if (u3 > usz) usz = u3;
    m.u = o; o += al256(usz);
    m.zq = o; o += al256((size_t)NROW * QP * sizeof(bf16_t));
    m.zk = o; o += al256((size_t)BATCH * SKEY * KP * sizeof(bf16_t));
    m.zv = o; o += al256((size_t)BATCH * SKEY * VP * sizeof(bf16_t));
    m.ax = o; o += al256((size_t)NROW * LRU_W * 4);
    m.ga = o; o += al256((size_t)NROW * LRU_W * 4);
    m.y = o; o += al256((size_t)NROW * MIX_W * sizeof(bf16_t));
    m.od = o; o += al256((size_t)NROW * ODP * sizeof(bf16_t));
    m.tg = o; o += al256((size_t)NROW * 2 * 4);
    m.slottok = o; o += al256((size_t)N_EXP * NROW * 4);
    m.hm = o; o += al256((size_t)MOE_ROWS * EXP_FF * sizeof(bf16_t));
    m.total = o; return m;
}
#define CTL_CNT_WORD 8192
static inline void fill_ws(P& p, unsigned char* ws) {
    WsMap m = ws_map();
    p.ctl = (unsigned*)(ws + m.ctl); p.cnt = (int*)(p.ctl + CTL_CNT_WORD);
    p.MOD = (float*)(ws + m.mod); p.WB[0] = (bf16_t*)(ws + m.wb0); p.WB[1] = (bf16_t*)(ws + m.wb1);
    p.XR = (float*)(ws + m.xr); p.H = (bf16_t*)(ws + m.h);
    p.Z = (float*)(ws + m.u);
    p.LA = (float*)(ws + m.u); p.LB = p.LA + (size_t)NROW * 2 * LRU_W; p.HS = p.LB + (size_t)NROW * 2 * LRU_W;
    p.YO = (float*)(ws + m.u); p.FO = (bf16_t*)(ws + m.u + (size_t)NROW * D_MODEL * 4);
    p.ZQ = (bf16_t*)(ws + m.zq); p.ZK = (bf16_t*)(ws + m.zk); p.ZV = (bf16_t*)(ws + m.zv);
    p.AX = (float*)(ws + m.ax); p.GA = (float*)(ws + m.ga); p.Y = (bf16_t*)(ws + m.y); p.OD = (bf16_t*)(ws + m.od);
    p.TG = (float*)(ws + m.tg); p.SLOTTOK = (int*)(ws + m.slottok); p.HM = (bf16_t*)(ws + m.hm); p.XRo = p.XR; p.Ho = p.H; p.TGo = p.TG; p.SLOTTOKo = p.SLOTTOK; p.cnto = p.cnt; p.pad_[0] = 0; p.pad_[1] = 0;
}
static inline void fill_inputs(P& p, void* const* d_in, void* d_out) {
    const float** f = (const float**)d_in;
    p.x = f[0]; p.c = f[1]; p.ctx = f[2]; p.c_ctx = f[3]; p.ada_w = f[4]; p.ada_b = f[5]; p.w_in = f[6]; p.conv_w = f[7]; p.conv_b = f[8];
    p.rg_wa = f[9]; p.rg_ba = f[10]; p.rg_wx = f[11]; p.rg_bx = f[12]; p.rg_lam = f[13]; p.q_norm_g = f[14]; p.k_norm_g = f[15];
    p.diff_lambda = f[16]; p.diff_subln_g = f[17]; p.w_out = f[18]; p.ln1_g = f[19]; p.ln1_b = f[20]; p.ln2_g = f[21]; p.ln2_b = f[22];
    p.router_w = f[23]; p.router_b = f[24]; p.exp_w_gate = f[25]; p.exp_w_up = f[26]; p.exp_w_down = f[27]; p.out = (float*)d_out;
}
constexpr int NTHR = 512;
constexpr int LDS_RING = 131072;
constexpr int LDS_BYTES = 147456;
constexpr int LDS_MISC = LDS_RING;
template <int CTRL> __device__ __forceinline__ float dpp_mov(float v) { return __builtin_bit_cast(float, __builtin_amdgcn_update_dpp(0, __builtin_bit_cast(int, v), CTRL, 0xf, 0xf, true)); }
#define DPP_XOR1 0xB1
#define DPP_XOR2 0x4E
#define DPP_HMIR 0x141
#define DPP_MIR  0x140
__device__ __forceinline__ float swap16_sum(float v) { auto rr = __builtin_amdgcn_permlane16_swap(__float_as_uint(v), __float_as_uint(v), false, false); return __uint_as_float(rr[0]) + __uint_as_float(rr[1]); }
__device__ __forceinline__ float swap32_sum(float v) { auto rr = __builtin_amdgcn_permlane32_swap(__float_as_uint(v), __float_as_uint(v), false, false); return __uint_as_float(rr[0]) + __uint_as_float(rr[1]); }
__device__ __forceinline__ float swap16_max(float v) { auto rr = __builtin_amdgcn_permlane16_swap(__float_as_uint(v), __float_as_uint(v), false, false); return fmaxf(__uint_as_float(rr[0]), __uint_as_float(rr[1])); }
__device__ __forceinline__ float swap32_max(float v) { auto rr = __builtin_amdgcn_permlane32_swap(__float_as_uint(v), __float_as_uint(v), false, false); return fmaxf(__uint_as_float(rr[0]), __uint_as_float(rr[1])); }
__device__ __forceinline__ float row16_sum(float v) { v += dpp_mov<DPP_XOR1>(v); v += dpp_mov<DPP_XOR2>(v); v += dpp_mov<DPP_HMIR>(v); v += dpp_mov<DPP_MIR>(v); return v; }
__device__ __forceinline__ float half32_sum(float v) { return swap16_sum(row16_sum(v)); }
__device__ __forceinline__ float wave_sum(float v) { return swap32_sum(swap16_sum(row16_sum(v))); }
__device__ __forceinline__ float xor32_get(float v, bool upper) { auto rr = __builtin_amdgcn_permlane32_swap(__float_as_uint(v), __float_as_uint(v), false, false); return __uint_as_float(upper ? rr[0] : rr[1]); }
#define XB_TMO      128
#define XB_XCNT(j)  (256  + 64 * (j))
#define XB_XSUB(j)  (1280 + 64 * (j))
#define XB_XGEN(j)  (2304 + 64 * (j))
#define XB_TOP      3328
#define XB_TOPGEN   3392
#define XCD_BAR_WORDS 3456
#define XB_SPIN_CAP (1u << 21)
#define LAS __attribute__((address_space(3)))

__device__ __forceinline__ unsigned xb_ld(unsigned* p)              { return __hip_atomic_load(p, __ATOMIC_RELAXED, __HIP_MEMORY_SCOPE_AGENT); }
__device__ __forceinline__ unsigned xb_add(unsigned* p, unsigned v) { return __hip_atomic_fetch_add(p, v, __ATOMIC_RELAXED, __HIP_MEMORY_SCOPE_AGENT); }
__device__ __forceinline__ unsigned xb_xcc_id() { return (unsigned)__builtin_amdgcn_s_getreg((3 << 11) | 20) & 0xFu; }
#define XB_SPIN(cond, bar) do { unsigned _sp = 0; while (cond) { __builtin_amdgcn_s_sleep(1); \
    if ((++_sp & 255u) == 0u) { if (xb_ld(&(bar)[XB_TMO])) break; if (_sp > XB_SPIN_CAP) { atomicAdd(&(bar)[XB_TMO], 1u); break; } } } } while (0)

struct XcdBarrier {
    unsigned* bar; unsigned x;
    volatile LAS unsigned* st;
};

__device__ __forceinline__ XcdBarrier xcd_barrier_post(unsigned* bar, volatile LAS unsigned* st) {
    XcdBarrier b; b.bar = bar; b.x = xb_xcc_id(); b.st = st;
    if (threadIdx.x == 0) (void)xb_add(&bar[XB_XCNT(b.x)], 1u);
    return b;
}
__device__ __forceinline__ void xcd_barrier_complete(unsigned* bar, unsigned x, unsigned& nloc, unsigned& nx) {
    const unsigned G = gridDim.x * gridDim.y * gridDim.z;
    unsigned sum, cnt, mine, sp = 0u;
    for (;;) {
        sum = 0u; cnt = 0u; mine = 0u;
#pragma unroll
        for (unsigned j = 0; j < 16; ++j) { const unsigned c = xb_ld(&bar[XB_XCNT(j)]); sum += c; cnt += (c > 0u) ? 1u : 0u; mine = (j == x) ? c : mine; }
        if (sum == G) break;
        __builtin_amdgcn_s_sleep(1);
        if ((++sp & 255u) == 0u) { if (xb_ld(&bar[XB_TMO])) break; if (sp > XB_SPIN_CAP) { atomicAdd(&bar[XB_TMO], 1u); break; } }
    }
    nloc = mine > 0u ? mine : 1u; nx = cnt > 0u ? cnt : 1u;
}

__device__ __forceinline__ void xcd_barrier(const XcdBarrier& b) {
    asm volatile("s_waitcnt vmcnt(0)" ::: "memory");
    __syncthreads();
    if (threadIdx.x == 0) {
        unsigned* bar = b.bar;
        __builtin_amdgcn_s_waitcnt(0);
        unsigned nloc = b.st[0], nx = b.st[1];
        if (nloc == 0u) { xcd_barrier_complete(bar, b.x, nloc, nx); b.st[0] = nloc; b.st[1] = nx; }
        const unsigned old = xb_add(&bar[XB_XSUB(b.x)], 1u);
        const unsigned gen = old / nloc;
        if (old + 1u == (gen + 1u) * nloc) {
            __builtin_amdgcn_fence(__ATOMIC_RELEASE, "agent");
            asm volatile("s_waitcnt vmcnt(0)" ::: "memory");
            const unsigned og = xb_add(&bar[XB_TOP], 1u);
            const unsigned tg = og / nx;
            if (og + 1u == (tg + 1u) * nx) xb_add(&bar[XB_TOPGEN], 1u);
            else XB_SPIN(xb_ld(&bar[XB_TOPGEN]) == tg, bar);
            __builtin_amdgcn_fence(__ATOMIC_ACQUIRE, "agent");
            xb_add(&bar[XB_XGEN(b.x)], 1u);
            asm volatile("s_waitcnt vmcnt(0)" ::: "memory");
        } else {
            XB_SPIN(xb_ld(&bar[XB_XGEN(b.x)]) == gen, bar);
            __builtin_amdgcn_fence(__ATOMIC_ACQUIRE, "agent");
            asm volatile("s_waitcnt vmcnt(0)" ::: "memory");
        }
    }
    __syncthreads();
}

#include <hip/hip_bf16.h>
#include <cmath>
namespace attn_body {
using bf16=__hip_bfloat16;
using bf16x8=__attribute__((ext_vector_type(8)))short;
using s16x4=__attribute__((ext_vector_type(4)))short;
using f32x16=__attribute__((ext_vector_type(16)))float;
using u32x4=__attribute__((ext_vector_type(4)))unsigned;
constexpr int D=64;
constexpr int NW=8,QBLK=32,QB=QBLK*NW,KVBLK=64;
constexpr int ATTN_UNIT_ROWS=QB;
__device__ __forceinline__ int crow(int r,int hi){return (r&3)+8*(r>>2)+4*hi;}
#define SBAR() __builtin_amdgcn_sched_barrier(0)
__device__ __forceinline__ void cmask(f32x16&p0,f32x16&p1,int jb,int qrel,int hi){
  const float NEG=-INFINITY; int kb=64*jb+4*hi;
  #pragma unroll
  for(int r=0;r<16;++r){int kv=kb+(r&3)+8*(r>>2); if(kv>qrel)p0[r]=NEG; if(kv+32>qrel)p1[r]=NEG;}
}

constexpr int NSLOT=3, SLOTB=8192;
constexpr int LDS_K=0, LDS_V=NSLOT*SLOTB, LDS_WS=2*NSLOT*SLOTB, LDS_OST=LDS_WS+NW*64*4, LDS_BYTES=LDS_OST+NW*4096;
constexpr float C2=0.125f*1.4426950408889634f;
__device__ __forceinline__ void glds16(const void*gsrc,unsigned lds_dst){unsigned keep;
  asm volatile("s_mov_b32 %0, m0\n\ts_mov_b32 m0, %2\n\ts_nop 0\n\tglobal_load_lds_dwordx4 %1, off\n\ts_mov_b32 m0, %0":"=&s"(keep):"v"(gsrc),"s"(lds_dst):"memory");}
__device__ __forceinline__ float max3f(float a,float b,float c){float r;asm("v_max3_f32 %0, %1, %2, %3":"=v"(r):"v"(a),"v"(b),"v"(c));return r;}
__device__ __forceinline__ float max2f(float a,float b){float r;asm("v_max_f32_e32 %0, %1, %2":"=v"(r):"v"(a),"v"(b));return r;}
__device__ __forceinline__ float fadd_s(float a,float b){float r;asm("v_add_f32_e32 %0, %1, %2":"=v"(r):"v"(a),"v"(b));return r;}
__device__ __forceinline__ float fsub_s(float a,float b){float r;asm("v_sub_f32_e32 %0, %1, %2":"=v"(r):"v"(a),"v"(b));return r;}
typedef float f32x2_t __attribute__((ext_vector_type(2))); typedef __bf16 bf16x2_t __attribute__((ext_vector_type(2)));
__device__ __forceinline__ unsigned cvtpk_s(float lo,float hi){f32x2_t v={lo,hi};bf16x2_t b=__builtin_convertvector(v,bf16x2_t);return __builtin_bit_cast(unsigned,b);}
#define WAIT_BAR(N) asm volatile("s_waitcnt vmcnt(" #N ") lgkmcnt(0)\n\ts_barrier":::"memory")

template<int ND> __device__ __forceinline__ void qkt(f32x16&p0,f32x16&p1,const char*Kslot,const bf16x8*qr,const f32x16&negm,int r32,int hi){
  const char*kb=Kslot+hi*1024+r32*16;
  #pragma unroll
  for(int d0=0;d0<ND;++d0){
    const bf16x8 b0=*reinterpret_cast<const bf16x8*>(kb+d0*2048);
    const bf16x8 b1=*reinterpret_cast<const bf16x8*>(kb+d0*2048+512);
    if(d0==0){p0=__builtin_amdgcn_mfma_f32_32x32x16_bf16(b0,qr[0],negm,0,0,0);p1=__builtin_amdgcn_mfma_f32_32x32x16_bf16(b1,qr[0],negm,0,0,0);}
    else{p0=__builtin_amdgcn_mfma_f32_32x32x16_bf16(b0,qr[d0],p0,0,0,0);p1=__builtin_amdgcn_mfma_f32_32x32x16_bf16(b1,qr[d0],p1,0,0,0);}}
}
typedef __attribute__((address_space(3))) const char* lds_cptr;
typedef short v4i16_t __attribute__((ext_vector_type(4)));
__device__ __forceinline__ void kload8(bf16x8*kf,lds_cptr kp){
  kf[0]=*(const __attribute__((address_space(3))) bf16x8*)(kp);      kf[1]=*(const __attribute__((address_space(3))) bf16x8*)(kp+512);
  kf[2]=*(const __attribute__((address_space(3))) bf16x8*)(kp+2048); kf[3]=*(const __attribute__((address_space(3))) bf16x8*)(kp+2560);
  kf[4]=*(const __attribute__((address_space(3))) bf16x8*)(kp+4096); kf[5]=*(const __attribute__((address_space(3))) bf16x8*)(kp+4608);
  kf[6]=*(const __attribute__((address_space(3))) bf16x8*)(kp+6144); kf[7]=*(const __attribute__((address_space(3))) bf16x8*)(kp+6656);
}
__device__ __forceinline__ void kload2(bf16x8*kf,lds_cptr kp,int j){ kf[2*j]=*(const __attribute__((address_space(3))) bf16x8*)(kp+j*2048); kf[2*j+1]=*(const __attribute__((address_space(3))) bf16x8*)(kp+j*2048+512); }
__device__ __forceinline__ s16x4 vtr(lds_cptr p){ return __builtin_bit_cast(s16x4,__builtin_amdgcn_ds_read_tr16_b64_v4i16((__attribute__((address_space(3))) v4i16_t*)p)); }
__device__ __forceinline__ float rowmax(const f32x16&p0,const f32x16&p1){
  float a=max3f(p0[0],p0[1],p1[0]),b=max3f(p0[2],p0[3],p1[1]);a=max3f(a,p1[2],p1[3]);
  #pragma unroll
  for(int r=4;r<16;r+=4){a=max3f(a,p0[r],p0[r+1]);b=max3f(b,p0[r+2],p0[r+3]);a=max3f(a,p1[r],p1[r+1]);b=max3f(b,p1[r+2],p1[r+3]);}
  const float m=max2f(a,b);
  auto rr=__builtin_amdgcn_permlane32_swap(__float_as_uint(m),__float_as_uint(m),false,false);
  return max2f(__uint_as_float(rr[0]),__uint_as_float(rr[1]));
}
__device__ __forceinline__ void pv(f32x16*o,int vb,bf16x8 pa0,bf16x8 pa1,bf16x8 pa2,bf16x8 pa3){
  #pragma unroll
  for(int d0=0;d0<2;++d0){s16x4 lo[4],hi[4];
    #pragma unroll
    for(int ks=0;ks<4;++ks){
      asm volatile("ds_read_b64_tr_b16 %0,%1 offset:%c2":"=&v"(lo[ks]):"v"(vb),"i"(d0*4096+ks*1024):"memory");
      asm volatile("ds_read_b64_tr_b16 %0,%1 offset:%c2":"=&v"(hi[ks]):"v"(vb),"i"(d0*4096+ks*1024+512):"memory");}
    asm volatile("s_waitcnt lgkmcnt(0)":::"memory");SBAR();
    #define PK(k) (bf16x8){lo[k][0],lo[k][1],lo[k][2],lo[k][3],hi[k][0],hi[k][1],hi[k][2],hi[k][3]}
    o[d0]=__builtin_amdgcn_mfma_f32_32x32x16_bf16(pa0,PK(0),o[d0],0,0,0);
    o[d0]=__builtin_amdgcn_mfma_f32_32x32x16_bf16(pa1,PK(1),o[d0],0,0,0);
    o[d0]=__builtin_amdgcn_mfma_f32_32x32x16_bf16(pa2,PK(2),o[d0],0,0,0);
    o[d0]=__builtin_amdgcn_mfma_f32_32x32x16_bf16(pa3,PK(3),o[d0],0,0,0);
    #undef PK
  }
}

#ifndef ATTN_STORE16
#define ATTN_STORE16(p,v) (*(u32x4*)(p)=(v))
#endif
template<int THRL,int QPITCH,int KPITCH,int VPITCH,int OPITCH,bool HALFK,bool NOMAX> __device__ __forceinline__ void attn_unit(const bf16*Qu,const bf16*__restrict__ Kh,const bf16*__restrict__ Vh,bf16*Ou,const int NT,char*shm,const bf16*Knext=nullptr,const bool kpre=false){
  int tid_l=threadIdx.x; asm volatile("":"+v"(tid_l)); const int tid=tid_l,lane=tid&63,r32=lane&31,hi=lane>>5; const int wid=__builtin_amdgcn_readfirstlane(tid>>6);
  const bf16*Qw=Qu+(long)(wid*QBLK)*QPITCH;
  const unsigned lds0=(unsigned)(uintptr_t)shm;
  float*wsf=(float*)(shm+LDS_WS)+wid*64;
  const bf16*ksrc=Kh+(long)lane*KPITCH+wid*8;
  const bf16*vsrc=Vh+(long)(16*(wid&3)+(lane>>2))*VPITCH+(wid>>2)*32+(lane&3)*8;
  const unsigned kdst=lds0+LDS_K+wid*1024, vdst=lds0+LDS_V+wid*1024;
  #define DMA_K(t,slot) glds16(ksrc+(long)(t)*KVBLK*KPITCH,(unsigned)__builtin_amdgcn_readfirstlane(kdst+(slot)))
  #define DMA_V(t,slot) glds16(vsrc+(long)(t)*KVBLK*VPITCH,(unsigned)__builtin_amdgcn_readfirstlane(vdst+(slot)))
  const int vb0=(int)(lds0+LDS_V)+((lane>>4)&1)*32+(lane&3)*8+(4*hi+((lane&15)>>2))*64;
  const char*Kbase=shm+LDS_K; bf16x8 kf[8];
  const lds_cptr shm3=(lds_cptr)shm; const lds_cptr kp0=shm3+LDS_K+hi*1024+r32*16; const lds_cptr vp0=shm3+LDS_V+((lane>>4)&1)*32+(lane&3)*8+(4*hi+((lane&15)>>2))*64;
  if(!kpre){DMA_K(0,0);DMA_V(0,0);DMA_K(1,SLOTB);}
  bf16x8 qr[4];
  #pragma unroll
  for(int d0=0;d0<4;++d0)qr[d0]=*reinterpret_cast<const bf16x8*>(&Qw[(long)r32*QPITCH+d0*16+hi*8]);
  float mhat=0.f,l_reg=0.f;f32x16 o[2];o[0]=f32x16{};o[1]=f32x16{};f32x16 negm=f32x16{};asm volatile("":"+v"(negm));
  #define CMASK(P0,P1,t) do{}while(0)
  bool resc=false;
  #define START(P0,P1) do{ resc=false; \
    if constexpr(!NOMAX){ const float rm=rowmax(P0,P1); const float dl=rm; mhat=fadd_s(mhat,dl); \
      _Pragma("unroll") for(int r=0;r<16;++r){P0[r]=fsub_s(P0[r],dl);P1[r]=fsub_s(P1[r],dl);} \
      _Pragma("unroll") for(int r=0;r<16;++r)negm[r]=-mhat; asm volatile("":"+v"(negm)); } \
    _Pragma("unroll") for(int r=0;r<16;++r)P0[r]=__builtin_amdgcn_exp2f(P0[r]); }while(0)
  #define RESC() do{ if(resc){ asm volatile("s_waitcnt lgkmcnt(0)":::"memory"); \
      _Pragma("unroll") for(int d_=0;d_<2;++d_) _Pragma("unroll") for(int r=0;r<16;++r)o[d_][r]*=wsf[crow(r,hi)]; } }while(0)
  f32x16 pA0,pA1,pB0,pB1;
  int sl_prev=0,sl_cur=0,sl_next=SLOTB;
  #define ROT() do{sl_prev=sl_cur;sl_cur=sl_next;sl_next=(sl_next==(NSLOT-1)*SLOTB)?0:sl_next+SLOTB;}while(0)
  if(!kpre){ DMA_K(2,2*SLOTB);
    WAIT_BAR(3); }
  else{ DMA_V(0,0); WAIT_BAR(1); }
  qkt<(HALFK?2:4)>(pA0,pA1,Kbase,qr,negm,r32,hi);asm volatile("s_nop 15\n\ts_nop 7":"+v"(pA0),"+v"(pA1));CMASK(pA0,pA1,0);
  START(pA0,pA1);
  _Pragma("unroll") for(int r=0;r<16;++r)pA1[r]=__builtin_amdgcn_exp2f(pA1[r]);
  WAIT_BAR(0);
  DMA_K(3,0);DMA_V(1,SLOTB);
  ROT();
  if constexpr(HALFK){kload2(kf,kp0+sl_cur,0);kload2(kf,kp0+sl_cur,1);}else kload8(kf,kp0+sl_cur);
  WAIT_BAR(2);
  s16x4 vlo[8],vhi[8]; u32x4 pw0,pw1,pw2,pw3;
  #define PKW(P,B) cvtpk_s(P[B],P[B+1])
  #define PAF(k) __builtin_bit_cast(bf16x8,pw##k)
  #define VFR(i) (bf16x8){vlo[i][0],vlo[i][1],vlo[i][2],vlo[i][3],vhi[i][0],vhi[i][1],vhi[i][2],vhi[i][3]}
  #define PIN(x) asm volatile("":"+v"(x))
  #define MX3(a,b,c) __builtin_fmaxf(__builtin_fmaxf((a),(b)),(c))
  #define GAPA(MF,A0,A1,A2,A3,W0,W1,PW) do{ MF; sacc+=A0; sacc+=A1; sacc+=A2; sacc+=A3; PIN(sacc); W0; W1; PIN(PW); SBAR(); }while(0)
  #define EX(v) __builtin_amdgcn_exp2f(v)
  #define GAPB(MF,X,B) do{ MF; X[B]=EX(X[B]); X[B+1]=EX(X[B+1]); X[B+2]=EX(X[B+2]); X[B+3]=EX(X[B+3]); PIN(X); SBAR(); }while(0)
  #define VRD(i) do{ vlo[i]=vtr(vp_+(((i)>>2)*4096+((i)&3)*1024)); vhi[i]=vtr(vp_+(((i)>>2)*4096+((i)&3)*1024+512)); }while(0)
  #define KRD(G,j) do{ if(G){ kload2(kf,kp0+sl_next,j); SBAR(); } }while(0)
  #define STEP(C0,C1,P0,P1,t,GK,GV,GL) do{ SBAR(); \
    const lds_cptr vp_=vp0+sl_prev; \
    VRD(0); SBAR(); float sacc=(P0[0]+P0[1]); \
    GAPA(C0=__builtin_amdgcn_mfma_f32_32x32x16_bf16(kf[0],qr[0],negm,0,0,0), P0[2],P0[3],P0[4],P0[5],     pw0[0]=PKW(P0,0), pw0[1]=PKW(P0,2), pw0); \
    VRD(4); SBAR(); GAPA(C1=__builtin_amdgcn_mfma_f32_32x32x16_bf16(kf[1],qr[0],negm,0,0,0), P0[6],P0[7],P0[8],P0[9],     pw0[2]=PKW(P0,4), pw0[3]=PKW(P0,6), pw0); \
    VRD(1); SBAR(); GAPA(C0=__builtin_amdgcn_mfma_f32_32x32x16_bf16(kf[2],qr[1],C0,0,0,0),   P0[10],P0[11],P0[12],P0[13], pw1[0]=PKW(P0,8), pw1[1]=PKW(P0,10), pw1); \
    VRD(5); SBAR(); GAPA(C1=__builtin_amdgcn_mfma_f32_32x32x16_bf16(kf[3],qr[1],C1,0,0,0),   P0[14],P0[15],P1[0],P1[1],   pw1[2]=PKW(P0,12),pw1[3]=PKW(P0,14), pw1); \
    VRD(2); SBAR(); GAPA(if constexpr(!HALFK)C0=__builtin_amdgcn_mfma_f32_32x32x16_bf16(kf[4],qr[2],C0,0,0,0),   P1[2],P1[3],P1[4],P1[5],     pw2[0]=PKW(P1,0), pw2[1]=PKW(P1,2), pw2); \
    VRD(6); SBAR(); GAPA(if constexpr(!HALFK)C1=__builtin_amdgcn_mfma_f32_32x32x16_bf16(kf[5],qr[2],C1,0,0,0),   P1[6],P1[7],P1[8],P1[9],     pw2[2]=PKW(P1,4), pw2[3]=PKW(P1,6), pw2); \
    VRD(3); SBAR(); GAPA(if constexpr(!HALFK)C0=__builtin_amdgcn_mfma_f32_32x32x16_bf16(kf[6],qr[3],C0,0,0,0),   P1[10],P1[11],P1[12],P1[13], pw3[0]=PKW(P1,8), pw3[1]=PKW(P1,10), pw3); \
    VRD(7); SBAR(); GAPA(if constexpr(!HALFK)C1=__builtin_amdgcn_mfma_f32_32x32x16_bf16(kf[7],qr[3],C1,0,0,0),   P1[14],P1[15],0.f,0.f,       pw3[2]=PKW(P1,12),pw3[3]=PKW(P1,14), pw3); \
    l_reg+=sacc; \
    if(GK){DMA_K((t)+3,sl_cur);} if(GV){DMA_V((t)+1,sl_next);} \
    CMASK(C0,C1,t); \
    if constexpr(!NOMAX){ float a=MX3(C0[0],C0[1],C1[0]),b=MX3(C0[2],C0[3],C1[1]); a=MX3(a,C1[2],C1[3]); \
      _Pragma("unroll") for(int r=4;r<16;r+=4){a=MX3(a,C0[r],C0[r+1]);b=MX3(b,C0[r+2],C0[r+3]);a=MX3(a,C1[r],C1[r+1]);b=MX3(b,C1[r+2],C1[r+3]);} \
      float rm=__builtin_fmaxf(a,b); { auto rr=__builtin_amdgcn_permlane32_swap(__float_as_uint(rm),__float_as_uint(rm),false,false); rm=__builtin_fmaxf(__uint_as_float(rr[0]),__uint_as_float(rr[1])); } \
      resc=false; \
      if(__builtin_expect(__any(rm>(float)THRL),0)){ const float dl=__builtin_fmaxf(rm,0.f); mhat+=dl; \
        _Pragma("unroll") for(int r=0;r<16;++r){C0[r]-=dl;C1[r]-=dl;} \
        _Pragma("unroll") for(int r=0;r<16;++r)negm[r]=-mhat; asm volatile("":"+v"(negm)); \
        const float f=__builtin_amdgcn_exp2f(-dl); l_reg*=f; if(hi==0)wsf[r32]=f; resc=true; } } \
    SBAR(); \
    GAPB(o[0]=__builtin_amdgcn_mfma_f32_32x32x16_bf16(PAF(0),VFR(0),o[0],0,0,0), C0,0); \
    GAPB(o[1]=__builtin_amdgcn_mfma_f32_32x32x16_bf16(PAF(0),VFR(4),o[1],0,0,0), C0,4); \
    KRD(GL,0); GAPB(o[0]=__builtin_amdgcn_mfma_f32_32x32x16_bf16(PAF(1),VFR(1),o[0],0,0,0), C0,8); \
    KRD(GL,1); GAPB(o[1]=__builtin_amdgcn_mfma_f32_32x32x16_bf16(PAF(1),VFR(5),o[1],0,0,0), C0,12); \
    KRD(GL&&!HALFK,2); GAPB(o[0]=__builtin_amdgcn_mfma_f32_32x32x16_bf16(PAF(2),VFR(2),o[0],0,0,0), C1,0); \
    KRD(GL&&!HALFK,3); GAPB(o[1]=__builtin_amdgcn_mfma_f32_32x32x16_bf16(PAF(2),VFR(6),o[1],0,0,0), C1,4); \
    GAPB(o[0]=__builtin_amdgcn_mfma_f32_32x32x16_bf16(PAF(3),VFR(3),o[0],0,0,0), C1,8); \
    GAPB(o[1]=__builtin_amdgcn_mfma_f32_32x32x16_bf16(PAF(3),VFR(7),o[1],0,0,0), C1,12); \
    }while(0)
  if(wid>=4)__builtin_amdgcn_s_setprio(1);
  int t=1;
  #undef CMASK
  #define CMASK(P0,P1,t) do{}while(0)
  for(;t+5<NT;t+=2){
    STEP(pB0,pB1,pA0,pA1,t,true,true,true);     WAIT_BAR(2); RESC(); ROT();
    STEP(pA0,pA1,pB0,pB1,t+1,true,true,true);   WAIT_BAR(2); RESC(); ROT();
  }
  #undef CMASK
  #define CMASK(P0,P1,t) do{}while(0)
  #define ENDW(tt) do{ if((tt)+3<NT){WAIT_BAR(2);} else if((tt)+2<NT){WAIT_BAR(1);} else {WAIT_BAR(0);} }while(0)
  for(;t+1<NT;t+=2){
    STEP(pB0,pB1,pA0,pA1,t,(t+3<NT),(t+1<NT),(t+1<NT));       ENDW(t);   RESC(); ROT();
    STEP(pA0,pA1,pB0,pB1,t+1,(t+4<NT),(t+2<NT),(t+2<NT));     ENDW(t+1); RESC(); ROT();
  }
  STEP(pB0,pB1,pA0,pA1,NT-1,false,false,false); RESC();
  if(Knext){ const bf16*kn=Knext+(long)lane*KPITCH+wid*8;
    glds16(kn,(unsigned)__builtin_amdgcn_readfirstlane(kdst)); glds16(kn+(long)KVBLK*KPITCH,(unsigned)__builtin_amdgcn_readfirstlane(kdst+SLOTB)); glds16(kn+(long)2*KVBLK*KPITCH,(unsigned)__builtin_amdgcn_readfirstlane(kdst+2*SLOTB)); }
  { float sacc=pB0[0]+pB0[1]; _Pragma("unroll") for(int r=2;r<16;++r)sacc+=pB0[r]; _Pragma("unroll") for(int r=0;r<16;++r)sacc+=pB1[r]; l_reg+=sacc;
    pw0=(u32x4){PKW(pB0,0),PKW(pB0,2),PKW(pB0,4),PKW(pB0,6)};pw1=(u32x4){PKW(pB0,8),PKW(pB0,10),PKW(pB0,12),PKW(pB0,14)};pw2=(u32x4){PKW(pB1,0),PKW(pB1,2),PKW(pB1,4),PKW(pB1,6)};pw3=(u32x4){PKW(pB1,8),PKW(pB1,10),PKW(pB1,12),PKW(pB1,14)};
    SBAR(); pv(o,vb0+sl_cur,PAF(0),PAF(1),PAF(2),PAF(3)); }
  #undef PKW
  #undef PAF
  #undef VFR
  #undef PIN
  #undef MX3
  #undef GAPA
  #undef GAPB
  #undef EX
  #undef VRD
  #undef KRD
  #undef STEP
  #undef ENDW
  __builtin_amdgcn_s_setprio(0);
  {auto rr=__builtin_amdgcn_permlane32_swap(__float_as_uint(l_reg),__float_as_uint(l_reg),false,false);l_reg=__uint_as_float(rr[0])+__uint_as_float(rr[1]);}
  if(hi==0)wsf[32+r32]=l_reg;asm volatile("s_waitcnt lgkmcnt(0)":::"memory");
  float rli[16];
  #pragma unroll
  for(int r=0;r<16;++r)rli[r]=__builtin_amdgcn_rcpf(wsf[32+crow(r,hi)]);
  bf16*Ow=Ou+(long)(wid*QBLK)*OPITCH;
  { bf16*stg=(bf16*)(shm+LDS_OST)+wid*2048;
    #pragma unroll
    for(int r=0;r<16;++r){const int orow=crow(r,hi);
      #pragma unroll
      for(int d0=0;d0<2;++d0)stg[orow*64+d0*32+r32]=__float2bfloat16(o[d0][r]*rli[r]);}
    asm volatile("s_waitcnt lgkmcnt(0)":::"memory");
    #pragma unroll
    for(int i=0;i<4;++i){const int row=i*8+(lane>>3),ch=lane&7; const u32x4 v=*(const u32x4*)(stg+row*64+ch*8); ATTN_STORE16(Ow+(long)row*OPITCH+ch*8,v);} }
  asm volatile("s_waitcnt lgkmcnt(0)\n\ts_barrier":::"memory");
  #undef DMA_K
  #undef DMA_V
  #undef CMASK
  #undef START
  #undef RESC
  #undef ROT
}
constexpr int ATTN_LDS_BYTES=LDS_BYTES;
#undef SBAR
#undef WAIT_BAR
}
namespace pg8 {
#define PG8_LAS __attribute__((address_space(3)))
typedef unsigned short bf16_t;
typedef short bf16x8 __attribute__((ext_vector_type(8)));
typedef float f32x4 __attribute__((ext_vector_type(4)));
typedef unsigned u32x4 __attribute__((ext_vector_type(4)));
constexpr int BM = 256, BK = 64, HALF = 128, HTB = HALF * BK * 2  , STAGE_BYTES = 8 * HTB, NXCD = 8, WGM = 8;

__host__ __device__ __forceinline__ int lds_byte(int r, int c) { const int st = (r >> 4) * 2 + (c >> 5), rr = r & 15, cc = c & 31, ob = rr * 64 + cc * 2; return st * 1024 + (ob ^ (((ob >> 9) & 1) << 5)); }
__host__ __device__ __forceinline__ void stage_rc(int b, int& R, int& C) { const int st = b / 1024, sb = b % 1024, swz = sb ^ (((sb >> 9) & 1) << 5); R = (st >> 1) * 16 + swz / 64; C = (st & 1) * 32 + (swz % 64) / 2; }
__host__ __device__ __forceinline__ int perm32(int rho) { const int n = rho >> 4, i = rho & 15; return 8 * (i >> 2) + 4 * n + (i & 3); }

struct Unit { int pm, pn, aux; };
__device__ __forceinline__ unsigned cvt_pk_bf16(float lo, float hi) { unsigned r; asm volatile("v_cvt_pk_bf16_f32 %0, %1, %2" : "=v"(r) : "v"(lo), "v"(hi)); return r; }
typedef float f32x2 __attribute__((ext_vector_type(2)));
template <class Epi, class Sched, bool ALIGN_EPI = false, bool SP2 = false>
__device__ __forceinline__ void gemm_phase(PG8_LAS unsigned char* lds, const int K, const Sched& S, const Epi& E) {
    int tid_l = threadIdx.x; asm volatile("" : "+v"(tid_l));
    const int tid = tid_l, wid = __builtin_amdgcn_readfirstlane(tid >> 6), lane = tid & 63, wr = wid >> 2, wc = wid & 3, fr = lane & 15, fq = lane >> 4;
    const int nt = K / BK;
    unsigned voffB[2]; int stR[2], stC[2];
#pragma unroll
    for (int i = 0; i < 2; ++i) { int R, C; stage_rc(tid * 16 + i * 8192, R, C); const int Rb = Epi::PERM ? ((R & ~31) + perm32(R & 31)) : R;
        stR[i] = R; stC[i] = C; voffB[i] = (unsigned)(Rb * K + C) * 2u; }
    const size_t kstep = (size_t)(BK * 2);
    const size_t hstep = (size_t)HALF * K * 2;
    const unsigned ldsw = (unsigned)wid * 1024u;
    const int aoff = lds_byte(wr * 64 + fr, fq * 8), boff = lds_byte(wc * 32 + fr, fq * 8);
#define PG8_SA(b, h) (((b) * 2 + (h)) * HTB)
#define PG8_SB(b, h) ((4 + (b) * 2 + (h)) * HTB)
#define PG8_STAGE(bufoff, gbase, voff) do { _Pragma("unroll") for (int _i = 0; _i < 2; ++_i) \
        __builtin_amdgcn_global_load_lds((const unsigned*)((const char*)(gbase) + (voff)[_i]), (PG8_LAS unsigned*)(lds + (bufoff) + ldsw + _i * 8192), 16, 0, 0); } while (0)
#define PG8_LDA(dst, b, h) do { _Pragma("unroll") for (int m = 0; m < 4; ++m) _Pragma("unroll") for (int k = 0; k < 2; ++k) dst[m][k] = *(const PG8_LAS bf16x8*)(lds + PG8_SA(b, h) + aoff + m * 2048 + k * 1024); } while (0)
#define PG8_LDB(dst, b, h) do { _Pragma("unroll") for (int n = 0; n < 2; ++n) _Pragma("unroll") for (int k = 0; k < 2; ++k) dst[n][k] = *(const PG8_LAS bf16x8*)(lds + PG8_SB(b, h) + boff + n * 2048 + k * 1024); } while (0)
#define PG8_MMA(ai, bj, At, Bt) do { __builtin_amdgcn_s_setprio(1); _Pragma("unroll") for (int m = 0; m < 4; ++m) _Pragma("unroll") for (int n = 0; n < 2; ++n) _Pragma("unroll") for (int k = 0; k < 2; ++k) \
        acc[ai][bj][m][n] = __builtin_amdgcn_mfma_f32_16x16x32_bf16(Bt[n][k], At[m][k], acc[ai][bj][m][n], 0, 0, 0); __builtin_amdgcn_s_setprio(0); } while (0)
#define PG8_WAIT_V(n) asm volatile("s_waitcnt vmcnt(" #n ")" ::: "memory")
#define PG8_WAIT_L(n) asm volatile("s_waitcnt lgkmcnt(" #n ")" ::: "memory")
#define PG8_BAR __builtin_amdgcn_s_barrier()
#define PG8_SCHED __builtin_amdgcn_sched_barrier(0)
    Unit cur, nxt; int ui = 0;
    if (!S.next(0, cur)) return;
    f32x4 acc[2][2][4][2];
#pragma unroll
    for (int a = 0; a < 2; ++a)
#pragma unroll
        for (int b = 0; b < 2; ++b)
#pragma unroll
            for (int m = 0; m < 4; ++m)
#pragma unroll
                for (int n = 0; n < 2; ++n) acc[a][b][m][n] = (f32x4){0.f, 0.f, 0.f, 0.f};
    bf16x8 At[4][2], B0[2][2], B1[2][2];
    const char* cA = S.a_ptr(cur); const char* cB = S.b_ptr(cur);
    unsigned cv0[2], cv1[2]; S.a_offs(cur, stR, stC, cv0, cv1);
    S.a_ready(cur);
    if constexpr (SP2) {
        PG8_STAGE(PG8_SB(0, 0), cB, voffB); PG8_STAGE(PG8_SB(0, 1), cB + hstep, voffB); PG8_STAGE(PG8_SA(0, 0), cA, cv0); PG8_STAGE(PG8_SA(0, 1), cA, cv1);
        if (wr == 1) PG8_BAR;
        PG8_WAIT_V(2); PG8_BAR;
        PG8_STAGE(PG8_SB(1, 0), cB + kstep, voffB); PG8_STAGE(PG8_SA(1, 0), cA + kstep, cv0); PG8_STAGE(PG8_SB(1, 1), cB + hstep + kstep, voffB);
        PG8_WAIT_V(6); PG8_BAR;
    } else {
        PG8_STAGE(PG8_SB(0, 0), cB, voffB); PG8_STAGE(PG8_SA(0, 0), cA, cv0); PG8_STAGE(PG8_SB(0, 1), cB + hstep, voffB); PG8_STAGE(PG8_SA(0, 1), cA, cv1);
        if (wr == 1) PG8_BAR;
        PG8_WAIT_V(4); PG8_BAR;
        PG8_STAGE(PG8_SB(1, 0), cB + kstep, voffB); PG8_STAGE(PG8_SA(1, 0), cA + kstep, cv0); PG8_STAGE(PG8_SB(1, 1), cB + hstep + kstep, voffB);
        PG8_WAIT_V(6); PG8_BAR;
    }
    for (;;) {
        const bool has_next = S.next(ui + 1, nxt);
        const char* nA = has_next ? S.a_ptr(nxt) : cA; const char* nB = has_next ? S.b_ptr(nxt) : cB;
        for (int t = 0; t < nt; t += 2) {
            const bool last = (t == nt - 2);
            const char* a1 = cA + (size_t)(t + 1) * kstep;
            const char* a2 = last ? nA : cA + (size_t)(t + 2) * kstep; const char* b2 = last ? nB : cB + (size_t)(t + 2) * kstep;
            const char* a3 = a2 + kstep; const char* b3 = b2 + kstep;
            unsigned c0_[2], c1[2], x0[2], x1[2];
            { int rr[2] = {stR[0], stR[1]}; asm volatile("" : "+v"(rr[0]), "+v"(rr[1])); Unit cu = cur, xu = (last && has_next) ? nxt : cur; asm volatile("" : "+s"(cu.aux), "+s"(xu.aux));
              S.a_offs(cu, rr, stC, c0_, c1); S.a_offs(xu, rr, stC, x0, x1); }
            if (last && has_next) S.a_ready(nxt);
            if constexpr (SP2) {
            PG8_LDB(B0, 0, 0); PG8_LDB(B1, 0, 1); PG8_SCHED; PG8_LDA(At, 0, 0); PG8_STAGE(PG8_SA(1, 1), a1, c1);
            PG8_WAIT_V(8); PG8_WAIT_L(0); PG8_BAR; PG8_MMA(0, 0, At, B0); PG8_MMA(0, 1, At, B1); PG8_BAR; PG8_SCHED;
            PG8_LDA(At, 0, 1); PG8_STAGE(PG8_SB(0, 0), b2, voffB); PG8_STAGE(PG8_SB(0, 1), b2 + hstep, voffB); PG8_STAGE(PG8_SA(0, 0), a2, x0);
            PG8_WAIT_V(8); PG8_WAIT_L(0); PG8_BAR; PG8_MMA(1, 0, At, B0); PG8_MMA(1, 1, At, B1); PG8_BAR; PG8_SCHED;
            PG8_LDB(B0, 1, 0); PG8_LDB(B1, 1, 1); PG8_SCHED; PG8_LDA(At, 1, 0); PG8_STAGE(PG8_SA(0, 1), a2, x1);
            PG8_WAIT_V(8); PG8_WAIT_L(0); PG8_BAR; PG8_MMA(0, 0, At, B0); PG8_MMA(0, 1, At, B1); PG8_BAR; PG8_SCHED;
            PG8_LDA(At, 1, 1); PG8_STAGE(PG8_SB(1, 0), b3, voffB); PG8_STAGE(PG8_SB(1, 1), b3 + hstep, voffB); PG8_STAGE(PG8_SA(1, 0), a3, x0);
            PG8_WAIT_V(8); PG8_WAIT_L(0); PG8_BAR; PG8_MMA(1, 0, At, B0); PG8_MMA(1, 1, At, B1); PG8_BAR; PG8_SCHED;
            } else {
            PG8_LDB(B0, 0, 0); PG8_SCHED; PG8_LDA(At, 0, 0); PG8_STAGE(PG8_SA(1, 1), a1, c1);
            PG8_WAIT_L(8); PG8_BAR; PG8_WAIT_L(0); PG8_MMA(0, 0, At, B0); PG8_BAR; PG8_SCHED;
            PG8_LDB(B1, 0, 1); PG8_STAGE(PG8_SB(0, 0), b2, voffB);
            PG8_BAR; PG8_WAIT_L(0); PG8_MMA(0, 1, At, B1); PG8_BAR;
            PG8_LDA(At, 0, 1); PG8_STAGE(PG8_SA(0, 0), a2, x0);
            PG8_BAR; PG8_WAIT_L(0); PG8_MMA(1, 0, At, B0); PG8_BAR; PG8_SCHED;
            PG8_STAGE(PG8_SB(0, 1), b2 + hstep, voffB);
            PG8_WAIT_V(6); PG8_BAR; PG8_MMA(1, 1, At, B1); PG8_BAR;
            PG8_LDB(B0, 1, 0); PG8_SCHED; PG8_LDA(At, 1, 0); PG8_STAGE(PG8_SA(0, 1), a2, x1);
            PG8_WAIT_L(8); PG8_BAR; PG8_WAIT_L(0); PG8_MMA(0, 0, At, B0); PG8_BAR; PG8_SCHED;
            PG8_LDB(B1, 1, 1); PG8_STAGE(PG8_SB(1, 0), b3, voffB);
            PG8_BAR; PG8_WAIT_L(0); PG8_MMA(0, 1, At, B1); PG8_BAR;
            PG8_LDA(At, 1, 1); PG8_STAGE(PG8_SA(1, 0), a3, x0);
            PG8_BAR; PG8_WAIT_L(0); PG8_MMA(1, 0, At, B0); PG8_BAR; PG8_SCHED;
            PG8_STAGE(PG8_SB(1, 1), b3 + hstep, voffB);
            PG8_WAIT_V(6); PG8_BAR; PG8_MMA(1, 1, At, B1); PG8_BAR;
            }
        }
        if constexpr (ALIGN_EPI) { if (wr == 0) PG8_BAR; }
        if constexpr (!Epi::AFTER_DRAIN) { E(acc, cur, wr, wc, fr, fq); S.done(cur); }
        if (!has_next) break;
#pragma unroll
        for (int a = 0; a < 2; ++a)
#pragma unroll
            for (int b = 0; b < 2; ++b)
#pragma unroll
                for (int m = 0; m < 4; ++m)
#pragma unroll
                    for (int n = 0; n < 2; ++n) acc[a][b][m][n] = (f32x4){0.f, 0.f, 0.f, 0.f};
        cur = nxt; cA = nA; cB = nB; ++ui;
        if constexpr (ALIGN_EPI) { if (wr == 1) PG8_BAR; }
    }
    PG8_WAIT_V(0);
    if constexpr (!ALIGN_EPI) { if (wr == 0) PG8_BAR; }
    PG8_BAR;
    if constexpr (Epi::AFTER_DRAIN) { E.fused(acc, cur, wr, wc, fr, fq, lds, wid, lane); S.done(cur); }
#undef PG8_SA
#undef PG8_SB
#undef PG8_STAGE
#undef PG8_LDA
#undef PG8_LDB
#undef PG8_MMA
#undef PG8_WAIT_V
#undef PG8_WAIT_L
#undef PG8_BAR
#undef PG8_SCHED
}
}
namespace pg8 {
struct DenseOrder {
    const char* A; const char* Bt; int K; int nM, nN, nwg, G, c;
    __device__ __forceinline__ void init(const void* A_, const void* Bt_, int M, int N, int K_, int G_, int c_) { A = (const char*)A_; Bt = (const char*)Bt_; K = K_; nM = M / BM; nN = N / BM; nwg = nM * nN; G = G_; c = c_; }
    __device__ __forceinline__ bool next(int i, Unit& u) const {
        const long L = (long)i * G + c; if (L >= nwg) return false;
        int wgid = (int)L; { const int q = nwg / NXCD, r = nwg % NXCD, xcd = wgid % NXCD, off = wgid / NXCD; wgid = (xcd < r ? xcd * (q + 1) : r * (q + 1) + (xcd - r) * q) + off; }
        const int nig = WGM * nN, gid = wgid / nig, fm = gid * WGM, gsz = (nM - fm) < WGM ? (nM - fm) : WGM;
        u.pm = fm + ((wgid % nig) % gsz); u.pn = (wgid % nig) / gsz; u.aux = i; return true;
    }
    __device__ __forceinline__ const char* a_ptr(const Unit& u) const { return A + (size_t)u.pm * BM * K * 2; }
    __device__ __forceinline__ const char* b_ptr(const Unit& u) const { return Bt + (size_t)u.pn * BM * K * 2; }
    __device__ __forceinline__ void a_offs(const Unit&, const int (&R)[2], const int (&C)[2], unsigned (&v0)[2], unsigned (&v1)[2]) const {
#pragma unroll
        for (int i = 0; i < 2; ++i) { v0[i] = (unsigned)(R[i] * K + C[i]) * 2u; v1[i] = v0[i] + (unsigned)(HALF * K * 2); } }
    __device__ __forceinline__ void a_ready(const Unit&) const {}
    __device__ __forceinline__ void done(const Unit&) const {}
};
struct EpiF32 {
    static constexpr bool PERM = false, AFTER_DRAIN = false;
    float* C; int ldc;
    __device__ __forceinline__ void operator()(const f32x4 (&acc)[2][2][4][2], const Unit& u, int wr, int wc, int fr, int fq) const {
        const int row0 = u.pm * BM + wr * 64 + fr, col0 = u.pn * BM + wc * 32 + 4 * fq;
#pragma unroll
        for (int ai = 0; ai < 2; ++ai)
#pragma unroll
            for (int m = 0; m < 4; ++m) { float* rowp = C + (size_t)(row0 + ai * HALF + m * 16) * ldc + col0;
#pragma unroll
                for (int bj = 0; bj < 2; ++bj)
#pragma unroll
                    for (int n = 0; n < 2; ++n) *(f32x4*)(rowp + bj * HALF + n * 16) = acc[ai][bj][m][n]; }
    }
};
struct EpiBf16Plain {
    static constexpr bool PERM = true, AFTER_DRAIN = false;
    bf16_t* O; int ldc;
    __device__ __forceinline__ void operator()(const f32x4 (&acc)[2][2][4][2], const Unit& u, int wr, int wc, int fr, int fq) const {
        const int row0 = u.pm * BM + wr * 64 + fr, col0 = u.pn * BM + wc * 32 + 8 * fq;
#pragma unroll
        for (int ai = 0; ai < 2; ++ai)
#pragma unroll
            for (int m = 0; m < 4; ++m) { bf16_t* rowp = O + (size_t)(row0 + ai * HALF + m * 16) * ldc + col0;
#pragma unroll
                for (int bj = 0; bj < 2; ++bj) { const f32x4 v0 = acc[ai][bj][m][0], v1 = acc[ai][bj][m][1];
                    u32x4 w; w.x = cvt_pk_bf16(v0[0], v0[1]); w.y = cvt_pk_bf16(v0[2], v0[3]); w.z = cvt_pk_bf16(v1[0], v1[1]); w.w = cvt_pk_bf16(v1[2], v1[3]);
                    *(u32x4*)(rowp + bj * HALF) = w; } }
    }
};
}
namespace pg8 {
constexpr int MOE_MAXU = 3;
typedef int i32x16 __attribute__((ext_vector_type(16)));
typedef unsigned u32x16 __attribute__((ext_vector_type(16)));
struct MoePlan {
    i32x16 toff, cnt; int TT;
    __device__ __forceinline__ void init(const int* cntp) { int acc = 0;
#pragma unroll
        for (int q = 0; q < N_EXP; ++q) { const int cq = __builtin_amdgcn_readfirstlane(cntp[q * CNT_STRIDE]); cnt[q] = cq; toff[q] = acc; acc += (cq + BM - 1) / BM; }
        TT = acc; }
    __device__ __forceinline__ void decode(int pm, int& e, int& lt, int& ce) const { int ee = 0, base = 0, cc = cnt[0];
#pragma unroll
        for (int q = 1; q < N_EXP; ++q) { const bool ge = pm >= toff[q]; ee = ge ? q : ee; base = ge ? toff[q] : base; cc = ge ? cnt[q] : cc; }
        e = ee; lt = pm - base; ce = cc; }
};
struct MoeOrder {
    const char* A; const char* W; const int* slottok; int K; size_t wexp; int nN, TT, nwg, G, c; bool gather;
    MoePlan pl;
    u32x16 goff;
    __device__ __forceinline__ bool next(int i, Unit& u) const {
        const long L = (long)i * G + c; if (L >= nwg) return false;
        int wgid = (int)L; { const int q = nwg / NXCD, r = nwg % NXCD, xcd = wgid % NXCD, off = wgid / NXCD; wgid = (xcd < r ? xcd * (q + 1) : r * (q + 1) + (xcd - r) * q) + off; }
        const int nig = WGM * nN, gid = wgid / nig, fm = gid * WGM, gsz = (TT - fm) < WGM ? (TT - fm) : WGM;
        u.pm = fm + ((wgid % nig) % gsz); u.pn = (wgid % nig) / gsz; u.aux = i; return true;
    }
    __device__ __forceinline__ void init(const void* A_, const void* W_, const int* cntp, const int* slottok_, int N, int K_, bool gather_, int G_, int c_) {
        A = (const char*)A_; W = (const char*)W_; slottok = slottok_; K = K_; wexp = (size_t)N * K_ * 2; nN = N / BM; G = G_; c = c_; gather = gather_;
        pl.init(cntp); TT = pl.TT; nwg = TT * nN;
        if (gather) {
            int tid_l = threadIdx.x; asm volatile("" : "+v"(tid_l));
#pragma unroll
            for (int ui = 0; ui < MOE_MAXU; ++ui) { Unit u; u.pm = 0; u.pn = 0; u.aux = 0; const bool ok = next(ui, u); int e, lt, ce; pl.decode(ok ? u.pm : 0, e, lt, ce);
#pragma unroll
                for (int i = 0; i < 2; ++i) { int R, C; stage_rc(tid_l * 16 + i * 8192, R, C);
#pragma unroll
                    for (int h = 0; h < 2; ++h) { int slot = lt * BM + h * HALF + R; if (slot >= ce) slot = 0;
                        const int tok2 = ok ? slottok[(size_t)e * NROW + slot] : 0;
                        goff[ui * 4 + h * 2 + i] = (unsigned)((tok2 >> 1) * K + C) * 2u; } } }
        }
    }
    __device__ __forceinline__ const char* a_ptr(const Unit& u) const { return gather ? A : A + (size_t)u.pm * BM * K * 2; }
    __device__ __forceinline__ const char* b_ptr(const Unit& u) const { int e, lt, ce; pl.decode(u.pm, e, lt, ce); return W + (size_t)e * wexp + (size_t)u.pn * BM * K * 2; }
    __device__ __forceinline__ void a_offs(const Unit& u, const int (&R)[2], const int (&C)[2], unsigned (&v0)[2], unsigned (&v1)[2]) const {
        if (gather) {
#pragma unroll
            for (int i = 0; i < 2; ++i) { unsigned a = goff[i], b = goff[2 + i];
#pragma unroll
                for (int q = 1; q < MOE_MAXU; ++q) { const bool is = (u.aux == q); a = is ? goff[q * 4 + i] : a; b = is ? goff[q * 4 + 2 + i] : b; }
                v0[i] = a; v1[i] = b; }
        } else {
#pragma unroll
            for (int i = 0; i < 2; ++i) { v0[i] = (unsigned)(R[i] * K + C[i]) * 2u; v1[i] = v0[i] + (unsigned)(HALF * K * 2); } }
    }
    __device__ __forceinline__ void a_ready(const Unit&) const {}
    __device__ __forceinline__ void done(const Unit&) const {}
};
struct EpiSwiGLU {
    static constexpr bool PERM = true, AFTER_DRAIN = false;
    bf16_t* HMp;
    __device__ __forceinline__ void operator()(const f32x4 (&acc)[2][2][4][2], const Unit& u, int wr, int wc, int fr, int fq) const {
        const int row0 = u.pm * BM + wr * 64 + fr, col0 = u.pn * HALF + wc * 32 + 8 * fq;
#pragma unroll
        for (int ai = 0; ai < 2; ++ai)
#pragma unroll
            for (int m = 0; m < 4; ++m) { bf16_t* rowp = HMp + (size_t)(row0 + ai * HALF + m * 16) * EXP_FF + col0;
                float h[8];
#pragma unroll
                for (int n = 0; n < 2; ++n)
#pragma unroll
                    for (int j = 0; j < 4; ++j) { const float g = acc[ai][0][m][n][j], uu = acc[ai][1][m][n][j]; h[n * 4 + j] = g * __builtin_amdgcn_rcpf(1.f + __expf(-g)) * uu; }
                u32x4 w; w.x = cvt_pk_bf16(h[0], h[1]); w.y = cvt_pk_bf16(h[2], h[3]); w.z = cvt_pk_bf16(h[4], h[5]); w.w = cvt_pk_bf16(h[6], h[7]);
                *(u32x4*)rowp = w; }
    }
};
struct EpiMoeDown {
    static constexpr bool PERM = true, AFTER_DRAIN = false;
    bf16_t* FOp; const float* TGp; const int* slottok; MoePlan pl;
    __device__ __forceinline__ void operator()(const f32x4 (&acc)[2][2][4][2], const Unit& u, int wr, int wc, int fr, int fq) const {
        int e, lt, ce; pl.decode(u.pm, e, lt, ce);
        const int col0 = u.pn * BM + wc * 32 + 8 * fq;
#pragma unroll
        for (int ai = 0; ai < 2; ++ai)
#pragma unroll
            for (int m = 0; m < 4; ++m) { const int slot = lt * BM + ai * HALF + wr * 64 + m * 16 + fr;
                if (slot < ce) { const int tok2 = slottok[(size_t)e * NROW + slot]; const float gate = TGp[tok2];
                    bf16_t* rowp = FOp + (size_t)tok2 * D_MODEL + col0;
#pragma unroll
                    for (int bj = 0; bj < 2; ++bj) { const f32x4 v0 = acc[ai][bj][m][0] * gate, v1 = acc[ai][bj][m][1] * gate;
                        u32x4 w; w.x = cvt_pk_bf16(v0[0], v0[1]); w.y = cvt_pk_bf16(v0[2], v0[3]); w.z = cvt_pk_bf16(v1[0], v1[1]); w.w = cvt_pk_bf16(v1[2], v1[3]);
                        *(u32x4*)(rowp + bj * HALF) = w; } } }
    }
};
}
namespace pg8 {
static_assert(IN_W == 8 * BM && LRU_W == BM && GQA_H == 8 && GQA_KV == 2 && DIFF_H == 4 && NLAT % BM == 0 && CTX_LEN == BM, "EpiInProj is written for this problem's column partition");
struct EpiInProj {
    static constexpr bool PERM = true, AFTER_DRAIN = false;
    float* AX; float* GA; bf16_t* ZQ; bf16_t* ZK; bf16_t* ZV; const float* qg; const float* kg;
    int* nb;
    __device__ __forceinline__ void operator()(const f32x4 (&acc)[2][2][4][2], const Unit& u, int wr, int wc, int fr, int fq) const {
        const int pn = u.pn, pm = u.pm;
        const bool lat = pm < NLAT / BM;
        const int b = lat ? pm / (SEQ / BM) : pm - NLAT / BM;
        const int rt0 = wr * 64 + fr;
        const int t0 = lat ? (pm % (SEQ / BM)) * BM : 0;
        const size_t kbase = (size_t)b * SKEY + (lat ? CTX_LEN + t0 : 0);
        const size_t row_base = (size_t)pm * BM;
        if (pn < 2) {
            float* dst = pn == 0 ? AX : GA;
#pragma unroll
            for (int ai = 0; ai < 2; ++ai)
#pragma unroll
                for (int m = 0; m < 4; ++m) { float* rowp = dst + (row_base + rt0 + ai * HALF + m * 16) * LRU_W + wc * 32 + 8 * fq;
#pragma unroll
                    for (int bj = 0; bj < 2; ++bj)
#pragma unroll
                        for (int n = 0; n < 2; ++n) { f32x4 v = acc[ai][bj][m][n];
                            if (pn == 1) {
#pragma unroll
                                for (int j = 0; j < 4; ++j) { const float x = v[j]; const float tt = 0.7978845608028654f * (x + 0.044715f * x * x * x); const float e2 = __expf(2.f * tt); v[j] = x - x * __builtin_amdgcn_rcpf(e2 + 1.f); } }
                            *(f32x4*)(rowp + bj * HALF + n * 4) = v; } }
            return;
        }
        const bool isq_g = (pn == 2 || pn == 3), is4 = (pn == 4), isdq = (pn == 5), isdk = (pn == 6), isdv = (pn == 7);
        const bool norm = isq_g || (is4 && wc < 2);
        const bool rope64 = norm && lat, rope32 = (isdq || isdk) && lat;
        const float* gains = isq_g ? qg : kg;
        float g16[2][8];
        if (norm) {
#pragma unroll
            for (int bj = 0; bj < 2; ++bj)
#pragma unroll
                for (int k = 0; k < 8; ++k) g16[bj][k] = gains[32 * bj + 8 * fq + k];
        }
        float inv[4]; bool usecol32 = false;
#pragma unroll
        for (int pp = 0; pp < 4; ++pp) {
            if (rope64) inv[pp] = exp2f(-(float)(4 * fq + pp) * (13.287712379549449f / 16.f));
            else { const int i = 4 * fq + pp; inv[pp] = exp2f(-(float)(i & 7) * (13.287712379549449f / 8.f)); }
        }
        usecol32 = fq >= 2;
        bf16_t* dbase; int dpitch; bool keyrow; float qs = 1.f; bool pad32 = false;
        if (isq_g) { dbase = ZQ + (4 * (pn - 2) + wc) * 64; dpitch = QP; keyrow = false; qs = QS_G; }
        else if (is4) { if (wc < 2) { dbase = ZK + wc * 64; dpitch = KP; } else { dbase = ZV + (wc - 2) * 64; dpitch = VP; } keyrow = true; }
        else if (isdq) { dbase = ZQ + (GQA_H + 2 * wc) * 64; dpitch = QP; keyrow = false; qs = QS_D; pad32 = true; }
        else if (isdk) { dbase = ZK + (GQA_KV + 2 * wc) * 64; dpitch = KP; keyrow = true; pad32 = true; }
        else { dbase = ZV + (GQA_KV + wc) * 64; dpitch = VP; keyrow = true; }
        (void)isdv;
        float nmx[2] = {0.f, 0.f};
#pragma unroll
        for (int ai = 0; ai < 2; ++ai)
#pragma unroll
            for (int m = 0; m < 4; ++m) {
                const int rin = rt0 + ai * HALF + m * 16;
                float v[2][8];
#pragma unroll
                for (int bj = 0; bj < 2; ++bj)
#pragma unroll
                    for (int n = 0; n < 2; ++n)
#pragma unroll
                        for (int j = 0; j < 4; ++j) v[bj][n * 4 + j] = acc[ai][bj][m][n][j];
                if (norm) { float ss = 0.f;
#pragma unroll
                    for (int bj = 0; bj < 2; ++bj)
#pragma unroll
                        for (int k = 0; k < 8; ++k) ss += v[bj][k] * v[bj][k];
                    ss = swap32_sum(swap16_sum(ss));
                    const float rs = 1.0f / sqrtf(ss * (1.f / 64.f) + 1e-6f);
#pragma unroll
                    for (int bj = 0; bj < 2; ++bj)
#pragma unroll
                        for (int k = 0; k < 8; ++k) v[bj][k] = v[bj][k] * rs * g16[bj][k]; }
                if (rope64 || rope32) { const int t = t0 + rin; const float prow = (float)(t / GRID_W), pcol = (float)(t % GRID_W);
#pragma unroll
                    for (int bj = 0; bj < 2; ++bj) { const float pos = rope64 ? (bj ? pcol : prow) : (usecol32 ? pcol : prow);
#pragma unroll
                        for (int pp = 0; pp < 4; ++pp) { const float ang = pos * inv[pp]; const float cs = __cosf(ang), sn = __sinf(ang);
                            const float x0 = v[bj][2 * pp], x1 = v[bj][2 * pp + 1]; v[bj][2 * pp] = x0 * cs - x1 * sn; v[bj][2 * pp + 1] = x0 * sn + x1 * cs; } } }
                if (pad32) {
#pragma unroll
                    for (int bj = 0; bj < 2; ++bj) { float ss = 0.f;
#pragma unroll
                        for (int k = 0; k < 8; ++k) ss += (v[bj][k] * qs) * (v[bj][k] * qs);
                        ss = swap32_sum(swap16_sum(ss)); nmx[bj] = fmaxf(nmx[bj], ss); } }
                bf16_t* rowp = dbase + (keyrow ? (kbase + rin) : (row_base + rin)) * (size_t)dpitch;
#pragma unroll
                for (int bj = 0; bj < 2; ++bj) { u32x4 w; w.x = cvt_pk_bf16(v[bj][0] * qs, v[bj][1] * qs); w.y = cvt_pk_bf16(v[bj][2] * qs, v[bj][3] * qs); w.z = cvt_pk_bf16(v[bj][4] * qs, v[bj][5] * qs); w.w = cvt_pk_bf16(v[bj][6] * qs, v[bj][7] * qs);
                    if (pad32) { bf16_t* q = rowp + bj * 64 + 8 * fq; *(u32x4*)q = w; unsigned z_ = 0u; asm volatile("" : "+v"(z_)); *(u32x4*)(q + 32) = (u32x4){z_, z_, z_, z_}; }
                    else *(u32x4*)(rowp + 32 * bj + 8 * fq) = w; }
            }
        if (pad32) {
#pragma unroll
            for (int bj = 0; bj < 2; ++bj) { float mxv = nmx[bj]; mxv = fmaxf(mxv, dpp_mov<DPP_XOR1>(mxv)); mxv = fmaxf(mxv, dpp_mov<DPP_XOR2>(mxv)); mxv = fmaxf(mxv, dpp_mov<DPP_HMIR>(mxv)); mxv = fmaxf(mxv, dpp_mov<DPP_MIR>(mxv));
                if (fr == 0 && fq == 0) atomicMax(nb + b * 16 + (isdk ? 8 : 0) + 2 * wc + bj, __float_as_int(mxv)); } }
    }
};
}
typedef float f32x4_t __attribute__((ext_vector_type(4)));
typedef unsigned u32x2_t __attribute__((ext_vector_type(2)));
typedef float f32x2_t_ __attribute__((ext_vector_type(2)));
typedef unsigned u32x4_t __attribute__((ext_vector_type(4)));
__device__ __forceinline__ unsigned pk2bf(float lo, float hi) { unsigned r; asm volatile("v_cvt_pk_bf16_f32 %0, %1, %2" : "=v"(r) : "v"(lo), "v"(hi)); return r; }
#define LDS_WAIT_() asm volatile("s_waitcnt lgkmcnt(0)" ::: "memory")
__device__ __forceinline__ f32x4_t unpk4bf(u32x2_t u) { f32x4_t f; f.x = __uint_as_float(u.x << 16); f.y = __uint_as_float(u.x & 0xffff0000u); f.z = __uint_as_float(u.y << 16); f.w = __uint_as_float(u.y & 0xffff0000u); return f; }
__device__ __forceinline__ u32x2_t pk4bf(f32x4_t v) { u32x2_t o; o.x = pk2bf(v.x, v.y); o.y = pk2bf(v.z, v.w); return o; }
#define LNC(j) (8 * lane + 512 * ((j) >> 1) + 4 * ((j) & 1))
constexpr int NJ4 = D_MODEL / 256;
__device__ __forceinline__ void ld8bf(const bf16_t* q, u32x2_t& a, u32x2_t& b) { const u32x4_t v = *(const u32x4_t*)q; a.x = v.x; a.y = v.y; b.x = v.z; b.y = v.w; }
__device__ __forceinline__ void st8bf(bf16_t* q, u32x2_t a, u32x2_t b) { *(u32x4_t*)q = (u32x4_t){a.x, a.y, b.x, b.y}; }

__device__ __forceinline__ void cvt_item(const float* W, int K, int N, bf16_t* WT, int k0, int n0, int dst_row0, LAS float* scr, int lane) {
    float tv[32];
#pragma unroll
    for (int i = 0; i < 32; ++i) tv[i] = W[(size_t)(k0 + 2 * i + (lane >> 5)) * N + n0 + (lane & 31)];
#pragma unroll
    for (int i = 0; i < 32; ++i) scr[(2 * i + (lane >> 5)) * 33 + (lane & 31)] = tv[i];
    LDS_WAIT_();
    const int c = lane & 7;
#pragma unroll
    for (int j = 0; j < 4; ++j) { const int n = (lane >> 3) + 8 * j; const LAS float* s = scr + (8 * c) * 33 + n;
        u32x4_t o; o.x = pk2bf(s[0 * 33], s[1 * 33]); o.y = pk2bf(s[2 * 33], s[3 * 33]); o.z = pk2bf(s[4 * 33], s[5 * 33]); o.w = pk2bf(s[6 * 33], s[7 * 33]);
        *(u32x4_t*)(WT + (size_t)(dst_row0 + n) * K + k0 + 8 * c) = o; }
    LDS_WAIT_();
}
constexpr int CVT_I_IN = (D_MODEL / 64) * (IN_W / 256), CVT_I_OUT = (MIX_W / 64) * (D_MODEL / 256), CVT_I_GU1 = (D_MODEL / 64) * (EXP_FF / 256), CVT_I_D1 = (EXP_FF / 64) * (D_MODEL / 256);
constexpr int CVT_NIT = CVT_I_IN + CVT_I_OUT + N_EXP * (2 * CVT_I_GU1 + CVT_I_D1);
struct CvtItem { const float* W; bf16_t* WT; int K, N, k0, n0, kind; };
__device__ __forceinline__ CvtItem cvt_decode(const P& p, int l, int it) {
    CvtItem c; bf16_t* wb = p.WB[l & 1]; int r = it;
    if (r < CVT_I_IN) { const int nb = IN_W / 256; c.W = p.w_in + (size_t)l * D_MODEL * IN_W; c.WT = WB_WIN(wb); c.K = D_MODEL; c.N = IN_W; c.k0 = 64 * (r % (D_MODEL / 64)); c.n0 = 256 * (r / (D_MODEL / 64)); c.kind = 1; (void)nb; return c; } r -= CVT_I_IN;
    if (r < CVT_I_OUT) { const int nb = D_MODEL / 256; c.W = p.w_out + (size_t)l * MIX_W * D_MODEL; c.WT = WB_WOUT(wb); c.K = MIX_W; c.N = D_MODEL; c.k0 = 64 * (r % (MIX_W / 64)); c.n0 = 256 * (r / (MIX_W / 64)); c.kind = 0; (void)nb; return c; } r -= CVT_I_OUT;
    const int per_e = 2 * CVT_I_GU1 + CVT_I_D1, e = r / per_e; r -= e * per_e;
    if (r < 2 * CVT_I_GU1) { const int half = r / CVT_I_GU1; r -= half * CVT_I_GU1; const int nb = EXP_FF / 256;
        c.W = (half ? p.exp_w_up : p.exp_w_gate) + ((size_t)l * N_EXP + e) * D_MODEL * EXP_FF; c.WT = WB_WGU(wb) + (size_t)e * 2 * EXP_FF * D_MODEL; c.K = D_MODEL; c.N = EXP_FF; c.k0 = 64 * (r % (D_MODEL / 64)); c.n0 = 256 * (r / (D_MODEL / 64)); c.kind = 2 + half; (void)nb; return c; }
    r -= 2 * CVT_I_GU1;
    { const int nb = D_MODEL / 256; c.W = p.exp_w_down + ((size_t)l * N_EXP + e) * EXP_FF * D_MODEL; c.WT = WB_WD(wb) + (size_t)e * D_MODEL * EXP_FF; c.K = EXP_FF; c.N = D_MODEL; c.k0 = 64 * (r % (EXP_FF / 64)); c.n0 = 256 * (r / (EXP_FF / 64)); c.kind = 0; (void)nb; }
    return c;
}
__device__ __forceinline__ int cvt_drow(int kind, int n) {
    if (kind == 1) { if (n < 512) return n; const int sc = n % 256; return (n - sc) + 128 * ((sc % 64) / 32) + 32 * (sc / 64) + (sc % 32); }
    if (kind >= 2) return gu_row(kind - 2, n);
    return n;
}
__device__ __forceinline__ void cvt_load(const CvtItem& c, f32x4_t (&v)[8], int wave, int lane) {
#pragma unroll
    for (int i = 0; i < 8; ++i) v[i] = *(const f32x4_t*)(c.W + (size_t)(c.k0 + wave * 8 + i) * c.N + c.n0 + 4 * lane);
}
template <int MODE = 0> __device__ __forceinline__ void ph_cvt_range(const P& p, int l, unsigned char* lds, int it0, int it1, int start, int stride, int tid) {
    LAS float* scr = (LAS float*)(LAS unsigned char*)lds;
    const int wave = tid >> 6, lane = tid & 63;
    if (it0 + start >= it1) return;
    CvtItem c = cvt_decode(p, l, it0 + start); f32x4_t v[8]; cvt_load(c, v, wave, lane);
    for (int it = it0 + start; it < it1; it += stride) {
#pragma unroll
        for (int i = 0; i < 8; ++i) { const int k = wave * 8 + i;
            scr[(4 * lane + 0) * 65 + k] = v[i].x; scr[(4 * lane + 1) * 65 + k] = v[i].y; scr[(4 * lane + 2) * 65 + k] = v[i].z; scr[(4 * lane + 3) * 65 + k] = v[i].w; }
        const CvtItem cur = c;
        if (it + stride < it1) { c = cvt_decode(p, l, it + stride); cvt_load(c, v, wave, lane); }
        __syncthreads();
        const int ch = lane & 7;
#pragma unroll
        for (int j = 0; j < 4; ++j) { const int n = wave * 32 + j * 8 + (lane >> 3); const LAS float* s = scr + n * 65 + 8 * ch;
            u32x4_t o; o.x = pk2bf(s[0], s[1]); o.y = pk2bf(s[2], s[3]); o.z = pk2bf(s[4], s[5]); o.w = pk2bf(s[6], s[7]);
            *(u32x4_t*)(cur.WT + (size_t)cvt_drow(cur.kind, cur.n0 + n) * cur.K + cur.k0 + 8 * ch) = o; }
        __syncthreads();
    }
}
__device__ __forceinline__ void ph_cvt(const P& p, int l, unsigned char* lds, int vcu, int G, int tid) { ph_cvt_range<0>(p, l, lds, 0, CVT_NIT, vcu, G, tid); }

__device__ __forceinline__ void ph_ada(const P& p, unsigned char* lds, int vcu, int G, int wave, int lane) {
    LAS float* red = (LAS float*)(LAS unsigned char*)lds;
    LAS float* sl = red + 8 * 3 * 64;
    for (int i = wave * 64 + lane; i < 3 * D_MODEL; i += NTHR) { const float x = i < 2 * D_MODEL ? p.c[i] : p.c_ctx[i - 2 * D_MODEL]; sl[i] = siluf_(x); }
    __syncthreads();
    constexpr int UPL = 6 * D_MODEL / 32, NU = DEPTH * UPL;
    const int cl = lane & 31, kh = lane >> 5;
    for (int u = vcu; u < NU; u += G) {
        const int l = u / UPL, col = (u % UPL) * 32 + cl;
        const float* W = p.ada_w + (size_t)l * D_MODEL * 6 * D_MODEL + col;
        float a0 = 0.f, a1 = 0.f, a2 = 0.f;
        const int kb = wave * (D_MODEL / 8) + kh * (D_MODEL / 16);
#pragma unroll 16
        for (int k = 0; k < D_MODEL / 16; ++k) { const float wv = W[(size_t)(kb + k) * 6 * D_MODEL];
            a0 += sl[kb + k] * wv; a1 += sl[D_MODEL + kb + k] * wv; a2 += sl[2 * D_MODEL + kb + k] * wv; }
        a0 += __shfl_xor(a0, 32); a1 += __shfl_xor(a1, 32); a2 += __shfl_xor(a2, 32);
        if (kh == 0) { red[(wave * 3 + 0) * 32 + cl] = a0; red[(wave * 3 + 1) * 32 + cl] = a1; red[(wave * 3 + 2) * 32 + cl] = a2; }
        __syncthreads();
        if (wave < 3 && lane < 32) { float s = 0.f;
#pragma unroll
            for (int w = 0; w < 8; ++w) s += red[(w * 3 + wave) * 32 + lane];
            p.MOD[((size_t)l * 3 + wave) * 6 * D_MODEL + col] = s + p.ada_b[l * 6 * D_MODEL + col]; }
        __syncthreads();
    }
}

__device__ __forceinline__ void ph_mod0(const P& p, int gw, int NGW, int lane) {
    f32x4_t sc[NJ4], sh[NJ4], va[NJ4], vn[NJ4]; int cur_who = -1;
#define MOD0_LOAD(V, ROW) do { const int rr_ = (ROW); const float* src_ = rr_ < NLAT ? p.x + (size_t)rr_ * D_MODEL : p.ctx + (size_t)(rr_ - NLAT) * D_MODEL; \
        _Pragma("unroll") for (int j = 0; j < NJ4; ++j) V[j] = *(const f32x4_t*)(src_ + LNC(j)); } while (0)
    if (gw < NROW) MOD0_LOAD(vn, gw);
    for (int r = gw; r < NROW; r += NGW) {
        const int who = row_who(r);
#pragma unroll
        for (int j = 0; j < NJ4; ++j) va[j] = vn[j];
        if (r + NGW < NROW) MOD0_LOAD(vn, r + NGW);
        if (who != cur_who) { cur_who = who;
#pragma unroll
            for (int j = 0; j < NJ4; ++j) { sh[j] = *(const f32x4_t*)(modp(p, 0, who, 0) + LNC(j)); sc[j] = *(const f32x4_t*)(modp(p, 0, who, 1) + LNC(j)); } }
#pragma unroll
        for (int j = 0; j < NJ4; j += 2) { const int c = LNC(j);
            st8bf((bf16_t*)p.XR + (size_t)r * D_MODEL + c, pk4bf(va[j]), pk4bf(va[j + 1]));
            st8bf(p.H + (size_t)r * D_MODEL + c, pk4bf(va[j] * (1.f + sc[j]) + sh[j]), pk4bf(va[j + 1] * (1.f + sc[j + 1]) + sh[j + 1])); }
    }
#undef MOD0_LOAD
}
__device__ __forceinline__ void route_tail(float lgt, const float* router_b, int lane, int& e1, int& e2, float& gw1, float& gw2);
__device__ __forceinline__ void route_wave(const float (&lg)[N_EXP], const float* router_b, int lane, int& e1, int& e2, float& gw1, float& gw2) {
    static_assert(N_EXP == 16, "lane layout");
    const bool b5 = (lane >> 5) & 1, b4 = (lane >> 4) & 1, b3 = (lane >> 3) & 1, b2 = (lane >> 2) & 1;
    float r8[8], r4[4], r2[2];
#pragma unroll
    for (int i = 0; i < 8; ++i) { const float a = b5 ? lg[i + 8] : lg[i], b = b5 ? lg[i] : lg[i + 8]; r8[i] = a + __shfl_xor(b, 32); }
#pragma unroll
    for (int i = 0; i < 4; ++i) { const float a = b4 ? r8[i + 4] : r8[i], b = b4 ? r8[i] : r8[i + 4]; r4[i] = a + __shfl_xor(b, 16); }
#pragma unroll
    for (int i = 0; i < 2; ++i) { const float a = b3 ? r4[i + 2] : r4[i], b = b3 ? r4[i] : r4[i + 2]; r2[i] = a + __shfl_xor(b, 8); }
    float lgt = (b2 ? r2[1] : r2[0]) + __shfl_xor(b2 ? r2[0] : r2[1], 4);
    lgt += __shfl_xor(lgt, 2); lgt += __shfl_xor(lgt, 1);
    route_tail(lgt, router_b, lane, e1, e2, gw1, gw2);
}
__device__ __forceinline__ void route_tail(float lgt, const float* router_b, int lane, int& e1, int& e2, float& gw1, float& gw2) {
    const int e = lane >> 2;
    float mx = lgt; mx = fmaxf(mx, dpp_mov<DPP_HMIR>(mx)); mx = fmaxf(mx, dpp_mov<DPP_MIR>(mx)); mx = swap16_max(mx); mx = swap32_max(mx);
    const float pe = expf(lgt - mx);
    float sm = pe; sm += dpp_mov<DPP_HMIR>(sm); sm += dpp_mov<DPP_MIR>(sm); sm = swap16_sum(sm); sm = swap32_sum(sm);
    const float prob = pe * (1.f / sm), sel = prob + router_b[e];
    const int rb = lane & 48;
    float sj[4], pj[4];
#pragma unroll
    for (int j = 0; j < 4; ++j) { sj[j] = __shfl(sel, rb + 4 * j); pj[j] = __shfl(prob, rb + 4 * j); }
    float s1 = -1e30f, p1 = 0.f; int i1 = 0;
#pragma unroll
    for (int j = 0; j < 4; ++j) if (sj[j] > s1) { s1 = sj[j]; i1 = j; p1 = pj[j]; }
    float s2 = -1e30f, p2 = 0.f; int i2 = 0;
#pragma unroll
    for (int j = 0; j < 4; ++j) if (j != i1 && sj[j] > s2) { s2 = sj[j]; i2 = j; p2 = pj[j]; }
    const float sc = s1 + s2;
    float bs = -1e30f; int bg = 0;
#pragma unroll
    for (int g = 0; g < 4; ++g) { const float sg = __shfl(sc, 16 * g); if (sg > bs) { bs = sg; bg = g; } }
    const int src = 16 * bg;
    const int ri1 = __shfl(i1, src), ri2 = __shfl(i2, src); const float rp1 = __shfl(p1, src), rp2 = __shfl(p2, src);
    e1 = bg * 4 + ri1; e2 = bg * 4 + ri2; const float ws = rp1 + rp2; gw1 = rp1 / ws; gw2 = rp2 / ws;
}
constexpr int LNR_MAXR = 16;
static_assert(NROW < 65536, "row index is packed in 16 bits");
__device__ __forceinline__ void ph_lnroute(const P& p, int l, unsigned char* lds, int gw, int NGW, int tid, int lane, const int nrow) {
    typedef short bf16x8_t __attribute__((ext_vector_type(8)));
    constexpr int AST = D_MODEL * 2 + 16;
    LAS unsigned char* AH = (LAS unsigned char*)lds; LAS unsigned char* AL = AH + 8 * AST;
    LAS float* PART = (LAS float*)(AL + 8 * AST);
    LAS int* LC = (LAS int*)(PART + 8 * 16 * 16);
    LAS int* REC = LC + 2 * N_EXP;
    const int wave = __builtin_amdgcn_readfirstlane(tid >> 6); int nrec = 0;
    if (tid < 2 * N_EXP) LC[tid] = 0;
    f32x4_t lng[NJ4], lnb[NJ4], mg1[NJ4], msc[NJ4], msh[NJ4]; int cur_who = -1;
#pragma unroll
    for (int j = 0; j < NJ4; ++j) { const int c = LNC(j); lng[j] = *(const f32x4_t*)(p.ln1_g + l * D_MODEL + c); lnb[j] = *(const f32x4_t*)(p.ln1_b + l * D_MODEL + c); }
    u32x2_t xa[NJ4], ya[NJ4], xn[NJ4], yn[NJ4];
    if (gw < nrow) {
#pragma unroll
        for (int j = 0; j < NJ4; j += 2) { const int c = LNC(j); ld8bf((const bf16_t*)p.XR + (size_t)gw * D_MODEL + c, xn[j], xn[j + 1]); ld8bf((const bf16_t*)p.YO + (size_t)gw * D_MODEL + c, yn[j], yn[j + 1]); } }
    bf16x8_t Bhi[4], Blo[4];
    { const int e = lane & 15, kq = lane >> 4;
#pragma unroll
      for (int s = 0; s < 4; ++s) { unsigned hh[4], ll[4];
#pragma unroll
          for (int j2 = 0; j2 < 4; ++j2) { const int k = 128 * wave + 32 * s + 8 * kq + 2 * j2; const float w0 = p.router_w[k * N_EXP + e], w1 = p.router_w[(k + 1) * N_EXP + e];
              hh[j2] = pk2bf(w0, w1); ll[j2] = pk2bf(w0 - __uint_as_float(hh[j2] << 16), w1 - __uint_as_float(hh[j2] & 0xffff0000u)); }
          Bhi[s] = __builtin_bit_cast(bf16x8_t, (u32x4_t){hh[0], hh[1], hh[2], hh[3]}); Blo[s] = __builtin_bit_cast(bf16x8_t, (u32x4_t){ll[0], ll[1], ll[2], ll[3]}); } }
    __syncthreads();
    for (int r = gw; r < nrow; r += NGW) {
        const int who = row_who(r);
#pragma unroll
        for (int j = 0; j < NJ4; ++j) { xa[j] = xn[j]; ya[j] = yn[j]; }
        if (r + NGW < nrow) {
#pragma unroll
            for (int j = 0; j < NJ4; j += 2) { const int c = LNC(j); ld8bf((const bf16_t*)p.XR + (size_t)(r + NGW) * D_MODEL + c, xn[j], xn[j + 1]); ld8bf((const bf16_t*)p.YO + (size_t)(r + NGW) * D_MODEL + c, yn[j], yn[j + 1]); } }
        if (who != cur_who) { cur_who = who;
#pragma unroll
            for (int j = 0; j < NJ4; ++j) { const int c = LNC(j); mg1[j] = *(const f32x4_t*)(modp(p, l, who, 2) + c); msh[j] = *(const f32x4_t*)(modp(p, l, who, 3) + c); msc[j] = *(const f32x4_t*)(modp(p, l, who, 4) + c); } }
        f32x4_t t[NJ4]; float s = 0.f;
#pragma unroll
        for (int j = 0; j < NJ4; ++j) { t[j] = unpk4bf(xa[j]) * DN_ALPHA + mg1[j] * unpk4bf(ya[j]); s += (t[j].x + t[j].y) + (t[j].z + t[j].w); }
        const float mean = wave_sum(s) * (1.f / D_MODEL); float s2 = 0.f;
#pragma unroll
        for (int j = 0; j < NJ4; ++j) { t[j] = t[j] - mean; s2 += (t[j].x * t[j].x + t[j].y * t[j].y) + (t[j].z * t[j].z + t[j].w * t[j].w); }
        const float rstd = 1.0f / sqrtf(wave_sum(s2) * (1.f / D_MODEL) + 1e-6f);
#pragma unroll
        for (int j = 0; j < NJ4; j += 2) { const int c = LNC(j); u32x2_t xo[2], hi[2], lo[2];
#pragma unroll
            for (int q = 0; q < 2; ++q) { const f32x4_t x1 = t[j + q] * rstd * lng[j + q] + lnb[j + q]; xo[q] = pk4bf(x1);
                const f32x4_t h2 = x1 * (1.f + msc[j + q]) + msh[j + q]; hi[q] = pk4bf(h2); lo[q] = pk4bf(h2 - unpk4bf(hi[q])); }
            st8bf((bf16_t*)p.XRo + (size_t)r * D_MODEL + c, xo[0], xo[1]); st8bf(p.Ho + (size_t)r * D_MODEL + c, hi[0], hi[1]);
            *(LAS u32x4_t*)(AH + wave * AST + c * 2) = (u32x4_t){hi[0].x, hi[0].y, hi[1].x, hi[1].y}; *(LAS u32x4_t*)(AL + wave * AST + c * 2) = (u32x4_t){lo[0].x, lo[0].y, lo[1].x, lo[1].y}; }
        __syncthreads();
        {
            f32x4_t acc = (f32x4_t){0.f, 0.f, 0.f, 0.f};
            const int arow = lane & 7, kq = lane >> 4;
#pragma unroll
            for (int s4 = 0; s4 < 4; ++s4) { const int off = arow * AST + (128 * wave + 32 * s4 + 8 * kq) * 2;
                const bf16x8_t ah = *(const LAS bf16x8_t*)(AH + off), al = *(const LAS bf16x8_t*)(AL + off);
                acc = __builtin_amdgcn_mfma_f32_16x16x32_bf16(ah, Bhi[s4], acc, 0, 0, 0);
                acc = __builtin_amdgcn_mfma_f32_16x16x32_bf16(ah, Blo[s4], acc, 0, 0, 0);
                acc = __builtin_amdgcn_mfma_f32_16x16x32_bf16(al, Bhi[s4], acc, 0, 0, 0); }
            if (lane < 32) {
#pragma unroll
                for (int i = 0; i < 4; ++i) PART[(wave * 16 + 4 * (lane >> 4) + i) * 16 + (lane & 15)] = acc[i]; }
        }
        __syncthreads();
        float lgt = 0.f;
#pragma unroll
        for (int w = 0; w < 8; ++w) lgt += PART[(w * 16 + wave) * 16 + (lane >> 2)];
        int e1, e2; float gw1, gw2; route_tail(lgt, p.router_b, lane, e1, e2, gw1, gw2);
        if (lane == 0) { p.TGo[r * 2 + 0] = gw1; p.TGo[r * 2 + 1] = gw2;
            const int k1 = __hip_atomic_fetch_add((LAS int*)&LC[e1], 1, __ATOMIC_RELAXED, __HIP_MEMORY_SCOPE_WORKGROUP), k2 = __hip_atomic_fetch_add((LAS int*)&LC[e2], 1, __ATOMIC_RELAXED, __HIP_MEMORY_SCOPE_WORKGROUP);
            REC[(wave * LNR_MAXR + nrec) * 2 + 0] = (r << 16) | (e1 << 12) | k1; REC[(wave * LNR_MAXR + nrec) * 2 + 1] = (r << 16) | (e2 << 12) | k2; }
        ++nrec;
    }
    __syncthreads();
    if (tid < N_EXP) { const int c = LC[tid]; LC[N_EXP + tid] = c ? atomicAdd(p.cnto + CNT_IDX(l, tid), c) : 0; }
    __syncthreads();
    if (lane < 2) for (int i = 0; i < nrec; ++i) { const int rec = REC[(wave * LNR_MAXR + i) * 2 + lane]; const int r = (unsigned)rec >> 16, e = (rec >> 12) & 15, k = rec & 4095;
        p.SLOTTOKo[(size_t)e * NROW + LC[N_EXP + e] + k] = r * 2 + lane; }
    __syncthreads();
}

__device__ __forceinline__ void ph_lnfinal(const P& p, int l, int gw, int NGW, int lane, const int nrow) {
    f32x4_t lng[NJ4], lnb[NJ4], mg2[NJ4], nsc[NJ4], nsh[NJ4]; int cur_who = -1;
#pragma unroll
    for (int j = 0; j < NJ4; ++j) { const int c = LNC(j); lng[j] = *(const f32x4_t*)(p.ln2_g + l * D_MODEL + c); lnb[j] = *(const f32x4_t*)(p.ln2_b + l * D_MODEL + c); }
    u32x2_t xa[NJ4], xn[NJ4], xm[NJ4]; u32x2_t fa0[NJ4], fa1[NJ4], fn0[NJ4], fn1[NJ4], fm0[NJ4], fm1[NJ4];
#define LNF_LOAD(X, F0, F1, ROW) do { const int rr_ = (ROW); _Pragma("unroll") for (int j = 0; j < NJ4; j += 2) { const int c = LNC(j); ld8bf((const bf16_t*)p.XR + (size_t)rr_ * D_MODEL + c, X[j], X[j + 1]); \
            ld8bf(p.FO + (size_t)(rr_ * 2) * D_MODEL + c, F0[j], F0[j + 1]); ld8bf(p.FO + (size_t)(rr_ * 2 + 1) * D_MODEL + c, F1[j], F1[j + 1]); } } while (0)
    if (gw < nrow) LNF_LOAD(xn, fn0, fn1, gw);
    if (gw + NGW < nrow) LNF_LOAD(xm, fm0, fm1, gw + NGW);
    for (int r = gw; r < nrow; r += NGW) {
        const int who = row_who(r);
#pragma unroll
        for (int j = 0; j < NJ4; ++j) { xa[j] = xn[j]; fa0[j] = fn0[j]; fa1[j] = fn1[j]; xn[j] = xm[j]; fn0[j] = fm0[j]; fn1[j] = fm1[j]; }
        if (r + 2 * NGW < nrow) LNF_LOAD(xm, fm0, fm1, r + 2 * NGW);
        if (who != cur_who) { cur_who = who;
#pragma unroll
            for (int j = 0; j < NJ4; ++j) { const int c = LNC(j); mg2[j] = *(const f32x4_t*)(modp(p, l, who, 5) + c);
                if (l + 1 < DEPTH) { nsh[j] = *(const f32x4_t*)(modp(p, l + 1, who, 0) + c); nsc[j] = *(const f32x4_t*)(modp(p, l + 1, who, 1) + c); } } }
        f32x4_t t[NJ4]; float s = 0.f;
#pragma unroll
        for (int j = 0; j < NJ4; ++j) { const u32x2_t u0 = fa0[j], u1 = fa1[j];
            f32x4_t f; f.x = __uint_as_float(u0.x << 16) + __uint_as_float(u1.x << 16); f.y = __uint_as_float(u0.x & 0xffff0000u) + __uint_as_float(u1.x & 0xffff0000u);
            f.z = __uint_as_float(u0.y << 16) + __uint_as_float(u1.y << 16); f.w = __uint_as_float(u0.y & 0xffff0000u) + __uint_as_float(u1.y & 0xffff0000u);
            t[j] = unpk4bf(xa[j]) * DN_ALPHA + mg2[j] * f; s += (t[j].x + t[j].y) + (t[j].z + t[j].w); }
        const float mean = wave_sum(s) * (1.f / D_MODEL); float s2 = 0.f;
#pragma unroll
        for (int j = 0; j < NJ4; ++j) { t[j] = t[j] - mean; s2 += (t[j].x * t[j].x + t[j].y * t[j].y) + (t[j].z * t[j].z + t[j].w * t[j].w); }
        const float rstd = 1.0f / sqrtf(wave_sum(s2) * (1.f / D_MODEL) + 1e-6f);
#pragma unroll
        for (int j = 0; j < NJ4; j += 2) { const int c = LNC(j);
            const f32x4_t xa2 = t[j] * rstd * lng[j] + lnb[j], xb2 = t[j + 1] * rstd * lng[j + 1] + lnb[j + 1];
            if (l + 1 < DEPTH) { st8bf((bf16_t*)p.XRo + (size_t)r * D_MODEL + c, pk4bf(xa2), pk4bf(xb2));
                st8bf(p.Ho + (size_t)r * D_MODEL + c, pk4bf(xa2 * (1.f + nsc[j]) + nsh[j]), pk4bf(xb2 * (1.f + nsc[j + 1]) + nsh[j + 1])); }
            else if (r < NLAT) { *(f32x4_t*)(p.out + (size_t)r * D_MODEL + c) = xa2; *(f32x4_t*)(p.out + (size_t)r * D_MODEL + c + 4) = xb2; } }
    }
#undef LNF_LOAD
}
constexpr int LCH = 64, CCH = 32;
constexpr int NLCH = SEQ / LCH, NCCH = CTX_LEN / CCH, NSEQC = NCCH + NLCH;
constexpr int LRU_UNITS = BATCH * (NLCH + NCCH);
struct LruChunk { int b, row0, ntok, seg0, seglen, sf, sr; };
__device__ __forceinline__ LruChunk lru_chunk(int u) {
    LruChunk k;
    if (u < BATCH * NLCH) { k.b = u / NLCH; const int c = u % NLCH; k.seg0 = k.b * SEQ; k.seglen = SEQ; k.row0 = k.seg0 + c * LCH; k.ntok = LCH; k.sf = NCCH + c; k.sr = NCCH + (NLCH - 1 - c); }
    else { const int q = u - BATCH * NLCH; k.b = q / NCCH; const int c = q % NCCH; k.seg0 = NLAT + k.b * CTX_LEN; k.seglen = CTX_LEN; k.row0 = k.seg0 + c * CCH; k.ntok = CCH; k.sf = c; k.sr = NCCH - 1 - c; }
    return k;
}
__device__ __forceinline__ float* agg_ptr(float* AGG, int b, int dir, int s) { return AGG + (((size_t)b * 2 + dir) * NSEQC + s) * 2 * LRU_W; }

__device__ __forceinline__ void lru_stage_rows(const float* AX, LAS float* Rw, unsigned rw_lds, int row0, int ntok, int seg0, int seglen, int wave, int lane) {
    const int nr = ntok + 3; asm volatile("" : "+v"(lane));
    for (int rr = wave; rr < nr; rr += 8) { const int r = row0 - 1 + rr;
        if (r >= seg0 && r < seg0 + seglen) attn_body::glds16(AX + (size_t)r * LRU_W + 4 * lane, (unsigned)__builtin_amdgcn_readfirstlane(rw_lds + (unsigned)rr * (LRU_W * 4)));
        else *(LAS f32x4_t*)(Rw + rr * LRU_W + 4 * lane) = (f32x4_t){0.f, 0.f, 0.f, 0.f}; }
}
__device__ __forceinline__ void ph_lru1(const P& p, int l, float* AGG, unsigned char* lds, int vcu, int G, int tid) {
    typedef short bf16x8_t __attribute__((ext_vector_type(8)));
    typedef float f32x16_t __attribute__((ext_vector_type(16)));
    constexpr int UST = LRU_W + 8;
    LAS bf16_t* Ub = (LAS bf16_t*)(LAS unsigned char*)lds;
    const int wave = __builtin_amdgcn_readfirstlane(tid >> 6), lane = tid & 63, col = lane & 31, hi = lane >> 5;
    const int n = wave >> 1, dir = wave & 1;
    LAS float* Rw = (LAS float*)((LAS unsigned char*)lds + LCH * UST * 2);
    const unsigned rw_lds = (unsigned)(uintptr_t)lds + (unsigned)(LCH * UST * 2);
    if (vcu < LRU_UNITS) { const LruChunk k0 = lru_chunk(vcu); lru_stage_rows(p.AX, Rw, rw_lds, k0.row0, k0.ntok, k0.seg0, k0.seglen, wave, lane); }
    bf16x8_t Bf[2][2][4];
    {
#pragma unroll
        for (int g = 0; g < 2; ++g) { const float* Wg = (g ? p.rg_wx : p.rg_wa) + ((size_t)(l * 2 + dir) * 4 + n) * LRU_BLK * LRU_BLK;
#pragma unroll
            for (int dh = 0; dh < 2; ++dh)
#pragma unroll
                for (int ks = 0; ks < 4; ++ks) { unsigned w4[4];
#pragma unroll
                    for (int j2 = 0; j2 < 4; ++j2) { const int c0 = 16 * ks + 8 * hi + 2 * j2; w4[j2] = pk2bf(Wg[c0 * LRU_BLK + 32 * dh + col], Wg[(c0 + 1) * LRU_BLK + 32 * dh + col]); }
                    Bf[g][dh][ks] = __builtin_bit_cast(bf16x8_t, (u32x4_t){w4[0], w4[1], w4[2], w4[3]}); } }
    }
    float ba[2], bx[2], nsp8[2];
#pragma unroll
    for (int dh = 0; dh < 2; ++dh) { const int ch = n * LRU_BLK + 32 * dh + col; ba[dh] = p.rg_ba[(l * 2 + dir) * LRU_W + ch]; bx[dh] = p.rg_bx[(l * 2 + dir) * LRU_W + ch];
        nsp8[dh] = -8.0f * __logf(1.f + __expf(-p.rg_lam[(l * 2 + dir) * LRU_W + ch])); }
    const int cch = tid & 255, cpar = tid >> 8;
    const float cw0 = p.conv_w[(l * 4 + 0) * LRU_W + cch], cw1 = p.conv_w[(l * 4 + 1) * LRU_W + cch], cw2 = p.conv_w[(l * 4 + 2) * LRU_W + cch], cw3 = p.conv_w[(l * 4 + 3) * LRU_W + cch], cb = p.conv_b[l * LRU_W + cch];
    for (int u = vcu; u < LRU_UNITS; u += G) {
        const LruChunk k = lru_chunk(u);
        asm volatile("s_waitcnt vmcnt(0)" ::: "memory");
        __syncthreads();
        for (int tt = cpar; tt < k.ntok; tt += 2) { const LAS float* ax = Rw + (tt + 1) * LRU_W + cch;
            Ub[tt * UST + cch] = f2bf(cb + cw0 * ax[-LRU_W] + cw1 * ax[0] + cw2 * ax[LRU_W] + cw3 * ax[2 * LRU_W]); }
        __syncthreads();
        if (u + G < LRU_UNITS) { const LruChunk kn = lru_chunk(u + G); lru_stage_rows(p.AX, Rw, rw_lds, kn.row0, kn.ntok, kn.seg0, kn.seglen, wave, lane); }
        float ap[2] = {1.f, 1.f}, hh[2] = {0.f, 0.f};
        const int nmt = k.ntok / 32;
        for (int im = 0; im < nmt; ++im) { const int mt = dir ? nmt - 1 - im : im;
            f32x16_t acc[2][2];
#pragma unroll
            for (int g = 0; g < 2; ++g)
#pragma unroll
                for (int dh = 0; dh < 2; ++dh) acc[g][dh] = (f32x16_t){0.f, 0.f, 0.f, 0.f, 0.f, 0.f, 0.f, 0.f, 0.f, 0.f, 0.f, 0.f, 0.f, 0.f, 0.f, 0.f};
#pragma unroll
            for (int ks = 0; ks < 4; ++ks) { const bf16x8_t af = *(const LAS bf16x8_t*)(Ub + (mt * 32 + col) * UST + n * LRU_BLK + 16 * ks + 8 * hi);
#pragma unroll
                for (int g = 0; g < 2; ++g)
#pragma unroll
                    for (int dh = 0; dh < 2; ++dh) acc[g][dh] = __builtin_amdgcn_mfma_f32_32x32x16_bf16(af, Bf[g][dh][ks], acc[g][dh], 0, 0, 0); }
#pragma unroll
            for (int dh = 0; dh < 2; ++dh) { const int ch = n * LRU_BLK + 32 * dh + col;
                float GA_[4], GB_[4];
#pragma unroll
                for (int g4 = 0; g4 < 4; ++g4) { float av[4], bv[4];
#pragma unroll
                    for (int i = 0; i < 4; ++i) { const int reg = 4 * g4 + i, tok = mt * 32 + 8 * g4 + 4 * hi + i;
                        const float uc = bf2f(Ub[tok * UST + ch]);
                        const float rg = __builtin_amdgcn_rcpf(1.f + __expf(-(acc[0][dh][reg] + ba[dh]))), ig = __builtin_amdgcn_rcpf(1.f + __expf(-(acc[1][dh][reg] + bx[dh])));
                        const float log_a = nsp8[dh] * rg; const float a = __expf(log_a); const float mult = sqrtf(fmaxf(1.f - __expf(2.f * log_a), 0.f));
                        const float b = mult * ig * uc; av[i] = a; bv[i] = b;
                        const size_t gi = ((size_t)(k.row0 + tok) * 2 + dir) * LRU_W + ch; p.LA[gi] = a; p.LB[gi] = b; }
                    float A_, B_;
                    if (dir == 0) { A_ = av[0]; B_ = bv[0];
#pragma unroll
                        for (int i = 1; i < 4; ++i) { B_ = av[i] * B_ + bv[i]; A_ *= av[i]; } }
                    else { A_ = av[3]; B_ = bv[3];
#pragma unroll
                        for (int i = 2; i >= 0; --i) { B_ = av[i] * B_ + bv[i]; A_ *= av[i]; } }
                    GA_[g4] = A_; GB_[g4] = B_; }
#pragma unroll
                for (int s = 0; s < 8; ++s) { const int q = dir ? 7 - s : s; const int g4 = q >> 1, qh = q & 1;
                    const float oa = __shfl_xor(GA_[g4], 32), ob = __shfl_xor(GB_[g4], 32);
                    const float A_ = (qh == hi) ? GA_[g4] : oa, B_ = (qh == hi) ? GB_[g4] : ob;
                    hh[dh] = A_ * hh[dh] + B_; ap[dh] *= A_; } }
        }
        if (hi == 0) { float* ag = agg_ptr(AGG, k.b, dir, dir ? k.sr : k.sf);
#pragma unroll
            for (int dh = 0; dh < 2; ++dh) { const int ch = n * LRU_BLK + 32 * dh + col; ag[ch] = ap[dh]; ag[LRU_W + ch] = hh[dh]; } }
        __syncthreads();
    }
}
__device__ __forceinline__ void ph_lru2(const P& p, const float* AGG, unsigned char* lds, int vcu, int G, int tid, const int nunits) {
    LAS float* HF = (LAS float*)(LAS unsigned char*)lds;
    const int dir = tid >> 8, ch = tid & 255;
    for (int u = vcu; u < nunits; u += G) {
        const LruChunk k = lru_chunk(u);
        const int me = dir ? k.sr : k.sf;
        const float* ag = AGG + (((size_t)k.b * 2 + dir) * NSEQC) * 2 * LRU_W + ch;
        f32x4_t gq[4][2];
#pragma unroll
        for (int i = 0; i < 4; ++i) { const int it = tid + i * NTHR, tt = it >> 5, c8 = (it & 31) * 8;
            if (tt < k.ntok) { const float* gp = p.GA + (size_t)(k.row0 + tt) * LRU_W + c8; gq[i][0] = *(const f32x4_t*)gp; gq[i][1] = *(const f32x4_t*)(gp + 4); }
            else { gq[i][0] = (f32x4_t){0.f, 0.f, 0.f, 0.f}; gq[i][1] = (f32x4_t){0.f, 0.f, 0.f, 0.f}; } }
        float an[8], bn[8];
#pragma unroll
        for (int q = 0; q < 8; ++q) { const int tt = dir ? k.ntok - 1 - q : q; const size_t gi = ((size_t)(k.row0 + tt) * 2 + dir) * LRU_W + ch; an[q] = p.LA[gi]; bn[q] = p.LB[gi]; }
        float h = 0.f;
        for (int s = 0; s < me; s += 16) { float av[16], hv[16];
#pragma unroll
            for (int q = 0; q < 16; ++q) { const bool ok = s + q < me; const int si = ok ? s + q : me - 1; av[q] = ag[(size_t)si * 2 * LRU_W]; hv[q] = ag[(size_t)si * 2 * LRU_W + LRU_W]; av[q] = ok ? av[q] : 1.f; hv[q] = ok ? hv[q] : 0.f; }
#pragma unroll
            for (int q = 0; q < 16; ++q) h = av[q] * h + hv[q]; }
        for (int i0 = 0; i0 < k.ntok; i0 += 8) { float av[8], bv[8];
#pragma unroll
            for (int q = 0; q < 8; ++q) { av[q] = an[q]; bv[q] = bn[q]; }
            if (i0 + 8 < k.ntok) {
#pragma unroll
                for (int q = 0; q < 8; ++q) { const int tt = dir ? k.ntok - 1 - (i0 + 8 + q) : i0 + 8 + q; const size_t gi = ((size_t)(k.row0 + tt) * 2 + dir) * LRU_W + ch; an[q] = p.LA[gi]; bn[q] = p.LB[gi]; } }
#pragma unroll
            for (int q = 0; q < 8; ++q) { const int tt = dir ? k.ntok - 1 - (i0 + q) : i0 + q; h = av[q] * h + bv[q]; HF[(dir * LCH + tt) * LRU_W + ch] = h; } }
        __syncthreads();
#pragma unroll
        for (int i = 0; i < 4; ++i) { const int it = tid + i * NTHR, tt = it >> 5, c8 = (it & 31) * 8;
            if (tt < k.ntok) { const LAS float* hf = HF + tt * LRU_W + c8; const LAS float* hb = HF + (LCH + tt) * LRU_W + c8;
                const f32x4_t f0 = *(const LAS f32x4_t*)hf, f1 = *(const LAS f32x4_t*)(hf + 4), b0 = *(const LAS f32x4_t*)hb, b1 = *(const LAS f32x4_t*)(hb + 4);
                const f32x4_t y0 = gq[i][0] * (f0 + b0), y1 = gq[i][1] * (f1 + b1);
                u32x4_t w; w.x = pk2bf(y0.x, y0.y); w.y = pk2bf(y0.z, y0.w); w.z = pk2bf(y1.x, y1.y); w.w = pk2bf(y1.z, y1.w);
                *(u32x4_t*)(p.Y + (size_t)(k.row0 + tt) * MIX_W + c8) = w; } }
        __syncthreads();
    }
}
__device__ __forceinline__ void ph_diffcomb(const P& p, int l, int gw, int NGW, int lane) {
    static_assert(DIFF_H == 4, "lane mapping assumes 4 diff heads (8 branch outputs of 64)");
    const float lam = diff_lam(p, l), lam_init = 0.8f - 0.6f * expf(-0.3f * (float)l);
    const int hb = lane >> 3, sub = lane & 7, head = hb >> 1;
    float g[8];
#pragma unroll
    for (int j = 0; j < 8; ++j) g[j] = p.diff_subln_g[l * 64 + sub * 8 + j] * (1.f - lam_init);
    for (int r = gw; r < NROW; r += NGW) {
        const u32x4_t v = *(const u32x4_t*)(p.OD + (size_t)r * ODP + hb * 64 + sub * 8);
        float o[8]; o[0] = __uint_as_float(v.x << 16); o[1] = __uint_as_float(v.x & 0xffff0000u); o[2] = __uint_as_float(v.y << 16); o[3] = __uint_as_float(v.y & 0xffff0000u);
        o[4] = __uint_as_float(v.z << 16); o[5] = __uint_as_float(v.z & 0xffff0000u); o[6] = __uint_as_float(v.w << 16); o[7] = __uint_as_float(v.w & 0xffff0000u);
        float ss = 0.f;
#pragma unroll
        for (int j = 0; j < 8; ++j) { const float o2 = __shfl_down(o[j], 8); o[j] = o[j] - lam * o2; ss += o[j] * o[j]; }
        ss += __shfl_xor(ss, 1); ss += __shfl_xor(ss, 2); ss += __shfl_xor(ss, 4);
        const float rs = 1.0f / sqrtf(ss * (1.f / 64.f) + 1e-6f);
        if ((hb & 1) == 0) { u32x4_t w; w.x = pk2bf(o[0] * rs * g[0], o[1] * rs * g[1]); w.y = pk2bf(o[2] * rs * g[2], o[3] * rs * g[3]); w.z = pk2bf(o[4] * rs * g[4], o[5] * rs * g[5]); w.w = pk2bf(o[6] * rs * g[6], o[7] * rs * g[7]);
            *(u32x4_t*)(p.Y + (size_t)r * MIX_W + LRU_W + GQA_H * 64 + head * 64 + sub * 8) = w; }
    }
}
#define FOR_GID(n) for (long gid = (long)blockIdx.x * NTHR + tid_; gid < (long)(n); gid += (long)gridDim.x * NTHR)
#define GRID_SYNC() do { XcdBarrier b2_ = bar; asm volatile("" : "+s"(b2_.bar), "+s"(b2_.x)); xcd_barrier(b2_); } while (0)
#define CTL_NB_WORD 16384
#define PHASE_P() int tid_ = threadIdx.x; asm volatile("" : "+v"(tid_)); const P& q = p

struct AttnWork { const attn_body::bf16* Qu; const attn_body::bf16* Kh; const attn_body::bf16* Vh; attn_body::bf16* Ou; int nt; };
__device__ __forceinline__ AttnWork attn_decode(const P& p, int b, int vh, int row0, int nt) {
    AttnWork w;
    const int kh = vh < GQA_H ? vh / (GQA_H / GQA_KV) : GQA_KV + (vh - GQA_H);
    const int vv = vh < GQA_H ? vh / (GQA_H / GQA_KV) : GQA_KV + (vh - GQA_H) / 2;
    w.Qu = (const attn_body::bf16*)(p.ZQ + (size_t)row0 * QP + vh * 64);
    w.Kh = (const attn_body::bf16*)(p.ZK + (size_t)b * SKEY * KP + kh * 64);
    w.Vh = (const attn_body::bf16*)(p.ZV + (size_t)b * SKEY * VP + vv * 64);
    if (vh < GQA_H) { w.Ou = (attn_body::bf16*)(p.Y + (size_t)row0 * MIX_W + LRU_W + vh * 64); }
    else { w.Ou = (attn_body::bf16*)(p.OD + (size_t)row0 * ODP + (vh - GQA_H) * 64); }
    w.nt = nt; return w;
}
__device__ __forceinline__ void diffcomb_wave(const P& p, int l, float lam, int row_first, int h, int lane) {
    asm volatile("s_waitcnt vmcnt(0)" ::: "memory");
    const float lam_init = 0.8f - 0.6f * expf(-0.3f * (float)l);
    const int rs = lane >> 5, dp = lane & 31;
    const float g0 = p.diff_subln_g[l * 64 + 2 * dp] * (1.f - lam_init), g1 = p.diff_subln_g[l * 64 + 2 * dp + 1] * (1.f - lam_init);
    unsigned u1[16], u2[16];
#pragma unroll
    for (int it = 0; it < 16; ++it) { const size_t r = (size_t)(row_first + 2 * it + rs);
        u1[it] = __hip_atomic_load((const unsigned*)(p.OD + r * ODP + (2 * h) * 64 + 2 * dp), __ATOMIC_RELAXED, __HIP_MEMORY_SCOPE_AGENT);
        u2[it] = __hip_atomic_load((const unsigned*)(p.OD + r * ODP + (2 * h + 1) * 64 + 2 * dp), __ATOMIC_RELAXED, __HIP_MEMORY_SCOPE_AGENT); }
#pragma unroll
    for (int it = 0; it < 16; ++it) { const size_t r = (size_t)(row_first + 2 * it + rs);
        const float a0 = __uint_as_float(u1[it] << 16) - lam * __uint_as_float(u2[it] << 16), a1 = __uint_as_float(u1[it] & 0xffff0000u) - lam * __uint_as_float(u2[it] & 0xffff0000u);
        const float ss = half32_sum(a0 * a0 + a1 * a1);
        const float rsq = 1.0f / sqrtf(ss * (1.f / 64.f) + 1e-6f);
        *(unsigned*)(p.Y + r * MIX_W + LRU_W + GQA_H * 64 + h * 64 + 2 * dp) = pk2bf(a0 * rsq * g0, a1 * rsq * g1); }
}
__device__ __forceinline__ void attn_one(const P& p, int l, float lam, char* lds, int b, int vh, int row0, int nt, int wid, int lane, const attn_body::bf16* knext = nullptr, const bool kpre = false) {
    const AttnWork w = attn_decode(p, b, vh, row0, nt);
    if (vh < GQA_H) attn_body::attn_unit<8, QP, KP, VP, MIX_W, false, true>(w.Qu, w.Kh, w.Vh, w.Ou, w.nt, lds, knext, kpre);
    else {
        const int* nb = (const int*)p.ctl + CTL_NB_WORD + 64 * l + b * 16 + (vh - GQA_H);
        const float q2 = __int_as_float(__builtin_amdgcn_readfirstlane(nb[0])), k2 = __int_as_float(__builtin_amdgcn_readfirstlane(nb[8]));
        if (sqrtf(q2 * k2) * 1.05f < 64.f) attn_body::attn_unit<8, QP, KP, VP, MIX_W, true, true>(w.Qu, w.Kh, w.Vh, w.Ou, w.nt, lds, knext, kpre);
        else attn_body::attn_unit<8, QP, KP, VP, MIX_W, true, false>(w.Qu, w.Kh, w.Vh, w.Ou, w.nt, lds, knext, kpre);
        if ((vh - GQA_H) & 1) diffcomb_wave(p, l, lam, row0 + wid * 32, (vh - GQA_H) >> 1, lane); }
}
__device__ __forceinline__ void attn_phase_all(const P& p, int l, char* lds, int vcu, int G, int tid, const bool need_ctx) {
    constexpr int NQB = SEQ / 256, NLU = BATCH * NVH * NQB;
    static_assert(NLU % 256 == 0 && NVH == 16 && CTX_LEN == 256, "unit deal");
    const int wid = __builtin_amdgcn_readfirstlane(tid >> 6), lane = tid & 63;
    const float lam = diff_lam(p, l);
    bool kpre = false;
    for (int u = vcu; u < NLU; u += G) { const int i = u / 256, v = u % 256, x = v / 32, j = v % 32; const int b = x / 4, g = x % 4; const int vh = (i == 0) ? 2 * g : (i == 1) ? GQA_H + 2 * g : (i == 2) ? GQA_H + 2 * g + 1 : 2 * g + 1;
        const attn_body::bf16* knext = nullptr;
        if (u + G < NLU) { const int u2 = u + G, i2 = u2 / 256, v2 = u2 % 256, x2 = v2 / 32; const int b2 = x2 / 4, g2 = x2 % 4; const int vh2 = (i2 == 0) ? 2 * g2 : (i2 == 1) ? GQA_H + 2 * g2 : (i2 == 2) ? GQA_H + 2 * g2 + 1 : 2 * g2 + 1;
            knext = attn_decode(p, b2, vh2, b2 * SEQ, SKEY / 64).Kh; }
        attn_one(p, l, lam, lds, b, vh, b * SEQ + j * 256, SKEY / 64, wid, lane, knext, kpre); kpre = knext != nullptr; }
    if (need_ctx) for (int k = 0; k < BATCH * NVH / 2; ++k) if ((k * 16) % G == vcu) {
#pragma unroll 1
        for (int c = 2 * k; c < 2 * k + 2; ++c) { const int b = c / NVH, vh = c % NVH; attn_one(p, l, lam, lds, b, vh, NLAT + b * CTX_LEN, CTX_LEN / 64, wid, lane); } }
}

__global__ void __launch_bounds__(NTHR, 2) k_mega(P p) {
    extern __shared__ __attribute__((aligned(16))) unsigned char lds[];
    if (threadIdx.x < 4) ((volatile LAS unsigned*)(lds + LDS_MISC))[threadIdx.x] = 0u;
    __syncthreads();
    XcdBarrier bar = xcd_barrier_post(p.ctl, (volatile LAS unsigned*)(lds + LDS_MISC));
    const int G = gridDim.x; const int vcu = (G % 8 == 0) ? ((int)blockIdx.x % 8) * (G / 8) + (int)blockIdx.x / 8 : (int)blockIdx.x;
    const int wave_ = __builtin_amdgcn_readfirstlane((int)threadIdx.x >> 6);
    { PHASE_P(); ph_ada(q, lds, vcu, G, wave_, tid_ & 63); }
    GRID_SYNC();
    { PHASE_P(); ph_mod0(q, vcu * 8 + wave_, G * 8, tid_ & 63); }
    for (int l = 0; l < DEPTH; ++l) {
        const bool need_ctx = l + 1 < DEPTH; const int nrow = need_ctx ? NROW : NLAT;
        { PHASE_P(); ph_cvt(q, l, lds, vcu, G, tid_); }
        GRID_SYNC();
        {
            pg8::DenseOrder S; S.init(p.H, WB_WIN(p.WB[l & 1]), NROW, IN_W, D_MODEL, G, (int)blockIdx.x);
            pg8::EpiInProj E{p.AX, p.GA, p.ZQ, p.ZK, p.ZV, p.q_norm_g + l * 64, p.k_norm_g + l * 64, (int*)p.ctl + CTL_NB_WORD + 64 * l};
            pg8::gemm_phase<pg8::EpiInProj, pg8::DenseOrder, true, true>((LAS unsigned char*)lds, D_MODEL, S, E); }
        GRID_SYNC();
        { PHASE_P(); ph_lru1(q, l, q.HS, lds, vcu, G, tid_); }
        GRID_SYNC();
        { PHASE_P(); ph_lru2(q, q.HS, lds, vcu, G, tid_, need_ctx ? LRU_UNITS : BATCH * NLCH); __syncthreads(); }
        { PHASE_P(); attn_phase_all(q, l, (char*)lds, vcu, G, tid_, need_ctx); }
        GRID_SYNC();
        {
            pg8::DenseOrder S; S.init(p.Y, WB_WOUT(p.WB[l & 1]), nrow, D_MODEL, MIX_W, G, (int)blockIdx.x);
            pg8::EpiBf16Plain E{(bf16_t*)p.YO, D_MODEL};
            pg8::gemm_phase<pg8::EpiBf16Plain, pg8::DenseOrder, true, true>((LAS unsigned char*)lds, MIX_W, S, E); }
        GRID_SYNC();
        { PHASE_P(); ph_lnroute(q, l, lds, vcu * 8 + wave_, G * 8, tid_, tid_ & 63, nrow); }
        GRID_SYNC();
        {
            pg8::MoeOrder S; S.init(p.H, WB_WGU(p.WB[l & 1]), p.cnt + CNT_IDX(l, 0), p.SLOTTOK, 2 * EXP_FF, D_MODEL, true, G, (int)blockIdx.x);
            pg8::EpiSwiGLU E{p.HM};
            pg8::gemm_phase<pg8::EpiSwiGLU, pg8::MoeOrder, true, true>((LAS unsigned char*)lds, D_MODEL, S, E); }
        GRID_SYNC();
        {
            pg8::MoeOrder S; S.init(p.HM, WB_WD(p.WB[l & 1]), p.cnt + CNT_IDX(l, 0), p.SLOTTOK, D_MODEL, EXP_FF, false, G, (int)blockIdx.x);
            pg8::EpiMoeDown E{p.FO, p.TG, p.SLOTTOK, S.pl};
            pg8::gemm_phase<pg8::EpiMoeDown, pg8::MoeOrder, true, true>((LAS unsigned char*)lds, EXP_FF, S, E); }
        GRID_SYNC();
        { PHASE_P(); ph_lnfinal(q, l, vcu * 8 + wave_, G * 8, tid_ & 63, nrow); }
    }
}
extern "C" void kernel_launch(void* const* d_in, const int* in_sizes, int n_in, void* d_out, int out_size, void* d_ws, size_t ws_size, hipStream_t stream) {
    (void)in_sizes; (void)n_in; (void)out_size;
    WsMap m = ws_map();
    if (ws_size < m.total) { fprintf(stderr, "ws too small: %zu < %zu\n", ws_size, m.total); return; }
    static int grid = 0;
    if (!grid) { int dev = 0, cus = 0; (void)hipGetDevice(&dev); (void)hipDeviceGetAttribute(&cus, hipDeviceAttributeMultiprocessorCount, dev);
        if (hipFuncSetAttribute((const void*)k_mega, hipFuncAttributeMaxDynamicSharedMemorySize, LDS_BYTES) != hipSuccess) { fprintf(stderr, "hipFuncSetAttribute failed\n"); grid = -1; return; }
        int per_cu = 0; (void)hipOccupancyMaxActiveBlocksPerMultiprocessor(&per_cu, (const void*)k_mega, NTHR, LDS_BYTES); (void)hipGetLastError();
        if (per_cu < 1) fprintf(stderr, "note: occupancy query says %d\n", per_cu);
        grid = cus; }
    if (grid < 0) return;
    P p; memset(&p, 0, sizeof(p)); fill_inputs(p, d_in, d_out); fill_ws(p, (unsigned char*)d_ws);
    (void)hipMemsetAsync(p.ctl, 0, 1 << 17, stream);
    k_mega<<<dim3(grid), dim3(NTHR), LDS_BYTES, stream>>>(p);
}
```

```cpp
#include <hip/hip_runtime.h>
#include <cstdio>
#include <stdint.h>
#include <math.h>
#include <string.h>

#ifdef CPU_TEST
#define HD inline
#define UNROLL
#else
#define HD __host__ __device__ __forceinline__
#define UNROLL _Pragma("unroll")
#endif
#if defined(__HIP_DEVICE_COMPILE__)
#define LAUNDER_V(x) asm volatile("" : "+v"(x))
#else
#define LAUNDER_V(x) do {} while (0)
#endif

#ifndef D_MODEL
#define D_MODEL 1024
#define BATCH 2
#define SEQ 8192
#define DEPTH 4
#define GRID_W 64
#define CTX_LEN 256
#define LRU_W 256
#define GQA_H 8
#define GQA_KV 2
#define DIFF_H 4
#define EXP_FF 512
#endif
#define LRU_BLK (LRU_W / 4)
#define N_EXP 16
#define CNT_STRIDE 32
#define CNT_IDX(l, e) ((((l) * N_EXP) + (e)) * CNT_STRIDE)
#define OFF_AX 0
#define OFF_AG (LRU_W)
#define OFF_GQ (2 * LRU_W)
#define OFF_GK (OFF_GQ + GQA_H * 64)
#define OFF_GV (OFF_GK + GQA_KV * 64)
#define OFF_DQ (OFF_GV + GQA_KV * 64)
#define OFF_DK (OFF_DQ + DIFF_H * 64)
#define OFF_DV (OFF_DK + DIFF_H * 64)
#define IN_W (OFF_DV + DIFF_H * 64)
#define MIX_W (LRU_W + GQA_H * 64 + DIFF_H * 64)
#define NLAT (BATCH * SEQ)
#define NCTX (BATCH * CTX_LEN)
#define NROW (NLAT + NCTX)
#define SKEY (CTX_LEN + SEQ)
#define NVH (GQA_H + 2 * DIFF_H)
#define NKH (GQA_KV + 2 * DIFF_H)
#define NVV (GQA_KV + DIFF_H)
#define QP (NVH * 64)
#define KP (NKH * 64)
#define VP (NVV * 64)
#define ODP MIX_W
#define GUB (EXP_FF < 128 ? EXP_FF : 128)
#define MOE_TM 256
#define MOE_ROWS (2 * NROW + N_EXP * MOE_TM)
#define DN_ALPHA 1.681792830507429f
#define LOG2E 1.4426950408889634f
#define QS_G (0.125f * LOG2E)
#define QS_D (0.17677669529663687f * LOG2E)

#ifdef EXACT_TEST
typedef float bf16_t;
HD float bf2f(bf16_t h) { return h; }
HD bf16_t f2bf(float f) { return f; }
#else
typedef unsigned short bf16_t;
HD float bf2f(bf16_t h) { unsigned u = ((unsigned)h) << 16; float f; memcpy(&f, &u, 4); return f; }
HD bf16_t f2bf(float f) { unsigned u; memcpy(&u, &f, 4); return (bf16_t)((u + 0x7fffu + ((u >> 16) & 1u)) >> 16); }
#endif

struct P {
    const float *x, *c, *ctx, *c_ctx, *ada_w, *ada_b, *w_in, *conv_w, *conv_b, *rg_wa, *rg_ba, *rg_wx, *rg_bx, *rg_lam,
        *q_norm_g, *k_norm_g, *diff_lambda, *diff_subln_g, *w_out, *ln1_g, *ln1_b, *ln2_g, *ln2_b, *router_w, *router_b,
        *exp_w_gate, *exp_w_up, *exp_w_down;
    float* out;
    unsigned* ctl;
    int* cnt;
    float* MOD;
    bf16_t* WB[2];
    float* XR;
    bf16_t* H;
    float* Z;
    float *LA, *LB, *HS;
    float* YO;
    bf16_t* FO;
    bf16_t *ZQ, *ZK, *ZV;
    float *AX, *GA;
    bf16_t* Y;
    bf16_t* OD;
    float* TG;
    int* SLOTTOK;
    bf16_t* HM;
    float* XRo; bf16_t* Ho; float* TGo; int* SLOTTOKo; int* cnto;
    int pad_[2];
};
#define WB_WIN(wb) (wb)
#define WB_WOUT(wb) ((wb) + (size_t)IN_W * D_MODEL)
#define WB_WGU(wb) (WB_WOUT(wb) + (size_t)D_MODEL * MIX_W)
#define WB_WD(wb) (WB_WGU(wb) + (size_t)N_EXP * 2 * EXP_FF * D_MODEL)
#define WB_ELEMS ((size_t)IN_W * D_MODEL + (size_t)D_MODEL * MIX_W + (size_t)N_EXP * 3 * EXP_FF * D_MODEL)

HD float sigmoidf_(float x) { return 1.f / (1.f + expf(-x)); }
HD float siluf_(float x) { return x / (1.f + expf(-x)); }
HD float gelu_tanhf_(float x) { return 0.5f * x * (1.f + tanhf(0.7978845608028654f * (x + 0.044715f * x * x * x))); }
HD float softplusf_(float x) { return x > 20.f ? x : log1pf(expf(x)); }

HD int row_who(int r) { return r < NLAT ? r / SEQ : BATCH; }
HD int row_kidx(int r) { if (r < NLAT) { int b = r / SEQ, t = r % SEQ; return b * SKEY + CTX_LEN + t; } int q = r - NLAT; int b = q / CTX_LEN, j = q % CTX_LEN; return b * SKEY + j; }
HD int gu_row(int half, int j) { return (j / GUB) * 2 * GUB + half * GUB + (j % GUB); }

HD long n_cvt() { return (long)WB_ELEMS; }
HD void st_cvt(const P& p, int l, long gid) {
    bf16_t* wb = p.WB[l & 1];
    size_t i = (size_t)gid;
    const size_t n_in = (size_t)IN_W * D_MODEL, n_out = (size_t)D_MODEL * MIX_W, n_gu = (size_t)N_EXP * 2 * EXP_FF * D_MODEL;
    if (i < n_in) { int n = (int)(i / D_MODEL), k = (int)(i % D_MODEL); wb[i] = f2bf(p.w_in[((size_t)l * D_MODEL + k) * IN_W + n]); return; }
    i -= n_in;
    if (i < n_out) { int n = (int)(i / MIX_W), k = (int)(i % MIX_W); WB_WOUT(wb)[i] = f2bf(p.w_out[((size_t)l * MIX_W + k) * D_MODEL + n]); return; }
    i -= n_out;
    if (i < n_gu) {
        int e = (int)(i / ((size_t)2 * EXP_FF * D_MODEL)); size_t q = i % ((size_t)2 * EXP_FF * D_MODEL); int r = (int)(q / D_MODEL), k = (int)(q % D_MODEL);
        int t = r / (2 * GUB), w = r % (2 * GUB), half = w / GUB, cc = w % GUB, j = t * GUB + cc;
        const float* src = half ? p.exp_w_up : p.exp_w_gate;
        WB_WGU(wb)[i] = f2bf(src[(((size_t)l * N_EXP + e) * D_MODEL + k) * EXP_FF + j]); return; }
    i -= n_gu;
    { int e = (int)(i / ((size_t)D_MODEL * EXP_FF)); size_t q = i % ((size_t)D_MODEL * EXP_FF); int n = (int)(q / EXP_FF), k = (int)(q % EXP_FF);
      WB_WD(wb)[i] = f2bf(p.exp_w_down[(((size_t)l * N_EXP + e) * EXP_FF + k) * D_MODEL + n]); }
}

HD long n_ada() { return (long)DEPTH * 6 * D_MODEL; }
HD void st_ada(const P& p, long gid) {
    int l = (int)(gid / (6 * D_MODEL)), col = (int)(gid % (6 * D_MODEL));
    float acc[BATCH + 1]; UNROLL for (int w = 0; w <= BATCH; ++w) acc[w] = 0.f;
    const float* W = p.ada_w + (size_t)l * D_MODEL * 6 * D_MODEL + col;
    for (int k = 0; k < D_MODEL; ++k) { float wv = W[(size_t)k * 6 * D_MODEL];
        for (int b = 0; b < BATCH; ++b) acc[b] += siluf_(p.c[b * D_MODEL + k]) * wv;
        acc[BATCH] += siluf_(p.c_ctx[k]) * wv; }
    float bias = p.ada_b[l * 6 * D_MODEL + col];
    UNROLL for (int w = 0; w <= BATCH; ++w) p.MOD[((size_t)l * 3 + w) * 6 * D_MODEL + col] = acc[w] + bias;
}
HD const float* modp(const P& p, int l, int who, int chunk) { return p.MOD + ((size_t)l * 3 + who) * 6 * D_MODEL + chunk * D_MODEL; }

HD long n_mod0() { return (long)NROW * D_MODEL; }
HD void st_mod0(const P& p, long gid) {
    int r = (int)(gid / D_MODEL), cc = (int)(gid % D_MODEL); int who = row_who(r);
    float v = r < NLAT ? p.x[(size_t)r * D_MODEL + cc] : p.ctx[(size_t)(r - NLAT) * D_MODEL + cc];
    p.XR[gid] = v;
    p.H[gid] = f2bf(v * (1.f + modp(p, 0, who, 1)[cc]) + modp(p, 0, who, 0)[cc]);
}

HD void dot4x4(const bf16_t* const a[4], const bf16_t* const b[4], int K, float acc[4][4]) {
    UNROLL for (int i = 0; i < 4; ++i) UNROLL for (int j = 0; j < 4; ++j) acc[i][j] = 0.f;
    for (int k = 0; k < K; k += 4) {
        float av[4][4], bv[4][4];
        UNROLL for (int i = 0; i < 4; ++i) UNROLL for (int q = 0; q < 4; ++q) { av[i][q] = bf2f(a[i][k + q]); bv[i][q] = bf2f(b[i][k + q]); }
        UNROLL for (int i = 0; i < 4; ++i) UNROLL for (int j = 0; j < 4; ++j) UNROLL for (int q = 0; q < 4; ++q) acc[i][j] += av[i][q] * bv[j][q];
    }
}
HD long n_gemm_in() { return (long)(NROW / 4) * (IN_W / 4); }
HD void st_gemm_in(const P& p, int l, long gid) {
    int m0 = (int)(gid / (IN_W / 4)) * 4, n0 = (int)(gid % (IN_W / 4)) * 4;
    const bf16_t* wb = WB_WIN(p.WB[l & 1]); const bf16_t *a[4], *b[4];
    UNROLL for (int i = 0; i < 4; ++i) { a[i] = p.H + (size_t)(m0 + i) * D_MODEL; b[i] = wb + (size_t)(n0 + i) * D_MODEL; }
    float acc[4][4]; dot4x4(a, b, D_MODEL, acc);
    UNROLL for (int i = 0; i < 4; ++i) UNROLL for (int j = 0; j < 4; ++j) p.Z[(size_t)(m0 + i) * IN_W + n0 + j] = acc[i][j];
}
HD long n_gemm_out() { return (long)(NROW / 4) * (D_MODEL / 4); }
HD void st_gemm_out(const P& p, int l, long gid) {
    int m0 = (int)(gid / (D_MODEL / 4)) * 4, n0 = (int)(gid % (D_MODEL / 4)) * 4;
    const bf16_t* wb = WB_WOUT(p.WB[l & 1]); const bf16_t *a[4], *b[4];
    UNROLL for (int i = 0; i < 4; ++i) { a[i] = p.Y + (size_t)(m0 + i) * MIX_W; b[i] = wb + (size_t)(n0 + i) * MIX_W; }
    float acc[4][4]; dot4x4(a, b, MIX_W, acc);
    UNROLL for (int i = 0; i < 4; ++i) UNROLL for (int j = 0; j < 4; ++j) p.YO[(size_t)(m0 + i) * D_MODEL + n0 + j] = acc[i][j];
}

HD void rope_cs(int t, int i, int nfreq, float& cs, float& sn) {
    int rowp = t / GRID_W, colp = t % GRID_W;
    float pos = (float)(i < nfreq ? rowp : colp); int j = i % nfreq;
    float inv = exp2f(-(float)j / (float)nfreq * 13.287712379549449f);
    float ang = pos * inv;
#if defined(__HIP_DEVICE_COMPILE__)
    cs = __cosf(ang); sn = __sinf(ang);
#else
    cs = cosf(ang); sn = sinf(ang);
#endif
}
HD long n_post() { return (long)NROW * (IN_W / 64); }
HD void st_post(const P& p, int l, long gid) {
    int r = (int)(gid / (IN_W / 64)), job = (int)(gid % (IN_W / 64)); int c0 = job * 64;
    const float* z = p.Z + (size_t)r * IN_W + c0;
    bool lat = r < NLAT; int t = lat ? r % SEQ : 0; int kidx = row_kidx(r);
    float v[64]; UNROLL for (int d = 0; d < 64; ++d) v[d] = z[d];
    unsigned zz_ = 0; LAUNDER_V(zz_); const bf16_t zz = (bf16_t)zz_;
    if (c0 < OFF_AG) { UNROLL for (int d = 0; d < 64; ++d) p.AX[(size_t)r * LRU_W + c0 + d] = v[d]; return; }
    if (c0 < OFF_GQ) { UNROLL for (int d = 0; d < 64; ++d) p.GA[(size_t)r * LRU_W + (c0 - OFF_AG) + d] = gelu_tanhf_(v[d]); return; }
    if (c0 < OFF_GV) {
        bool isq = c0 < OFF_GK; int h = isq ? (c0 - OFF_GQ) / 64 : (c0 - OFF_GK) / 64;
        const float* g = (isq ? p.q_norm_g : p.k_norm_g) + l * 64;
        float ss = 0.f; UNROLL for (int d = 0; d < 64; ++d) ss += v[d] * v[d];
        float rs = 1.0f / sqrtf(ss / 64.f + 1e-6f);
        UNROLL for (int d = 0; d < 64; ++d) v[d] = v[d] * rs * g[d];
        if (lat) UNROLL for (int i = 0; i < 32; ++i) { float cs, sn; rope_cs(t, i, 16, cs, sn); float x0 = v[2 * i], x1 = v[2 * i + 1]; v[2 * i] = x0 * cs - x1 * sn; v[2 * i + 1] = x0 * sn + x1 * cs; }
        if (isq) { UNROLL for (int d = 0; d < 64; ++d) p.ZQ[(size_t)r * QP + h * 64 + d] = f2bf(v[d] * QS_G); }
        else { UNROLL for (int d = 0; d < 64; ++d) p.ZK[(size_t)kidx * KP + h * 64 + d] = f2bf(v[d]); }
        return; }
    if (c0 < OFF_DQ) { int h = (c0 - OFF_GV) / 64; UNROLL for (int d = 0; d < 64; ++d) p.ZV[(size_t)kidx * VP + h * 64 + d] = f2bf(v[d]); return; }
    if (c0 < OFF_DV) {
        bool isq = c0 < OFF_DK; int h = isq ? (c0 - OFF_DQ) / 64 : (c0 - OFF_DK) / 64;
        UNROLL for (int m = 0; m < 2; ++m) {
            float* w = v + m * 32;
            if (lat) UNROLL for (int i = 0; i < 16; ++i) { float cs, sn; rope_cs(t, i, 8, cs, sn); float x0 = w[2 * i], x1 = w[2 * i + 1]; w[2 * i] = x0 * cs - x1 * sn; w[2 * i + 1] = x0 * sn + x1 * cs; }
            if (isq) { bf16_t* o = p.ZQ + (size_t)r * QP + (GQA_H + 2 * h + m) * 64; UNROLL for (int d = 0; d < 32; ++d) { o[d] = f2bf(w[d] * QS_D); o[32 + d] = zz; } }
            else { bf16_t* o = p.ZK + (size_t)kidx * KP + (GQA_KV + 2 * h + m) * 64; UNROLL for (int d = 0; d < 32; ++d) { o[d] = f2bf(w[d]); o[32 + d] = zz; } }
        }
        return; }
    { int h = (c0 - OFF_DV) / 64; UNROLL for (int d = 0; d < 64; ++d) p.ZV[(size_t)kidx * VP + (GQA_KV + h) * 64 + d] = f2bf(v[d]); }
}

HD float conv_u(const P& p, int l, int r, int ch) {
    int base, pos, len;
    if (r < NLAT) { base = (r / SEQ) * SEQ; pos = r % SEQ; len = SEQ; } else { int q = r - NLAT; base = NLAT + (q / CTX_LEN) * CTX_LEN; pos = q % CTX_LEN; len = CTX_LEN; }
    float y = p.conv_b[l * LRU_W + ch];
    UNROLL for (int k = 0; k < 4; ++k) { int pp = pos + k - 1; if (pp >= 0 && pp < len) y += p.AX[(size_t)(base + pp) * LRU_W + ch] * p.conv_w[(l * 4 + k) * LRU_W + ch]; }
    return y;
}
HD long n_lru_ab() { return (long)NROW * 2 * LRU_W; }
HD void st_lru_ab(const P& p, int l, long gid) {
    int r = (int)(gid / (2 * LRU_W)), dir = (int)((gid / LRU_W) % 2), ch = (int)(gid % LRU_W);
    int n = ch / LRU_BLK, d = ch % LRU_BLK;
    const float* wa = p.rg_wa + ((size_t)(l * 2 + dir) * 4 + n) * LRU_BLK * LRU_BLK;
    const float* wx = p.rg_wx + ((size_t)(l * 2 + dir) * 4 + n) * LRU_BLK * LRU_BLK;
    float sa = 0.f, sx = 0.f, uc = 0.f;
    for (int c = 0; c < LRU_BLK; ++c) { float u = conv_u(p, l, r, n * LRU_BLK + c); if (c == d) uc = u; sa += u * wa[c * LRU_BLK + d]; sx += u * wx[c * LRU_BLK + d]; }
    float rg = sigmoidf_(sa + p.rg_ba[(l * 2 + dir) * LRU_W + ch]), ig = sigmoidf_(sx + p.rg_bx[(l * 2 + dir) * LRU_W + ch]);
    float log_a = -8.0f * rg * softplusf_(-p.rg_lam[(l * 2 + dir) * LRU_W + ch]);
    float a = expf(log_a), mult = sqrtf(-expm1f(2.f * log_a));
    p.LA[gid] = a; p.LB[gid] = mult * (ig * uc);
}
HD long n_lru_scan() { return (long)BATCH * 2 * LRU_W; }
HD void st_lru_scan(const P& p, long gid) {
    int b = (int)(gid / (2 * LRU_W)), dir = (int)((gid / LRU_W) % 2), ch = (int)(gid % LRU_W);
    float h = 0.f;
    for (int s = 0; s < SKEY; ++s) {
        int r;
        if (dir == 0) r = s < CTX_LEN ? NLAT + b * CTX_LEN + s : b * SEQ + (s - CTX_LEN);
        else r = s < CTX_LEN ? NLAT + b * CTX_LEN + (CTX_LEN - 1 - s) : b * SEQ + (SEQ - 1 - (s - CTX_LEN));
        size_t i = ((size_t)r * 2 + dir) * LRU_W + ch;
        h = p.LA[i] * h + p.LB[i]; p.HS[i] = h;
    }
}

HD long n_att() { return (long)NROW * NVH; }
HD void st_att(const P& p, long gid) {
    int vh = (int)(gid / NROW), r = (int)(gid % NROW);
    int b = r < NLAT ? r / SEQ : (r - NLAT) / CTX_LEN; int nk = r < NLAT ? SKEY : CTX_LEN;
    int kh = vh < GQA_H ? vh / (GQA_H / GQA_KV) : GQA_KV + (vh - GQA_H);
    int vv = vh < GQA_H ? vh / (GQA_H / GQA_KV) : GQA_KV + (vh - GQA_H) / 2;
    float q[64], o[64]; UNROLL for (int d = 0; d < 64; ++d) { q[d] = bf2f(p.ZQ[(size_t)r * QP + vh * 64 + d]); o[d] = 0.f; }
    float m = -1e30f, lsum = 0.f;
    const bf16_t* K = p.ZK + (size_t)b * SKEY * KP + kh * 64; const bf16_t* V = p.ZV + (size_t)b * SKEY * VP + vv * 64;
    for (int j = 0; j < nk; ++j) {
        float s = 0.f; UNROLL for (int d = 0; d < 64; ++d) s += q[d] * bf2f(K[(size_t)j * KP + d]);
        if (s > m) { float f = exp2f(m - s); lsum *= f; UNROLL for (int d = 0; d < 64; ++d) o[d] *= f; m = s; }
        float pr = exp2f(s - m); lsum += pr;
        UNROLL for (int d = 0; d < 64; ++d) o[d] += pr * bf2f(V[(size_t)j * VP + d]);
    }
    float inv = 1.f / lsum;
    if (vh < GQA_H) { UNROLL for (int d = 0; d < 64; ++d) p.Y[(size_t)r * MIX_W + LRU_W + vh * 64 + d] = f2bf(o[d] * inv); }
    else { UNROLL for (int d = 0; d < 64; ++d) p.OD[(size_t)r * ODP + (vh - GQA_H) * 64 + d] = f2bf(o[d] * inv); }
}

HD float diff_lam(const P& p, int l) {
    const float* dl = p.diff_lambda + l * 4 * 32; float s0 = 0.f, s1 = 0.f;
    UNROLL for (int i = 0; i < 32; ++i) { s0 += dl[i] * dl[32 + i]; s1 += dl[64 + i] * dl[96 + i]; }
    float lam_init = 0.8f - 0.6f * expf(-0.3f * (float)l);
    return expf(s0) - expf(s1) + lam_init;
}
HD long n_yasm() { return (long)NROW * (LRU_W / 64 + DIFF_H); }
HD void st_yasm(const P& p, int l, long gid) {
    const int NJ = LRU_W / 64 + DIFF_H; int r = (int)(gid / NJ), job = (int)(gid % NJ);
    if (job < LRU_W / 64) {
        UNROLL for (int d = 0; d < 64; ++d) { int ch = job * 64 + d;
            float h = p.HS[((size_t)r * 2 + 0) * LRU_W + ch] + p.HS[((size_t)r * 2 + 1) * LRU_W + ch];
            p.Y[(size_t)r * MIX_W + ch] = f2bf(p.GA[(size_t)r * LRU_W + ch] * h); }
        return; }
    int h = job - LRU_W / 64; float lam = diff_lam(p, l); float lam_init = 0.8f - 0.6f * expf(-0.3f * (float)l);
    float o[64], ss = 0.f;
    UNROLL for (int d = 0; d < 64; ++d) { o[d] = bf2f(p.OD[(size_t)r * ODP + (2 * h) * 64 + d]) - lam * bf2f(p.OD[(size_t)r * ODP + (2 * h + 1) * 64 + d]); ss += o[d] * o[d]; }
    float rs = 1.0f / sqrtf(ss / 64.f + 1e-6f);
    UNROLL for (int d = 0; d < 64; ++d) p.Y[(size_t)r * MIX_W + LRU_W + GQA_H * 64 + h * 64 + d] = f2bf(o[d] * rs * p.diff_subln_g[l * 64 + d] * (1.f - lam_init));
}

#ifdef CPU_TEST
HD int atomic_inc(int* p_) { int v; _Pragma("omp atomic capture") { v = *p_; *p_ += 1; } return v; }
#else
__device__ __forceinline__ int atomic_inc(int* p_) { return atomicAdd(p_, 1); }
#endif
HD void route_select(const float (&lg)[N_EXP], const float* router_b, int& e1, int& e2, float& gw1, float& gw2) {
    float mx = lg[0]; UNROLL for (int e = 1; e < N_EXP; ++e) mx = fmaxf(mx, lg[e]);
    float pr[N_EXP], sum = 0.f; UNROLL for (int e = 0; e < N_EXP; ++e) { pr[e] = expf(lg[e] - mx); sum += pr[e]; }
    float inv = 1.f / sum;
    UNROLL for (int e = 0; e < N_EXP; ++e) pr[e] *= inv;
    float bs = -1e30f; e1 = 0; e2 = 1; float bp1 = 0.f, bp2 = 0.f;
    UNROLL for (int g = 0; g < 4; ++g) {
        float s1 = -1e30f, p1 = 0.f; int i1 = 0;
        UNROLL for (int i = 0; i < 4; ++i) { float sv = pr[g * 4 + i] + router_b[g * 4 + i]; if (sv > s1) { s1 = sv; i1 = i; p1 = pr[g * 4 + i]; } }
        float s2 = -1e30f, p2 = 0.f; int i2 = 0;
        UNROLL for (int i = 0; i < 4; ++i) { float sv = pr[g * 4 + i] + router_b[g * 4 + i]; if (i != i1 && sv > s2) { s2 = sv; i2 = i; p2 = pr[g * 4 + i]; } }
        float sc = s1 + s2;
        if (sc > bs) { bs = sc; e1 = g * 4 + i1; e2 = g * 4 + i2; bp1 = p1; bp2 = p2; } }
    float ws = bp1 + bp2; gw1 = bp1 / ws; gw2 = bp2 / ws;
}
HD long n_lnroute() { return (long)NROW; }
HD void st_lnroute(const P& p, int l, long gid) {
    int r = (int)gid, who = row_who(r);
    float* xr = p.XR + (size_t)r * D_MODEL; const float* yo = p.YO + (size_t)r * D_MODEL;
    const float *g1 = modp(p, l, who, 2), *sh2 = modp(p, l, who, 3), *sc2 = modp(p, l, who, 4);
    float mu = 0.f; for (int c = 0; c < D_MODEL; ++c) mu += DN_ALPHA * xr[c] + g1[c] * yo[c];
    mu /= D_MODEL; float var = 0.f;
    for (int c = 0; c < D_MODEL; ++c) { float t = DN_ALPHA * xr[c] + g1[c] * yo[c] - mu; var += t * t; }
    float rstd = 1.0f / sqrtf(var / D_MODEL + 1e-6f);
    float lg[N_EXP]; UNROLL for (int e = 0; e < N_EXP; ++e) lg[e] = 0.f;
    for (int c = 0; c < D_MODEL; ++c) {
        float t = DN_ALPHA * xr[c] + g1[c] * yo[c];
        float x1 = (t - mu) * rstd * p.ln1_g[l * D_MODEL + c] + p.ln1_b[l * D_MODEL + c];
        xr[c] = x1; float h2 = x1 * (1.f + sc2[c]) + sh2[c]; p.H[(size_t)r * D_MODEL + c] = f2bf(h2);
        UNROLL for (int e = 0; e < N_EXP; ++e) lg[e] += h2 * p.router_w[c * N_EXP + e]; }
    int e1, e2; float gw1, gw2; route_select(lg, p.router_b, e1, e2, gw1, gw2);
    p.TG[r * 2 + 0] = gw1; p.TG[r * 2 + 1] = gw2;
    int s1 = atomic_inc(p.cnt + CNT_IDX(l, e1)); p.SLOTTOK[(size_t)e1 * NROW + s1] = r * 2 + 0;
    int s2 = atomic_inc(p.cnt + CNT_IDX(l, e2)); p.SLOTTOK[(size_t)e2 * NROW + s2] = r * 2 + 1;
}

HD bool moe_row(const P& p, int l, int i, int& e, int& tok2) {
    int off = 0;
    UNROLL for (int q = 0; q < N_EXP; ++q) { int c = p.cnt[CNT_IDX(l, q)]; int pc = (c + MOE_TM - 1) / MOE_TM * MOE_TM;
        if (i < off + pc) { e = q; int s = i - off; if (s >= c) return false; tok2 = p.SLOTTOK[(size_t)q * NROW + s]; return true; }
        off += pc; }
    return false;
}
HD long n_moe_up() { return (long)MOE_ROWS * (EXP_FF / 4); }
HD void st_moe_up(const P& p, int l, long gid) {
    int i = (int)(gid / (EXP_FF / 4)), j0 = (int)(gid % (EXP_FF / 4)) * 4; int e, tok2;
    if (!moe_row(p, l, i, e, tok2)) return;
    const bf16_t* a = p.H + (size_t)(tok2 >> 1) * D_MODEL; const bf16_t* W = WB_WGU(p.WB[l & 1]) + (size_t)e * 2 * EXP_FF * D_MODEL;
    for (int j = j0; j < j0 + 4; ++j) {
        const bf16_t* wg = W + (size_t)gu_row(0, j) * D_MODEL; const bf16_t* wu = W + (size_t)gu_row(1, j) * D_MODEL;
        float g = 0.f, u = 0.f; for (int k = 0; k < D_MODEL; ++k) { float av = bf2f(a[k]); g += av * bf2f(wg[k]); u += av * bf2f(wu[k]); }
        p.HM[(size_t)i * EXP_FF + j] = f2bf(siluf_(g) * u); }
}
HD long n_moe_down() { return (long)MOE_ROWS * (D_MODEL / 4); }
HD void st_moe_down(const P& p, int l, long gid) {
    int i = (int)(gid / (D_MODEL / 4)), n0 = (int)(gid % (D_MODEL / 4)) * 4; int e, tok2;
    if (!moe_row(p, l, i, e, tok2)) return;
    const bf16_t* a = p.HM + (size_t)i * EXP_FF; const bf16_t* W = WB_WD(p.WB[l & 1]) + (size_t)e * D_MODEL * EXP_FF;
    float gate = p.TG[tok2];
    for (int n = n0; n < n0 + 4; ++n) { const bf16_t* w = W + (size_t)n * EXP_FF; float acc = 0.f; for (int k = 0; k < EXP_FF; ++k) acc += bf2f(a[k]) * bf2f(w[k]);
        p.FO[(size_t)tok2 * D_MODEL + n] = f2bf(acc * gate); }
}

HD long n_lnfinal() { return (long)NROW; }
HD void st_lnfinal(const P& p, int l, long gid) {
    int r = (int)gid, who = row_who(r);
    float* xr = p.XR + (size_t)r * D_MODEL; const bf16_t* f0 = p.FO + (size_t)(r * 2) * D_MODEL; const bf16_t* f1 = f0 + D_MODEL;
    const float* g2 = modp(p, l, who, 5);
    float mu = 0.f; for (int c = 0; c < D_MODEL; ++c) mu += DN_ALPHA * xr[c] + g2[c] * (bf2f(f0[c]) + bf2f(f1[c]));
    mu /= D_MODEL; float var = 0.f;
    for (int c = 0; c < D_MODEL; ++c) { float t = DN_ALPHA * xr[c] + g2[c] * (bf2f(f0[c]) + bf2f(f1[c])) - mu; var += t * t; }
    float rstd = 1.0f / sqrtf(var / D_MODEL + 1e-6f);
    for (int c = 0; c < D_MODEL; ++c) {
        float t = DN_ALPHA * xr[c] + g2[c] * (bf2f(f0[c]) + bf2f(f1[c]));
        float x2 = (t - mu) * rstd * p.ln2_g[l * D_MODEL + c] + p.ln2_b[l * D_MODEL + c];
        xr[c] = x2;
        if (l + 1 < DEPTH) p.H[(size_t)r * D_MODEL + c] = f2bf(x2 * (1.f + modp(p, l + 1, who, 1)[c]) + modp(p, l + 1, who, 0)[c]);
        else if (r < NLAT) p.out[(size_t)r * D_MODEL + c] = x2; }
}
#define NPH_PRE 2
#define NPH_LAYER 11
#define NPH_TOTAL (NPH_PRE + DEPTH * NPH_LAYER)

#define RUN_PHASE(IDX, N, CALL) do { if ((IDX) >= ph_lo && (IDX) < ph_hi) { FOR_GID(N) { CALL; } PHASE_END(); } } while (0)

#define PHASE_PROGRAM(p, ph_lo, ph_hi) do { \
    RUN_PHASE(0, n_ada(), st_ada(p, gid)); \
    RUN_PHASE(1, n_mod0(), st_mod0(p, gid)); \
    for (int l = 0; l < DEPTH; ++l) { const int pb = NPH_PRE + l * NPH_LAYER; \
        RUN_PHASE(pb + 0, n_cvt(), st_cvt(p, l, gid)); \
        RUN_PHASE(pb + 1, n_gemm_in(), st_gemm_in(p, l, gid)); \
        RUN_PHASE(pb + 2, n_post(), st_post(p, l, gid)); \
        RUN_PHASE(pb + 3, n_lru_ab(), st_lru_ab(p, l, gid)); \
        RUN_PHASE(pb + 4, n_lru_scan() + n_att(), { if (gid < n_lru_scan()) st_lru_scan(p, gid); else st_att(p, gid - n_lru_scan()); }); \
        RUN_PHASE(pb + 5, n_yasm(), st_yasm(p, l, gid)); \
        RUN_PHASE(pb + 6, n_gemm_out(), st_gemm_out(p, l, gid)); \
        RUN_PHASE(pb + 7, n_lnroute(), st_lnroute(p, l, gid)); \
        RUN_PHASE(pb + 8, n_moe_up(), st_moe_up(p, l, gid)); \
        RUN_PHASE(pb + 9, n_moe_down(), st_moe_down(p, l, gid)); \
        RUN_PHASE(pb + 10, n_lnfinal(), st_lnfinal(p, l, gid)); \
    } } while (0)

struct WsMap { size_t ctl, mod, wb0, wb1, xr, h, u, zq, zk, zv, ax, ga, y, od, tg, slottok, hm, total; };
static inline size_t al256(size_t v) { return (v + 255) & ~(size_t)255; }
static inline WsMap ws_map() {
    WsMap m; size_t o = 0;
    m.ctl = o; o += al256(1 << 20);
    m.mod = o; o += al256((size_t)DEPTH * 3 * 6 * D_MODEL * 4);
    m.wb0 = o; o += al256(WB_ELEMS * sizeof(bf16_t));
    m.wb1 = o; o += al256(WB_ELEMS * sizeof(bf16_t));
    m.xr = o; o += al256((size_t)NROW * D_MODEL * 4);
    m.h = o; o += al256((size_t)NROW * D_MODEL * sizeof(bf16_t));
    size_t usz = (size_t)NROW * IN_W * 4; size_t u2 = (size_t)NROW * 2 * LRU_W * 4 * 3; if (u2 > usz) usz = u2; size_t u3 = (size_t)NROW * D_MODEL * 4 + (size_t)NROW * 2 * D_MODEL * sizeof(bf16_t); if (u3 > usz) usz = u3;
    m.u = o; o += al256(usz);
    m.zq = o; o += al256((size_t)NROW * QP * sizeof(bf16_t));
    m.zk = o; o += al256((size_t)BATCH * SKEY * KP * sizeof(bf16_t));
    m.zv = o; o += al256((size_t)BATCH * SKEY * VP * sizeof(bf16_t));
    m.ax = o; o += al256((size_t)NROW * LRU_W * 4);
    m.ga = o; o += al256((size_t)NROW * LRU_W * 4);
    m.y = o; o += al256((size_t)NROW * MIX_W * sizeof(bf16_t));
    m.od = o; o += al256((size_t)NROW * ODP * sizeof(bf16_t));
    m.tg = o; o += al256((size_t)NROW * 2 * 4);
    m.slottok = o; o += al256((size_t)N_EXP * NROW * 4);
    m.hm = o; o += al256((size_t)MOE_ROWS * EXP_FF * sizeof(bf16_t));
    m.total = o; return m;
}
#define CTL_CNT_WORD 8192
static inline void fill_ws(P& p, unsigned char* ws) {
    WsMap m = ws_map();
    p.ctl = (unsigned*)(ws + m.ctl); p.cnt = (int*)(p.ctl + CTL_CNT_WORD);
    p.MOD = (float*)(ws + m.mod); p.WB[0] = (bf16_t*)(ws + m.wb0); p.WB[1] = (bf16_t*)(ws + m.wb1);
    p.XR = (float*)(ws + m.xr); p.H = (bf16_t*)(ws + m.h);
    p.Z = (float*)(ws + m.u);
    p.LA = (float*)(ws + m.u); p.LB = p.LA + (size_t)NROW * 2 * LRU_W; p.HS = p.LB + (size_t)NROW * 2 * LRU_W;
    p.YO = (float*)(ws + m.u); p.FO = (bf16_t*)(ws + m.u + (size_t)NROW * D_MODEL * 4);
    p.ZQ = (bf16_t*)(ws + m.zq); p.ZK = (bf16_t*)(ws + m.zk); p.ZV = (bf16_t*)(ws + m.zv);
    p.AX = (float*)(ws + m.ax); p.GA = (float*)(ws + m.ga); p.Y = (bf16_t*)(ws + m.y); p.OD = (bf16_t*)(ws + m.od);
    p.TG = (float*)(ws + m.tg); p.SLOTTOK = (int*)(ws + m.slottok); p.HM = (bf16_t*)(ws + m.hm); p.XRo = p.XR; p.Ho = p.H; p.TGo = p.TG; p.SLOTTOKo = p.SLOTTOK; p.cnto = p.cnt; p.pad_[0] = 0; p.pad_[1] = 0;
}
static inline void fill_inputs(P& p, void* const* d_in, void* d_out) {
    const float** f = (const float**)d_in;
    p.x = f[0]; p.c = f[1]; p.ctx = f[2]; p.c_ctx = f[3]; p.ada_w = f[4]; p.ada_b = f[5]; p.w_in = f[6]; p.conv_w = f[7]; p.conv_b = f[8];
    p.rg_wa = f[9]; p.rg_ba = f[10]; p.rg_wx = f[11]; p.rg_bx = f[12]; p.rg_lam = f[13]; p.q_norm_g = f[14]; p.k_norm_g = f[15];
    p.diff_lambda = f[16]; p.diff_subln_g = f[17]; p.w_out = f[18]; p.ln1_g = f[19]; p.ln1_b = f[20]; p.ln2_g = f[21]; p.ln2_b = f[22];
    p.router_w = f[23]; p.router_b = f[24]; p.exp_w_gate = f[25]; p.exp_w_up = f[26]; p.exp_w_down = f[27]; p.out = (float*)d_out;
}
constexpr int NTHR = 512;
constexpr int LDS_RING = 131072;
constexpr int LDS_BYTES = 147456;
constexpr int LDS_MISC = LDS_RING;
template <int CTRL> __device__ __forceinline__ float dpp_mov(float v) { return __builtin_bit_cast(float, __builtin_amdgcn_update_dpp(0, __builtin_bit_cast(int, v), CTRL, 0xf, 0xf, true)); }
#define DPP_XOR1 0xB1
#define DPP_XOR2 0x4E
#define DPP_HMIR 0x141
#define DPP_MIR  0x140
__device__ __forceinline__ float swap16_sum(float v) { auto rr = __builtin_amdgcn_permlane16_swap(__float_as_uint(v), __float_as_uint(v), false, false); return __uint_as_float(rr[0]) + __uint_as_float(rr[1]); }
__device__ __forceinline__ float swap32_sum(float v) { auto rr = __builtin_amdgcn_permlane32_swap(__float_as_uint(v), __float_as_uint(v), false, false); return __uint_as_float(rr[0]) + __uint_as_float(rr[1]); }
__device__ __forceinline__ float swap16_max(float v) { auto rr = __builtin_amdgcn_permlane16_swap(__float_as_uint(v), __float_as_uint(v), false, false); return fmaxf(__uint_as_float(rr[0]), __uint_as_float(rr[1])); }
__device__ __forceinline__ float swap32_max(float v) { auto rr = __builtin_amdgcn_permlane32_swap(__float_as_uint(v), __float_as_uint(v), false, false); return fmaxf(__uint_as_float(rr[0]), __uint_as_float(rr[1])); }
__device__ __forceinline__ float row16_sum(float v) { v += dpp_mov<DPP_XOR1>(v); v += dpp_mov<DPP_XOR2>(v); v += dpp_mov<DPP_HMIR>(v); v += dpp_mov<DPP_MIR>(v); return v; }
__device__ __forceinline__ float half32_sum(float v) { return swap16_sum(row16_sum(v)); }
__device__ __forceinline__ float wave_sum(float v) { return swap32_sum(swap16_sum(row16_sum(v))); }
__device__ __forceinline__ float xor32_get(float v, bool upper) { auto rr = __builtin_amdgcn_permlane32_swap(__float_as_uint(v), __float_as_uint(v), false, false); return __uint_as_float(upper ? rr[0] : rr[1]); }
#define XB_TMO      128
#define XB_XCNT(j)  (256  + 64 * (j))
#define XB_XSUB(j)  (1280 + 64 * (j))
#define XB_XGEN(j)  (2304 + 64 * (j))
#define XB_TOP      3328
#define XB_TOPGEN   3392
#define XCD_BAR_WORDS 3456
#define XB_SPIN_CAP (1u << 21)
#define LAS __attribute__((address_space(3)))

__device__ __forceinline__ unsigned xb_ld(unsigned* p)              { return __hip_atomic_load(p, __ATOMIC_RELAXED, __HIP_MEMORY_SCOPE_AGENT); }
__device__ __forceinline__ unsigned xb_add(unsigned* p, unsigned v) { return __hip_atomic_fetch_add(p, v, __ATOMIC_RELAXED, __HIP_MEMORY_SCOPE_AGENT); }
__device__ __forceinline__ unsigned xb_xcc_id() { return (unsigned)__builtin_amdgcn_s_getreg((3 << 11) | 20) & 0xFu; }
#define XB_SPIN(cond, bar) do { unsigned _sp = 0; while (cond) { __builtin_amdgcn_s_sleep(1); \
    if ((++_sp & 255u) == 0u) { if (xb_ld(&(bar)[XB_TMO])) break; if (_sp > XB_SPIN_CAP) { atomicAdd(&(bar)[XB_TMO], 1u); break; } } } } while (0)

struct XcdBarrier {
    unsigned* bar; unsigned x;
    volatile LAS unsigned* st;
};

__device__ __forceinline__ XcdBarrier xcd_barrier_post(unsigned* bar, volatile LAS unsigned* st) {
    XcdBarrier b; b.bar = bar; b.x = xb_xcc_id(); b.st = st;
    if (threadIdx.x == 0) (void)xb_add(&bar[XB_XCNT(b.x)], 1u);
    return b;
}
__device__ __forceinline__ void xcd_barrier_complete(unsigned* bar, unsigned x, unsigned& nloc, unsigned& nx) {
    const unsigned G = gridDim.x * gridDim.y * gridDim.z;
    unsigned sum, cnt, mine, sp = 0u;
    for (;;) {
        sum = 0u; cnt = 0u; mine = 0u;
#pragma unroll
        for (unsigned j = 0; j < 16; ++j) { const unsigned c = xb_ld(&bar[XB_XCNT(j)]); sum += c; cnt += (c > 0u) ? 1u : 0u; mine = (j == x) ? c : mine; }
        if (sum == G) break;
        __builtin_amdgcn_s_sleep(1);
        if ((++sp & 255u) == 0u) { if (xb_ld(&bar[XB_TMO])) break; if (sp > XB_SPIN_CAP) { atomicAdd(&bar[XB_TMO], 1u); break; } }
    }
    nloc = mine > 0u ? mine : 1u; nx = cnt > 0u ? cnt : 1u;
}

__device__ __forceinline__ void xcd_barrier(const XcdBarrier& b) {
    asm volatile("s_waitcnt vmcnt(0)" ::: "memory");
    __syncthreads();
    if (threadIdx.x == 0) {
        unsigned* bar = b.bar;
        __builtin_amdgcn_s_waitcnt(0);
        unsigned nloc = b.st[0], nx = b.st[1];
        if (nloc == 0u) { xcd_barrier_complete(bar, b.x, nloc, nx); b.st[0] = nloc; b.st[1] = nx; }
        const unsigned old = xb_add(&bar[XB_XSUB(b.x)], 1u);
        const unsigned gen = old / nloc;
        if (old + 1u == (gen + 1u) * nloc) {
            __builtin_amdgcn_fence(__ATOMIC_RELEASE, "agent");
            asm volatile("s_waitcnt vmcnt(0)" ::: "memory");
            const unsigned og = xb_add(&bar[XB_TOP], 1u);
            const unsigned tg = og / nx;
            if (og + 1u == (tg + 1u) * nx) xb_add(&bar[XB_TOPGEN], 1u);
            else XB_SPIN(xb_ld(&bar[XB_TOPGEN]) == tg, bar);
            __builtin_amdgcn_fence(__ATOMIC_ACQUIRE, "agent");
            xb_add(&bar[XB_XGEN(b.x)], 1u);
            asm volatile("s_waitcnt vmcnt(0)" ::: "memory");
        } else {
            XB_SPIN(xb_ld(&bar[XB_XGEN(b.x)]) == gen, bar);
            __builtin_amdgcn_fence(__ATOMIC_ACQUIRE, "agent");
            asm volatile("s_waitcnt vmcnt(0)" ::: "memory");
        }
    }
    __syncthreads();
}

#include <hip/hip_bf16.h>
#include <cmath>
namespace attn_body {
using bf16=__hip_bfloat16;
using bf16x8=__attribute__((ext_vector_type(8)))short;
using s16x4=__attribute__((ext_vector_type(4)))short;
using f32x16=__attribute__((ext_vector_type(16)))float;
using u32x4=__attribute__((ext_vector_type(4)))unsigned;
constexpr int D=64;
constexpr int NW=8,QBLK=32,QB=QBLK*NW,KVBLK=64;
constexpr int ATTN_UNIT_ROWS=QB;
__device__ __forceinline__ int crow(int r,int hi){return (r&3)+8*(r>>2)+4*hi;}
#define SBAR() __builtin_amdgcn_sched_barrier(0)
__device__ __forceinline__ void cmask(f32x16&p0,f32x16&p1,int jb,int qrel,int hi){
  const float NEG=-INFINITY; int kb=64*jb+4*hi;
  #pragma unroll
  for(int r=0;r<16;++r){int kv=kb+(r&3)+8*(r>>2); if(kv>qrel)p0[r]=NEG; if(kv+32>qrel)p1[r]=NEG;}
}

constexpr int NSLOT=3, SLOTB=8192;
constexpr int LDS_K=0, LDS_V=NSLOT*SLOTB, LDS_WS=2*NSLOT*SLOTB, LDS_OST=LDS_WS+NW*64*4, LDS_BYTES=LDS_OST+NW*4096;
constexpr float C2=0.125f*1.4426950408889634f;
__device__ __forceinline__ void glds16(const void*gsrc,unsigned lds_dst){unsigned keep;
  asm volatile("s_mov_b32 %0, m0\n\ts_mov_b32 m0, %2\n\ts_nop 0\n\tglobal_load_lds_dwordx4 %1, off\n\ts_mov_b32 m0, %0":"=&s"(keep):"v"(gsrc),"s"(lds_dst):"memory");}
__device__ __forceinline__ float max3f(float a,float b,float c){float r;asm("v_max3_f32 %0, %1, %2, %3":"=v"(r):"v"(a),"v"(b),"v"(c));return r;}
__device__ __forceinline__ float max2f(float a,float b){float r;asm("v_max_f32_e32 %0, %1, %2":"=v"(r):"v"(a),"v"(b));return r;}
__device__ __forceinline__ float fadd_s(float a,float b){float r;asm("v_add_f32_e32 %0, %1, %2":"=v"(r):"v"(a),"v"(b));return r;}
__device__ __forceinline__ float fsub_s(float a,float b){float r;asm("v_sub_f32_e32 %0, %1, %2":"=v"(r):"v"(a),"v"(b));return r;}
typedef float f32x2_t __attribute__((ext_vector_type(2))); typedef __bf16 bf16x2_t __attribute__((ext_vector_type(2)));
__device__ __forceinline__ unsigned cvtpk_s(float lo,float hi){f32x2_t v={lo,hi};bf16x2_t b=__builtin_convertvector(v,bf16x2_t);return __builtin_bit_cast(unsigned,b);}
#define WAIT_BAR(N) asm volatile("s_waitcnt vmcnt(" #N ") lgkmcnt(0)\n\ts_barrier":::"memory")

template<int ND> __device__ __forceinline__ void qkt(f32x16&p0,f32x16&p1,const char*Kslot,const bf16x8*qr,const f32x16&negm,int r32,int hi){
  const char*kb=Kslot+hi*1024+r32*16;
  #pragma unroll
  for(int d0=0;d0<ND;++d0){
    const bf16x8 b0=*reinterpret_cast<const bf16x8*>(kb+d0*2048);
    const bf16x8 b1=*reinterpret_cast<const bf16x8*>(kb+d0*2048+512);
    if(d0==0){p0=__builtin_amdgcn_mfma_f32_32x32x16_bf16(b0,qr[0],negm,0,0,0);p1=__builtin_amdgcn_mfma_f32_32x32x16_bf16(b1,qr[0],negm,0,0,0);}
    else{p0=__builtin_amdgcn_mfma_f32_32x32x16_bf16(b0,qr[d0],p0,0,0,0);p1=__builtin_amdgcn_mfma_f32_32x32x16_bf16(b1,qr[d0],p1,0,0,0);}}
}
typedef __attribute__((address_space(3))) const char* lds_cptr;
typedef short v4i16_t __attribute__((ext_vector_type(4)));
__device__ __forceinline__ void kload8(bf16x8*kf,lds_cptr kp){
  kf[0]=*(const __attribute__((address_space(3))) bf16x8*)(kp);      kf[1]=*(const __attribute__((address_space(3))) bf16x8*)(kp+512);
  kf[2]=*(const __attribute__((address_space(3))) bf16x8*)(kp+2048); kf[3]=*(const __attribute__((address_space(3))) bf16x8*)(kp+2560);
  kf[4]=*(const __attribute__((address_space(3))) bf16x8*)(kp+4096); kf[5]=*(const __attribute__((address_space(3))) bf16x8*)(kp+4608);
  kf[6]=*(const __attribute__((address_space(3))) bf16x8*)(kp+6144); kf[7]=*(const __attribute__((address_space(3))) bf16x8*)(kp+6656);
}
__device__ __forceinline__ void kload2(bf16x8*kf,lds_cptr kp,int j){ kf[2*j]=*(const __attribute__((address_space(3))) bf16x8*)(kp+j*2048); kf[2*j+1]=*(const __attribute__((address_space(3))) bf16x8*)(kp+j*2048+512); }
__device__ __forceinline__ s16x4 vtr(lds_cptr p){ return __builtin_bit_cast(s16x4,__builtin_amdgcn_ds_read_tr16_b64_v4i16((__attribute__((address_space(3))) v4i16_t*)p)); }
__device__ __forceinline__ float rowmax(const f32x16&p0,const f32x16&p1){
  float a=max3f(p0[0],p0[1],p1[0]),b=max3f(p0[2],p0[3],p1[1]);a=max3f(a,p1[2],p1[3]);
  #pragma unroll
  for(int r=4;r<16;r+=4){a=max3f(a,p0[r],p0[r+1]);b=max3f(b,p0[r+2],p0[r+3]);a=max3f(a,p1[r],p1[r+1]);b=max3f(b,p1[r+2],p1[r+3]);}
  const float m=max2f(a,b);
  auto rr=__builtin_amdgcn_permlane32_swap(__float_as_uint(m),__float_as_uint(m),false,false);
  return max2f(__uint_as_float(rr[0]),__uint_as_float(rr[1]));
}
__device__ __forceinline__ void pv(f32x16*o,int vb,bf16x8 pa0,bf16x8 pa1,bf16x8 pa2,bf16x8 pa3){
  #pragma unroll
  for(int d0=0;d0<2;++d0){s16x4 lo[4],hi[4];
    #pragma unroll
    for(int ks=0;ks<4;++ks){
      asm volatile("ds_read_b64_tr_b16 %0,%1 offset:%c2":"=&v"(lo[ks]):"v"(vb),"i"(d0*4096+ks*1024):"memory");
      asm volatile("ds_read_b64_tr_b16 %0,%1 offset:%c2":"=&v"(hi[ks]):"v"(vb),"i"(d0*4096+ks*1024+512):"memory");}
    asm volatile("s_waitcnt lgkmcnt(0)":::"memory");SBAR();
    #define PK(k) (bf16x8){lo[k][0],lo[k][1],lo[k][2],lo[k][3],hi[k][0],hi[k][1],hi[k][2],hi[k][3]}
    o[d0]=__builtin_amdgcn_mfma_f32_32x32x16_bf16(pa0,PK(0),o[d0],0,0,0);
    o[d0]=__builtin_amdgcn_mfma_f32_32x32x16_bf16(pa1,PK(1),o[d0],0,0,0);
    o[d0]=__builtin_amdgcn_mfma_f32_32x32x16_bf16(pa2,PK(2),o[d0],0,0,0);
    o[d0]=__builtin_amdgcn_mfma_f32_32x32x16_bf16(pa3,PK(3),o[d0],0,0,0);
    #undef PK
  }
}

#ifndef ATTN_STORE16
#define ATTN_STORE16(p,v) (*(u32x4*)(p)=(v))
#endif
template<int THRL,int QPITCH,int KPITCH,int VPITCH,int OPITCH,bool HALFK,bool NOMAX> __device__ __forceinline__ void attn_unit(const bf16*Qu,const bf16*__restrict__ Kh,const bf16*__restrict__ Vh,bf16*Ou,const int NT,char*shm,const bf16*Knext=nullptr,const bool kpre=false){
  int tid_l=threadIdx.x; asm volatile("":"+v"(tid_l)); const int tid=tid_l,lane=tid&63,r32=lane&31,hi=lane>>5; const int wid=__builtin_amdgcn_readfirstlane(tid>>6);
  const bf16*Qw=Qu+(long)(wid*QBLK)*QPITCH;
  const unsigned lds0=(unsigned)(uintptr_t)shm;
  float*wsf=(float*)(shm+LDS_WS)+wid*64;
  const bf16*ksrc=Kh+(long)lane*KPITCH+wid*8;
  const bf16*vsrc=Vh+(long)(16*(wid&3)+(lane>>2))*VPITCH+(wid>>2)*32+(lane&3)*8;
  const unsigned kdst=lds0+LDS_K+wid*1024, vdst=lds0+LDS_V+wid*1024;
  #define DMA_K(t,slot) glds16(ksrc+(long)(t)*KVBLK*KPITCH,(unsigned)__builtin_amdgcn_readfirstlane(kdst+(slot)))
  #define DMA_V(t,slot) glds16(vsrc+(long)(t)*KVBLK*VPITCH,(unsigned)__builtin_amdgcn_readfirstlane(vdst+(slot)))
  const int vb0=(int)(lds0+LDS_V)+((lane>>4)&1)*32+(lane&3)*8+(4*hi+((lane&15)>>2))*64;
  const char*Kbase=shm+LDS_K; bf16x8 kf[8];
  const lds_cptr shm3=(lds_cptr)shm; const lds_cptr kp0=shm3+LDS_K+hi*1024+r32*16; const lds_cptr vp0=shm3+LDS_V+((lane>>4)&1)*32+(lane&3)*8+(4*hi+((lane&15)>>2))*64;
  if(!kpre){DMA_K(0,0);DMA_V(0,0);DMA_K(1,SLOTB);}
  bf16x8 qr[4];
  #pragma unroll
  for(int d0=0;d0<4;++d0)qr[d0]=*reinterpret_cast<const bf16x8*>(&Qw[(long)r32*QPITCH+d0*16+hi*8]);
  float mhat=0.f,l_reg=0.f;f32x16 o[2];o[0]=f32x16{};o[1]=f32x16{};f32x16 negm=f32x16{};asm volatile("":"+v"(negm));
  #define CMASK(P0,P1,t) do{}while(0)
  bool resc=false;
  #define START(P0,P1) do{ resc=false; \
    if constexpr(!NOMAX){ const float rm=rowmax(P0,P1); const float dl=rm; mhat=fadd_s(mhat,dl); \
      _Pragma("unroll") for(int r=0;r<16;++r){P0[r]=fsub_s(P0[r],dl);P1[r]=fsub_s(P1[r],dl);} \
      _Pragma("unroll") for(int r=0;r<16;++r)negm[r]=-mhat; asm volatile("":"+v"(negm)); } \
    _Pragma("unroll") for(int r=0;r<16;++r)P0[r]=__builtin_amdgcn_exp2f(P0[r]); }while(0)
  #define RESC() do{ if(resc){ asm volatile("s_waitcnt lgkmcnt(0)":::"memory"); \
      _Pragma("unroll") for(int d_=0;d_<2;++d_) _Pragma("unroll") for(int r=0;r<16;++r)o[d_][r]*=wsf[crow(r,hi)]; } }while(0)
  f32x16 pA0,pA1,pB0,pB1;
  int sl_prev=0,sl_cur=0,sl_next=SLOTB;
  #define ROT() do{sl_prev=sl_cur;sl_cur=sl_next;sl_next=(sl_next==(NSLOT-1)*SLOTB)?0:sl_next+SLOTB;}while(0)
  if(!kpre){ DMA_K(2,2*SLOTB);
    WAIT_BAR(3); }
  else{ DMA_V(0,0); WAIT_BAR(1); }
  qkt<(HALFK?2:4)>(pA0,pA1,Kbase,qr,negm,r32,hi);asm volatile("s_nop 15\n\ts_nop 7":"+v"(pA0),"+v"(pA1));CMASK(pA0,pA1,0);
  START(pA0,pA1);
  _Pragma("unroll") for(int r=0;r<16;++r)pA1[r]=__builtin_amdgcn_exp2f(pA1[r]);
  WAIT_BAR(0);
  DMA_K(3,0);DMA_V(1,SLOTB);
  ROT();
  if constexpr(HALFK){kload2(kf,kp0+sl_cur,0);kload2(kf,kp0+sl_cur,1);}else kload8(kf,kp0+sl_cur);
  WAIT_BAR(2);
  s16x4 vlo[8],vhi[8]; u32x4 pw0,pw1,pw2,pw3;
  #define PKW(P,B) cvtpk_s(P[B],P[B+1])
  #define PAF(k) __builtin_bit_cast(bf16x8,pw##k)
  #define VFR(i) (bf16x8){vlo[i][0],vlo[i][1],vlo[i][2],vlo[i][3],vhi[i][0],vhi[i][1],vhi[i][2],vhi[i][3]}
  #define PIN(x) asm volatile("":"+v"(x))
  #define MX3(a,b,c) __builtin_fmaxf(__builtin_fmaxf((a),(b)),(c))
  #define GAPA(MF,A0,A1,A2,A3,W0,W1,PW) do{ MF; sacc+=A0; sacc+=A1; sacc+=A2; sacc+=A3; PIN(sacc); W0; W1; PIN(PW); SBAR(); }while(0)
  #define EX(v) __builtin_amdgcn_exp2f(v)
  #define GAPB(MF,X,B) do{ MF; X[B]=EX(X[B]); X[B+1]=EX(X[B+1]); X[B+2]=EX(X[B+2]); X[B+3]=EX(X[B+3]); PIN(X); SBAR(); }while(0)
  #define VRD(i) do{ vlo[i]=vtr(vp_+(((i)>>2)*4096+((i)&3)*1024)); vhi[i]=vtr(vp_+(((i)>>2)*4096+((i)&3)*1024+512)); }while(0)
  #define KRD(G,j) do{ if(G){ kload2(kf,kp0+sl_next,j); SBAR(); } }while(0)
  #define STEP(C0,C1,P0,P1,t,GK,GV,GL) do{ SBAR(); \
    const lds_cptr vp_=vp0+sl_prev; \
    VRD(0); SBAR(); float sacc=(P0[0]+P0[1]); \
    GAPA(C0=__builtin_amdgcn_mfma_f32_32x32x16_bf16(kf[0],qr[0],negm,0,0,0), P0[2],P0[3],P0[4],P0[5],     pw0[0]=PKW(P0,0), pw0[1]=PKW(P0,2), pw0); \
    VRD(4); SBAR(); GAPA(C1=__builtin_amdgcn_mfma_f32_32x32x16_bf16(kf[1],qr[0],negm,0,0,0), P0[6],P0[7],P0[8],P0[9],     pw0[2]=PKW(P0,4), pw0[3]=PKW(P0,6), pw0); \
    VRD(1); SBAR(); GAPA(C0=__builtin_amdgcn_mfma_f32_32x32x16_bf16(kf[2],qr[1],C0,0,0,0),   P0[10],P0[11],P0[12],P0[13], pw1[0]=PKW(P0,8), pw1[1]=PKW(P0,10), pw1); \
    VRD(5); SBAR(); GAPA(C1=__builtin_amdgcn_mfma_f32_32x32x16_bf16(kf[3],qr[1],C1,0,0,0),   P0[14],P0[15],P1[0],P1[1],   pw1[2]=PKW(P0,12),pw1[3]=PKW(P0,14), pw1); \
    VRD(2); SBAR(); GAPA(if constexpr(!HALFK)C0=__builtin_amdgcn_mfma_f32_32x32x16_bf16(kf[4],qr[2],C0,0,0,0),   P1[2],P1[3],P1[4],P1[5],     pw2[0]=PKW(P1,0), pw2[1]=PKW(P1,2), pw2); \
    VRD(6); SBAR(); GAPA(if constexpr(!HALFK)C1=__builtin_amdgcn_mfma_f32_32x32x16_bf16(kf[5],qr[2],C1,0,0,0),   P1[6],P1[7],P1[8],P1[9],     pw2[2]=PKW(P1,4), pw2[3]=PKW(P1,6), pw2); \
    VRD(3); SBAR(); GAPA(if constexpr(!HALFK)C0=__builtin_amdgcn_mfma_f32_32x32x16_bf16(kf[6],qr[3],C0,0,0,0),   P1[10],P1[11],P1[12],P1[13], pw3[0]=PKW(P1,8), pw3[1]=PKW(P1,10), pw3); \
    VRD(7); SBAR(); GAPA(if constexpr(!HALFK)C1=__builtin_amdgcn_mfma_f32_32x32x16_bf16(kf[7],qr[3],C1,0,0,0),   P1[14],P1[15],0.f,0.f,       pw3[2]=PKW(P1,12),pw3[3]=PKW(P1,14), pw3); \
    l_reg+=sacc; \
    if(GK){DMA_K((t)+3,sl_cur);} if(GV){DMA_V((t)+1,sl_next);} \
    CMASK(C0,C1,t); \
    if constexpr(!NOMAX){ float a=MX3(C0[0],C0[1],C1[0]),b=MX3(C0[2],C0[3],C1[1]); a=MX3(a,C1[2],C1[3]); \
      _Pragma("unroll") for(int r=4;r<16;r+=4){a=MX3(a,C0[r],C0[r+1]);b=MX3(b,C0[r+2],C0[r+3]);a=MX3(a,C1[r],C1[r+1]);b=MX3(b,C1[r+2],C1[r+3]);} \
      float rm=__builtin_fmaxf(a,b); { auto rr=__builtin_amdgcn_permlane32_swap(__float_as_uint(rm),__float_as_uint(rm),false,false); rm=__builtin_fmaxf(__uint_as_float(rr[0]),__uint_as_float(rr[1])); } \
      resc=false; \
      if(__builtin_expect(__any(rm>(float)THRL),0)){ const float dl=__builtin_fmaxf(rm,0.f); mhat+=dl; \
        _Pragma("unroll") for(int r=0;r<16;++r){C0[r]-=dl;C1[r]-=dl;} \
        _Pragma("unroll") for(int r=0;r<16;++r)negm[r]=-mhat; asm volatile("":"+v"(negm)); \
        const float f=__builtin_amdgcn_exp2f(-dl); l_reg*=f; if(hi==0)wsf[r32]=f; resc=true; } } \
    SBAR(); \
    GAPB(o[0]=__builtin_amdgcn_mfma_f32_32x32x16_bf16(PAF(0),VFR(0),o[0],0,0,0), C0,0); \
    GAPB(o[1]=__builtin_amdgcn_mfma_f32_32x32x16_bf16(PAF(0),VFR(4),o[1],0,0,0), C0,4); \
    KRD(GL,0); GAPB(o[0]=__builtin_amdgcn_mfma_f32_32x32x16_bf16(PAF(1),VFR(1),o[0],0,0,0), C0,8); \
    KRD(GL,1); GAPB(o[1]=__builtin_amdgcn_mfma_f32_32x32x16_bf16(PAF(1),VFR(5),o[1],0,0,0), C0,12); \
    KRD(GL&&!HALFK,2); GAPB(o[0]=__builtin_amdgcn_mfma_f32_32x32x16_bf16(PAF(2),VFR(2),o[0],0,0,0), C1,0); \
    KRD(GL&&!HALFK,3); GAPB(o[1]=__builtin_amdgcn_mfma_f32_32x32x16_bf16(PAF(2),VFR(6),o[1],0,0,0), C1,4); \
    GAPB(o[0]=__builtin_amdgcn_mfma_f32_32x32x16_bf16(PAF(3),VFR(3),o[0],0,0,0), C1,8); \
    GAPB(o[1]=__builtin_amdgcn_mfma_f32_32x32x16_bf16(PAF(3),VFR(7),o[1],0,0,0), C1,12); \
    }while(0)
  int t=1;
  #undef CMASK
  #define CMASK(P0,P1,t) do{}while(0)
  for(;t+5<NT;t+=2){
    STEP(pB0,pB1,pA0,pA1,t,true,true,true);     WAIT_BAR(2); RESC(); ROT();
    STEP(pA0,pA1,pB0,pB1,t+1,true,true,true);   WAIT_BAR(2); RESC(); ROT();
  }
  #undef CMASK
  #define CMASK(P0,P1,t) do{}while(0)
  #define ENDW(tt) do{ if((tt)+3<NT){WAIT_BAR(2);} else if((tt)+2<NT){WAIT_BAR(1);} else {WAIT_BAR(0);} }while(0)
  for(;t+1<NT;t+=2){
    STEP(pB0,pB1,pA0,pA1,t,(t+3<NT),(t+1<NT),(t+1<NT));       ENDW(t);   RESC(); ROT();
    STEP(pA0,pA1,pB0,pB1,t+1,(t+4<NT),(t+2<NT),(t+2<NT));     ENDW(t+1); RESC(); ROT();
  }
  STEP(pB0,pB1,pA0,pA1,NT-1,false,false,false); RESC();
  if(Knext){ const bf16*kn=Knext+(long)lane*KPITCH+wid*8;
    glds16(kn,(unsigned)__builtin_amdgcn_readfirstlane(kdst)); glds16(kn+(long)KVBLK*KPITCH,(unsigned)__builtin_amdgcn_readfirstlane(kdst+SLOTB)); glds16(kn+(long)2*KVBLK*KPITCH,(unsigned)__builtin_amdgcn_readfirstlane(kdst+2*SLOTB)); }
  { float sacc=pB0[0]+pB0[1]; _Pragma("unroll") for(int r=2;r<16;++r)sacc+=pB0[r]; _Pragma("unroll") for(int r=0;r<16;++r)sacc+=pB1[r]; l_reg+=sacc;
    pw0=(u32x4){PKW(pB0,0),PKW(pB0,2),PKW(pB0,4),PKW(pB0,6)};pw1=(u32x4){PKW(pB0,8),PKW(pB0,10),PKW(pB0,12),PKW(pB0,14)};pw2=(u32x4){PKW(pB1,0),PKW(pB1,2),PKW(pB1,4),PKW(pB1,6)};pw3=(u32x4){PKW(pB1,8),PKW(pB1,10),PKW(pB1,12),PKW(pB1,14)};
    SBAR(); pv(o,vb0+sl_cur,PAF(0),PAF(1),PAF(2),PAF(3)); }
  #undef PKW
  #undef PAF
  #undef VFR
  #undef PIN
  #undef MX3
  #undef GAPA
  #undef GAPB
  #undef EX
  #undef VRD
  #undef KRD
  #undef STEP
  #undef ENDW
  {auto rr=__builtin_amdgcn_permlane32_swap(__float_as_uint(l_reg),__float_as_uint(l_reg),false,false);l_reg=__uint_as_float(rr[0])+__uint_as_float(rr[1]);}
  if(hi==0)wsf[32+r32]=l_reg;asm volatile("s_waitcnt lgkmcnt(0)":::"memory");
  float rli[16];
  #pragma unroll
  for(int r=0;r<16;++r)rli[r]=__builtin_amdgcn_rcpf(wsf[32+crow(r,hi)]);
  bf16*Ow=Ou+(long)(wid*QBLK)*OPITCH;
  { bf16*stg=(bf16*)(shm+LDS_OST)+wid*2048;
    #pragma unroll
    for(int r=0;r<16;++r){const int orow=crow(r,hi);
      #pragma unroll
      for(int d0=0;d0<2;++d0)stg[orow*64+d0*32+r32]=__float2bfloat16(o[d0][r]*rli[r]);}
    asm volatile("s_waitcnt lgkmcnt(0)":::"memory");
    #pragma unroll
    for(int i=0;i<4;++i){const int row=i*8+(lane>>3),ch=lane&7; const u32x4 v=*(const u32x4*)(stg+row*64+ch*8); ATTN_STORE16(Ow+(long)row*OPITCH+ch*8,v);} }
  asm volatile("s_waitcnt lgkmcnt(0)\n\ts_barrier":::"memory");
  #undef DMA_K
  #undef DMA_V
  #undef CMASK
  #undef START
  #undef RESC
  #undef ROT
}
constexpr int ATTN_LDS_BYTES=LDS_BYTES;
#undef SBAR
#undef WAIT_BAR
}
namespace pg8 {
#define PG8_LAS __attribute__((address_space(3)))
typedef unsigned short bf16_t;
typedef short bf16x8 __attribute__((ext_vector_type(8)));
typedef float f32x4 __attribute__((ext_vector_type(4)));
typedef unsigned u32x4 __attribute__((ext_vector_type(4)));
constexpr int BM = 256, BK = 64, HALF = 128, HTB = HALF * BK * 2  , STAGE_BYTES = 8 * HTB, NXCD = 8, WGM = 8;

__host__ __device__ __forceinline__ int lds_byte(int r, int c) { const int st = (r >> 4) * 2 + (c >> 5), rr = r & 15, cc = c & 31, ob = rr * 64 + cc * 2; return st * 1024 + (ob ^ (((ob >> 9) & 1) << 5)); }
__host__ __device__ __forceinline__ void stage_rc(int b, int& R, int& C) { const int st = b / 1024, sb = b % 1024, swz = sb ^ (((sb >> 9) & 1) << 5); R = (st >> 1) * 16 + swz / 64; C = (st & 1) * 32 + (swz % 64) / 2; }
__host__ __device__ __forceinline__ int perm32(int rho) { const int n = rho >> 4, i = rho & 15; return 8 * (i >> 2) + 4 * n + (i & 3); }

struct Unit { int pm, pn, aux; };
__device__ __forceinline__ unsigned cvt_pk_bf16(float lo, float hi) { unsigned r; asm volatile("v_cvt_pk_bf16_f32 %0, %1, %2" : "=v"(r) : "v"(lo), "v"(hi)); return r; }
typedef float f32x2 __attribute__((ext_vector_type(2)));
template <class Epi, class Sched, bool ALIGN_EPI = false, bool SP2 = false>
__device__ __forceinline__ void gemm_phase(PG8_LAS unsigned char* lds, const int K, const Sched& S, const Epi& E) {
    int tid_l = threadIdx.x; asm volatile("" : "+v"(tid_l));
    const int tid = tid_l, wid = __builtin_amdgcn_readfirstlane(tid >> 6), lane = tid & 63, wr = wid >> 2, wc = wid & 3, fr = lane & 15, fq = lane >> 4;
    const int nt = K / BK;
    unsigned voffB[2]; int stR[2], stC[2];
#pragma unroll
    for (int i = 0; i < 2; ++i) { int R, C; stage_rc(tid * 16 + i * 8192, R, C); const int Rb = Epi::PERM ? ((R & ~31) + perm32(R & 31)) : R;
        stR[i] = R; stC[i] = C; voffB[i] = (unsigned)(Rb * K + C) * 2u; }
    const size_t kstep = (size_t)(BK * 2);
    const size_t hstep = (size_t)HALF * K * 2;
    const unsigned ldsw = (unsigned)wid * 1024u;
    const int aoff = lds_byte(wr * 64 + fr, fq * 8), boff = lds_byte(wc * 32 + fr, fq * 8);
#define PG8_SA(b, h) (((b) * 2 + (h)) * HTB)
#define PG8_SB(b, h) ((4 + (b) * 2 + (h)) * HTB)
#define PG8_STAGE(bufoff, gbase, voff) do { _Pragma("unroll") for (int _i = 0; _i < 2; ++_i) \
        __builtin_amdgcn_global_load_lds((const unsigned*)((const char*)(gbase) + (voff)[_i]), (PG8_LAS unsigned*)(lds + (bufoff) + ldsw + _i * 8192), 16, 0, 0); } while (0)
#define PG8_LDA(dst, b, h) do { _Pragma("unroll") for (int m = 0; m < 4; ++m) _Pragma("unroll") for (int k = 0; k < 2; ++k) dst[m][k] = *(const PG8_LAS bf16x8*)(lds + PG8_SA(b, h) + aoff + m * 2048 + k * 1024); } while (0)
#define PG8_LDB(dst, b, h) do { _Pragma("unroll") for (int n = 0; n < 2; ++n) _Pragma("unroll") for (int k = 0; k < 2; ++k) dst[n][k] = *(const PG8_LAS bf16x8*)(lds + PG8_SB(b, h) + boff + n * 2048 + k * 1024); } while (0)
#define PG8_MMA(ai, bj, At, Bt) do { __builtin_amdgcn_s_setprio(1); _Pragma("unroll") for (int m = 0; m < 4; ++m) _Pragma("unroll") for (int n = 0; n < 2; ++n) _Pragma("unroll") for (int k = 0; k < 2; ++k) \
        acc[ai][bj][m][n] = __builtin_amdgcn_mfma_f32_16x16x32_bf16(Bt[n][k], At[m][k], acc[ai][bj][m][n], 0, 0, 0); __builtin_amdgcn_s_setprio(0); } while (0)
#define PG8_WAIT_V(n) asm volatile("s_waitcnt vmcnt(" #n ")" ::: "memory")
#define PG8_WAIT_L(n) asm volatile("s_waitcnt lgkmcnt(" #n ")" ::: "memory")
#define PG8_BAR __builtin_amdgcn_s_barrier()
#define PG8_SCHED __builtin_amdgcn_sched_barrier(0)
    Unit cur, nxt; int ui = 0;
    if (!S.next(0, cur)) return;
    f32x4 acc[2][2][4][2];
#pragma unroll
    for (int a = 0; a < 2; ++a)
#pragma unroll
        for (int b = 0; b < 2; ++b)
#pragma unroll
            for (int m = 0; m < 4; ++m)
#pragma unroll
                for (int n = 0; n < 2; ++n) acc[a][b][m][n] = (f32x4){0.f, 0.f, 0.f, 0.f};
    bf16x8 At[4][2], B0[2][2], B1[2][2];
    const char* cA = S.a_ptr(cur); const char* cB = S.b_ptr(cur);
    unsigned cv0[2], cv1[2]; S.a_offs(cur, stR, stC, cv0, cv1);
    S.a_ready(cur);
    if constexpr (SP2) {
        PG8_STAGE(PG8_SB(0, 0), cB, voffB); PG8_STAGE(PG8_SB(0, 1), cB + hstep, voffB); PG8_STAGE(PG8_SA(0, 0), cA, cv0); PG8_STAGE(PG8_SA(0, 1), cA, cv1);
        if (wr == 1) PG8_BAR;
        PG8_WAIT_V(2); PG8_BAR;
        PG8_STAGE(PG8_SB(1, 0), cB + kstep, voffB); PG8_STAGE(PG8_SA(1, 0), cA + kstep, cv0); PG8_STAGE(PG8_SB(1, 1), cB + hstep + kstep, voffB);
        PG8_WAIT_V(6); PG8_BAR;
    } else {
        PG8_STAGE(PG8_SB(0, 0), cB, voffB); PG8_STAGE(PG8_SA(0, 0), cA, cv0); PG8_STAGE(PG8_SB(0, 1), cB + hstep, voffB); PG8_STAGE(PG8_SA(0, 1), cA, cv1);
        if (wr == 1) PG8_BAR;
        PG8_WAIT_V(4); PG8_BAR;
        PG8_STAGE(PG8_SB(1, 0), cB + kstep, voffB); PG8_STAGE(PG8_SA(1, 0), cA + kstep, cv0); PG8_STAGE(PG8_SB(1, 1), cB + hstep + kstep, voffB);
        PG8_WAIT_V(6); PG8_BAR;
    }
    for (;;) {
        const bool has_next = S.next(ui + 1, nxt);
        const char* nA = has_next ? S.a_ptr(nxt) : cA; const char* nB = has_next ? S.b_ptr(nxt) : cB;
        for (int t = 0; t < nt; t += 2) {
            const bool last = (t == nt - 2);
            const char* a1 = cA + (size_t)(t + 1) * kstep;
            const char* a2 = last ? nA : cA + (size_t)(t + 2) * kstep; const char* b2 = last ? nB : cB + (size_t)(t + 2) * kstep;
            const char* a3 = a2 + kstep; const char* b3 = b2 + kstep;
            unsigned c0_[2], c1[2], x0[2], x1[2];
            { int rr[2] = {stR[0], stR[1]}; asm volatile("" : "+v"(rr[0]), "+v"(rr[1])); Unit cu = cur, xu = (last && has_next) ? nxt : cur; asm volatile("" : "+s"(cu.aux), "+s"(xu.aux));
              S.a_offs(cu, rr, stC, c0_, c1); S.a_offs(xu, rr, stC, x0, x1); }
            if (last && has_next) S.a_ready(nxt);
            if constexpr (SP2) {
            PG8_LDB(B0, 0, 0); PG8_LDB(B1, 0, 1); PG8_SCHED; PG8_LDA(At, 0, 0); PG8_STAGE(PG8_SA(1, 1), a1, c1);
            PG8_WAIT_V(8); PG8_WAIT_L(0); PG8_BAR; PG8_MMA(0, 0, At, B0); PG8_MMA(0, 1, At, B1); PG8_BAR; PG8_SCHED;
            PG8_LDA(At, 0, 1); PG8_STAGE(PG8_SB(0, 0), b2, voffB); PG8_STAGE(PG8_SB(0, 1), b2 + hstep, voffB); PG8_STAGE(PG8_SA(0, 0), a2, x0);
            PG8_WAIT_V(8); PG8_WAIT_L(0); PG8_BAR; PG8_MMA(1, 0, At, B0); PG8_MMA(1, 1, At, B1); PG8_BAR; PG8_SCHED;
            PG8_LDB(B0, 1, 0); PG8_LDB(B1, 1, 1); PG8_SCHED; PG8_LDA(At, 1, 0); PG8_STAGE(PG8_SA(0, 1), a2, x1);
            PG8_WAIT_V(8); PG8_WAIT_L(0); PG8_BAR; PG8_MMA(0, 0, At, B0); PG8_MMA(0, 1, At, B1); PG8_BAR; PG8_SCHED;
            PG8_LDA(At, 1, 1); PG8_STAGE(PG8_SB(1, 0), b3, voffB); PG8_STAGE(PG8_SB(1, 1), b3 + hstep, voffB); PG8_STAGE(PG8_SA(1, 0), a3, x0);
            PG8_WAIT_V(8); PG8_WAIT_L(0); PG8_BAR; PG8_MMA(1, 0, At, B0); PG8_MMA(1, 1, At, B1); PG8_BAR; PG8_SCHED;
            } else {
            PG8_LDB(B0, 0, 0); PG8_SCHED; PG8_LDA(At, 0, 0); PG8_STAGE(PG8_SA(1, 1), a1, c1);
            PG8_WAIT_L(8); PG8_BAR; PG8_WAIT_L(0); PG8_MMA(0, 0, At, B0); PG8_BAR; PG8_SCHED;
            PG8_LDB(B1, 0, 1); PG8_STAGE(PG8_SB(0, 0), b2, voffB);
            PG8_BAR; PG8_WAIT_L(0); PG8_MMA(0, 1, At, B1); PG8_BAR;
            PG8_LDA(At, 0, 1); PG8_STAGE(PG8_SA(0, 0), a2, x0);
            PG8_BAR; PG8_WAIT_L(0); PG8_MMA(1, 0, At, B0); PG8_BAR; PG8_SCHED;
            PG8_STAGE(PG8_SB(0, 1), b2 + hstep, voffB);
            PG8_WAIT_V(6); PG8_BAR; PG8_MMA(1, 1, At, B1); PG8_BAR;
            PG8_LDB(B0, 1, 0); PG8_SCHED; PG8_LDA(At, 1, 0); PG8_STAGE(PG8_SA(0, 1), a2, x1);
            PG8_WAIT_L(8); PG8_BAR; PG8_WAIT_L(0); PG8_MMA(0, 0, At, B0); PG8_BAR; PG8_SCHED;
            PG8_LDB(B1, 1, 1); PG8_STAGE(PG8_SB(1, 0), b3, voffB);
            PG8_BAR; PG8_WAIT_L(0); PG8_MMA(0, 1, At, B1); PG8_BAR;
            PG8_LDA(At, 1, 1); PG8_STAGE(PG8_SA(1, 0), a3, x0);
            PG8_BAR; PG8_WAIT_L(0); PG8_MMA(1, 0, At, B0); PG8_BAR; PG8_SCHED;
            PG8_STAGE(PG8_SB(1, 1), b3 + hstep, voffB);
            PG8_WAIT_V(6); PG8_BAR; PG8_MMA(1, 1, At, B1); PG8_BAR;
            }
        }
        if constexpr (ALIGN_EPI) { if (wr == 0) PG8_BAR; }
        if constexpr (!Epi::AFTER_DRAIN) { E(acc, cur, wr, wc, fr, fq); S.done(cur); }
        if (!has_next) break;
#pragma unroll
        for (int a = 0; a < 2; ++a)
#pragma unroll
            for (int b = 0; b < 2; ++b)
#pragma unroll
                for (int m = 0; m < 4; ++m)
#pragma unroll
                    for (int n = 0; n < 2; ++n) acc[a][b][m][n] = (f32x4){0.f, 0.f, 0.f, 0.f};
        cur = nxt; cA = nA; cB = nB; ++ui;
        if constexpr (ALIGN_EPI) { if (wr == 1) PG8_BAR; }
    }
    PG8_WAIT_V(0);
    if constexpr (!ALIGN_EPI) { if (wr == 0) PG8_BAR; }
    PG8_BAR;
    if constexpr (Epi::AFTER_DRAIN) { E.fused(acc, cur, wr, wc, fr, fq, lds, wid, lane); S.done(cur); }
#undef PG8_SA
#undef PG8_SB
#undef PG8_STAGE
#undef PG8_LDA
#undef PG8_LDB
#undef PG8_MMA
#undef PG8_WAIT_V
#undef PG8_WAIT_L
#undef PG8_BAR
#undef PG8_SCHED
}
}
namespace pg8 {
struct DenseOrder {
    const char* A; const char* Bt; int K; int nM, nN, nwg, G, c;
    __device__ __forceinline__ void init(const void* A_, const void* Bt_, int M, int N, int K_, int G_, int c_) { A = (const char*)A_; Bt = (const char*)Bt_; K = K_; nM = M / BM; nN = N / BM; nwg = nM * nN; G = G_; c = c_; }
    __device__ __forceinline__ bool next(int i, Unit& u) const {
        const long L = (long)i * G + c; if (L >= nwg) return false;
        int wgid = (int)L; { const int q = nwg / NXCD, r = nwg % NXCD, xcd = wgid % NXCD, off = wgid / NXCD; wgid = (xcd < r ? xcd * (q + 1) : r * (q + 1) + (xcd - r) * q) + off; }
        const int nig = WGM * nN, gid = wgid / nig, fm = gid * WGM, gsz = (nM - fm) < WGM ? (nM - fm) : WGM;
        u.pm = fm + ((wgid % nig) % gsz); u.pn = (wgid % nig) / gsz; u.aux = i; return true;
    }
    __device__ __forceinline__ const char* a_ptr(const Unit& u) const { return A + (size_t)u.pm * BM * K * 2; }
    __device__ __forceinline__ const char* b_ptr(const Unit& u) const { return Bt + (size_t)u.pn * BM * K * 2; }
    __device__ __forceinline__ void a_offs(const Unit&, const int (&R)[2], const int (&C)[2], unsigned (&v0)[2], unsigned (&v1)[2]) const {
#pragma unroll
        for (int i = 0; i < 2; ++i) { v0[i] = (unsigned)(R[i] * K + C[i]) * 2u; v1[i] = v0[i] + (unsigned)(HALF * K * 2); } }
    __device__ __forceinline__ void a_ready(const Unit&) const {}
    __device__ __forceinline__ void done(const Unit&) const {}
};
struct EpiF32 {
    static constexpr bool PERM = false, AFTER_DRAIN = false;
    float* C; int ldc;
    __device__ __forceinline__ void operator()(const f32x4 (&acc)[2][2][4][2], const Unit& u, int wr, int wc, int fr, int fq) const {
        const int row0 = u.pm * BM + wr * 64 + fr, col0 = u.pn * BM + wc * 32 + 4 * fq;
#pragma unroll
        for (int ai = 0; ai < 2; ++ai)
#pragma unroll
            for (int m = 0; m < 4; ++m) { float* rowp = C + (size_t)(row0 + ai * HALF + m * 16) * ldc + col0;
#pragma unroll
                for (int bj = 0; bj < 2; ++bj)
#pragma unroll
                    for (int n = 0; n < 2; ++n) *(f32x4*)(rowp + bj * HALF + n * 16) = acc[ai][bj][m][n]; }
    }
};
struct EpiBf16Plain {
    static constexpr bool PERM = true, AFTER_DRAIN = false;
    bf16_t* O; int ldc;
    __device__ __forceinline__ void operator()(const f32x4 (&acc)[2][2][4][2], const Unit& u, int wr, int wc, int fr, int fq) const {
        const int row0 = u.pm * BM + wr * 64 + fr, col0 = u.pn * BM + wc * 32 + 8 * fq;
#pragma unroll
        for (int ai = 0; ai < 2; ++ai)
#pragma unroll
            for (int m = 0; m < 4; ++m) { bf16_t* rowp = O + (size_t)(row0 + ai * HALF + m * 16) * ldc + col0;
#pragma unroll
                for (int bj = 0; bj < 2; ++bj) { const f32x4 v0 = acc[ai][bj][m][0], v1 = acc[ai][bj][m][1];
                    u32x4 w; w.x = cvt_pk_bf16(v0[0], v0[1]); w.y = cvt_pk_bf16(v0[2], v0[3]); w.z = cvt_pk_bf16(v1[0], v1[1]); w.w = cvt_pk_bf16(v1[2], v1[3]);
                    *(u32x4*)(rowp + bj * HALF) = w; } }
    }
};
}
namespace pg8 {
constexpr int MOE_MAXU = 3;
typedef int i32x16 __attribute__((ext_vector_type(16)));
typedef unsigned u32x16 __attribute__((ext_vector_type(16)));
struct MoePlan {
    i32x16 toff, cnt; int TT;
    __device__ __forceinline__ void init(const int* cntp) { int acc = 0;
#pragma unroll
        for (int q = 0; q < N_EXP; ++q) { const int cq = __builtin_amdgcn_readfirstlane(cntp[q * CNT_STRIDE]); cnt[q] = cq; toff[q] = acc; acc += (cq + BM - 1) / BM; }
        TT = acc; }
    __device__ __forceinline__ void decode(int pm, int& e, int& lt, int& ce) const { int ee = 0, base = 0, cc = cnt[0];
#pragma unroll
        for (int q = 1; q < N_EXP; ++q) { const bool ge = pm >= toff[q]; ee = ge ? q : ee; base = ge ? toff[q] : base; cc = ge ? cnt[q] : cc; }
        e = ee; lt = pm - base; ce = cc; }
};
struct MoeOrder {
    const char* A; const char* W; const int* slottok; int K; size_t wexp; int nN, TT, nwg, G, c; bool gather;
    MoePlan pl;
    u32x16 goff;
    __device__ __forceinline__ bool next(int i, Unit& u) const {
        const long L = (long)i * G + c; if (L >= nwg) return false;
        int wgid = (int)L; { const int q = nwg / NXCD, r = nwg % NXCD, xcd = wgid % NXCD, off = wgid / NXCD; wgid = (xcd < r ? xcd * (q + 1) : r * (q + 1) + (xcd - r) * q) + off; }
        const int nig = WGM * nN, gid = wgid / nig, fm = gid * WGM, gsz = (TT - fm) < WGM ? (TT - fm) : WGM;
        u.pm = fm + ((wgid % nig) % gsz); u.pn = (wgid % nig) / gsz; u.aux = i; return true;
    }
    __device__ __forceinline__ void init(const void* A_, const void* W_, const int* cntp, const int* slottok_, int N, int K_, bool gather_, int G_, int c_) {
        A = (const char*)A_; W = (const char*)W_; slottok = slottok_; K = K_; wexp = (size_t)N * K_ * 2; nN = N / BM; G = G_; c = c_; gather = gather_;
        pl.init(cntp); TT = pl.TT; nwg = TT * nN;
        if (gather) {
            int tid_l = threadIdx.x; asm volatile("" : "+v"(tid_l));
#pragma unroll
            for (int ui = 0; ui < MOE_MAXU; ++ui) { Unit u; u.pm = 0; u.pn = 0; u.aux = 0; const bool ok = next(ui, u); int e, lt, ce; pl.decode(ok ? u.pm : 0, e, lt, ce);
#pragma unroll
                for (int i = 0; i < 2; ++i) { int R, C; stage_rc(tid_l * 16 + i * 8192, R, C);
#pragma unroll
                    for (int h = 0; h < 2; ++h) { int slot = lt * BM + h * HALF + R; if (slot >= ce) slot = 0;
                        const int tok2 = ok ? slottok[(size_t)e * NROW + slot] : 0;
                        goff[ui * 4 + h * 2 + i] = (unsigned)((tok2 >> 1) * K + C) * 2u; } } }
        }
    }
    __device__ __forceinline__ const char* a_ptr(const Unit& u) const { return gather ? A : A + (size_t)u.pm * BM * K * 2; }
    __device__ __forceinline__ const char* b_ptr(const Unit& u) const { int e, lt, ce; pl.decode(u.pm, e, lt, ce); return W + (size_t)e * wexp + (size_t)u.pn * BM * K * 2; }
    __device__ __forceinline__ void a_offs(const Unit& u, const int (&R)[2], const int (&C)[2], unsigned (&v0)[2], unsigned (&v1)[2]) const {
        if (gather) {
#pragma unroll
            for (int i = 0; i < 2; ++i) { unsigned a = goff[i], b = goff[2 + i];
#pragma unroll
                for (int q = 1; q < MOE_MAXU; ++q) { const bool is = (u.aux == q); a = is ? goff[q * 4 + i] : a; b = is ? goff[q * 4 + 2 + i] : b; }
                v0[i] = a; v1[i] = b; }
        } else {
#pragma unroll
            for (int i = 0; i < 2; ++i) { v0[i] = (unsigned)(R[i] * K + C[i]) * 2u; v1[i] = v0[i] + (unsigned)(HALF * K * 2); } }
    }
    __device__ __forceinline__ void a_ready(const Unit&) const {}
    __device__ __forceinline__ void done(const Unit&) const {}
};
struct EpiSwiGLU {
    static constexpr bool PERM = true, AFTER_DRAIN = false;
    bf16_t* HMp;
    __device__ __forceinline__ void operator()(const f32x4 (&acc)[2][2][4][2], const Unit& u, int wr, int wc, int fr, int fq) const {
        const int row0 = u.pm * BM + wr * 64 + fr, col0 = u.pn * HALF + wc * 32 + 8 * fq;
#pragma unroll
        for (int ai = 0; ai < 2; ++ai)
#pragma unroll
            for (int m = 0; m < 4; ++m) { bf16_t* rowp = HMp + (size_t)(row0 + ai * HALF + m * 16) * EXP_FF + col0;
                float h[8];
#pragma unroll
                for (int n = 0; n < 2; ++n)
#pragma unroll
                    for (int j = 0; j < 4; ++j) { const float g = acc[ai][0][m][n][j], uu = acc[ai][1][m][n][j]; h[n * 4 + j] = g * __builtin_amdgcn_rcpf(1.f + __expf(-g)) * uu; }
                u32x4 w; w.x = cvt_pk_bf16(h[0], h[1]); w.y = cvt_pk_bf16(h[2], h[3]); w.z = cvt_pk_bf16(h[4], h[5]); w.w = cvt_pk_bf16(h[6], h[7]);
                *(u32x4*)rowp = w; }
    }
};
struct EpiMoeDown {
    static constexpr bool PERM = true, AFTER_DRAIN = false;
    bf16_t* FOp; const float* TGp; const int* slottok; MoePlan pl;
    __device__ __forceinline__ void operator()(const f32x4 (&acc)[2][2][4][2], const Unit& u, int wr, int wc, int fr, int fq) const {
        int e, lt, ce; pl.decode(u.pm, e, lt, ce);
        const int col0 = u.pn * BM + wc * 32 + 8 * fq;
#pragma unroll
        for (int ai = 0; ai < 2; ++ai)
#pragma unroll
            for (int m = 0; m < 4; ++m) { const int slot = lt * BM + ai * HALF + wr * 64 + m * 16 + fr;
                if (slot < ce) { const int tok2 = slottok[(size_t)e * NROW + slot]; const float gate = TGp[tok2];
                    bf16_t* rowp = FOp + (size_t)tok2 * D_MODEL + col0;
#pragma unroll
                    for (int bj = 0; bj < 2; ++bj) { const f32x4 v0 = acc[ai][bj][m][0] * gate, v1 = acc[ai][bj][m][1] * gate;
                        u32x4 w; w.x = cvt_pk_bf16(v0[0], v0[1]); w.y = cvt_pk_bf16(v0[2], v0[3]); w.z = cvt_pk_bf16(v1[0], v1[1]); w.w = cvt_pk_bf16(v1[2], v1[3]);
                        *(u32x4*)(rowp + bj * HALF) = w; } } }
    }
};
}
namespace pg8 {
static_assert(IN_W == 8 * BM && LRU_W == BM && GQA_H == 8 && GQA_KV == 2 && DIFF_H == 4 && NLAT % BM == 0 && CTX_LEN == BM, "EpiInProj is written for this problem's column partition");
struct EpiInProj {
    static constexpr bool PERM = true, AFTER_DRAIN = false;
    float* AX; float* GA; bf16_t* ZQ; bf16_t* ZK; bf16_t* ZV; const float* qg; const float* kg;
    int* nb;
    __device__ __forceinline__ void operator()(const f32x4 (&acc)[2][2][4][2], const Unit& u, int wr, int wc, int fr, int fq) const {
        const int pn = u.pn, pm = u.pm;
        const bool lat = pm < NLAT / BM;
        const int b = lat ? pm / (SEQ / BM) : pm - NLAT / BM;
        const int rt0 = wr * 64 + fr;
        const int t0 = lat ? (pm % (SEQ / BM)) * BM : 0;
        const size_t kbase = (size_t)b * SKEY + (lat ? CTX_LEN + t0 : 0);
        const size_t row_base = (size_t)pm * BM;
        if (pn < 2) {
            float* dst = pn == 0 ? AX : GA;
#pragma unroll
            for (int ai = 0; ai < 2; ++ai)
#pragma unroll
                for (int m = 0; m < 4; ++m) { float* rowp = dst + (row_base + rt0 + ai * HALF + m * 16) * LRU_W + wc * 32 + 8 * fq;
#pragma unroll
                    for (int bj = 0; bj < 2; ++bj)
#pragma unroll
                        for (int n = 0; n < 2; ++n) { f32x4 v = acc[ai][bj][m][n];
                            if (pn == 1) {
#pragma unroll
                                for (int j = 0; j < 4; ++j) { const float x = v[j]; const float tt = 0.7978845608028654f * (x + 0.044715f * x * x * x); const float e2 = __expf(2.f * tt); v[j] = x - x * __builtin_amdgcn_rcpf(e2 + 1.f); } }
                            *(f32x4*)(rowp + bj * HALF + n * 4) = v; } }
            return;
        }
        const bool isq_g = (pn == 2 || pn == 3), is4 = (pn == 4), isdq = (pn == 5), isdk = (pn == 6), isdv = (pn == 7);
        const bool norm = isq_g || (is4 && wc < 2);
        const bool rope64 = norm && lat, rope32 = (isdq || isdk) && lat;
        const float* gains = isq_g ? qg : kg;
        float g16[2][8];
        if (norm) {
#pragma unroll
            for (int bj = 0; bj < 2; ++bj)
#pragma unroll
                for (int k = 0; k < 8; ++k) g16[bj][k] = gains[32 * bj + 8 * fq + k];
        }
        float inv[4]; bool usecol32 = false;
#pragma unroll
        for (int pp = 0; pp < 4; ++pp) {
            if (rope64) inv[pp] = exp2f(-(float)(4 * fq + pp) * (13.287712379549449f / 16.f));
            else { const int i = 4 * fq + pp; inv[pp] = exp2f(-(float)(i & 7) * (13.287712379549449f / 8.f)); }
        }
        usecol32 = fq >= 2;
        bf16_t* dbase; int dpitch; bool keyrow; float qs = 1.f; bool pad32 = false;
        if (isq_g) { dbase = ZQ + (4 * (pn - 2) + wc) * 64; dpitch = QP; keyrow = false; qs = QS_G; }
        else if (is4) { if (wc < 2) { dbase = ZK + wc * 64; dpitch = KP; } else { dbase = ZV + (wc - 2) * 64; dpitch = VP; } keyrow = true; }
        else if (isdq) { dbase = ZQ + (GQA_H + 2 * wc) * 64; dpitch = QP; keyrow = false; qs = QS_D; pad32 = true; }
        else if (isdk) { dbase = ZK + (GQA_KV + 2 * wc) * 64; dpitch = KP; keyrow = true; pad32 = true; }
        else { dbase = ZV + (GQA_KV + wc) * 64; dpitch = VP; keyrow = true; }
        (void)isdv;
        float nmx[2] = {0.f, 0.f};
#pragma unroll
        for (int ai = 0; ai < 2; ++ai)
#pragma unroll
            for (int m = 0; m < 4; ++m) {
                const int rin = rt0 + ai * HALF + m * 16;
                float v[2][8];
#pragma unroll
                for (int bj = 0; bj < 2; ++bj)
#pragma unroll
                    for (int n = 0; n < 2; ++n)
#pragma unroll
                        for (int j = 0; j < 4; ++j) v[bj][n * 4 + j] = acc[ai][bj][m][n][j];
                if (norm) { float ss = 0.f;
#pragma unroll
                    for (int bj = 0; bj < 2; ++bj)
#pragma unroll
                        for (int k = 0; k < 8; ++k) ss += v[bj][k] * v[bj][k];
                    ss = swap32_sum(swap16_sum(ss));
                    const float rs = 1.0f / sqrtf(ss * (1.f / 64.f) + 1e-6f);
#pragma unroll
                    for (int bj = 0; bj < 2; ++bj)
#pragma unroll
                        for (int k = 0; k < 8; ++k) v[bj][k] = v[bj][k] * rs * g16[bj][k]; }
                if (rope64 || rope32) { const int t = t0 + rin; const float prow = (float)(t / GRID_W), pcol = (float)(t % GRID_W);
#pragma unroll
                    for (int bj = 0; bj < 2; ++bj) { const float pos = rope64 ? (bj ? pcol : prow) : (usecol32 ? pcol : prow);
#pragma unroll
                        for (int pp = 0; pp < 4; ++pp) { const float ang = pos * inv[pp]; const float cs = __cosf(ang), sn = __sinf(ang);
                            const float x0 = v[bj][2 * pp], x1 = v[bj][2 * pp + 1]; v[bj][2 * pp] = x0 * cs - x1 * sn; v[bj][2 * pp + 1] = x0 * sn + x1 * cs; } } }
                if (pad32) {
#pragma unroll
                    for (int bj = 0; bj < 2; ++bj) { float ss = 0.f;
#pragma unroll
                        for (int k = 0; k < 8; ++k) ss += (v[bj][k] * qs) * (v[bj][k] * qs);
                        ss = swap32_sum(swap16_sum(ss)); nmx[bj] = fmaxf(nmx[bj], ss); } }
                bf16_t* rowp = dbase + (keyrow ? (kbase + rin) : (row_base + rin)) * (size_t)dpitch;
#pragma unroll
                for (int bj = 0; bj < 2; ++bj) { u32x4 w; w.x = cvt_pk_bf16(v[bj][0] * qs, v[bj][1] * qs); w.y = cvt_pk_bf16(v[bj][2] * qs, v[bj][3] * qs); w.z = cvt_pk_bf16(v[bj][4] * qs, v[bj][5] * qs); w.w = cvt_pk_bf16(v[bj][6] * qs, v[bj][7] * qs);
                    if (pad32) { bf16_t* q = rowp + bj * 64 + 8 * fq; *(u32x4*)q = w; unsigned z_ = 0u; asm volatile("" : "+v"(z_)); *(u32x4*)(q + 32) = (u32x4){z_, z_, z_, z_}; }
                    else *(u32x4*)(rowp + 32 * bj + 8 * fq) = w; }
            }
        if (pad32) {
#pragma unroll
            for (int bj = 0; bj < 2; ++bj) { float mxv = nmx[bj]; mxv = fmaxf(mxv, dpp_mov<DPP_XOR1>(mxv)); mxv = fmaxf(mxv, dpp_mov<DPP_XOR2>(mxv)); mxv = fmaxf(mxv, dpp_mov<DPP_HMIR>(mxv)); mxv = fmaxf(mxv, dpp_mov<DPP_MIR>(mxv));
                if (fr == 0 && fq == 0) atomicMax(nb + b * 16 + (isdk ? 8 : 0) + 2 * wc + bj, __float_as_int(mxv)); } }
    }
};
}
typedef float f32x4_t __attribute__((ext_vector_type(4)));
typedef unsigned u32x2_t __attribute__((ext_vector_type(2)));
typedef float f32x2_t_ __attribute__((ext_vector_type(2)));
typedef unsigned u32x4_t __attribute__((ext_vector_type(4)));
__device__ __forceinline__ unsigned pk2bf(float lo, float hi) { unsigned r; asm volatile("v_cvt_pk_bf16_f32 %0, %1, %2" : "=v"(r) : "v"(lo), "v"(hi)); return r; }
#define LDS_WAIT_() asm volatile("s_waitcnt lgkmcnt(0)" ::: "memory")
__device__ __forceinline__ f32x4_t unpk4bf(u32x2_t u) { f32x4_t f; f.x = __uint_as_float(u.x << 16); f.y = __uint_as_float(u.x & 0xffff0000u); f.z = __uint_as_float(u.y << 16); f.w = __uint_as_float(u.y & 0xffff0000u); return f; }
__device__ __forceinline__ u32x2_t pk4bf(f32x4_t v) { u32x2_t o; o.x = pk2bf(v.x, v.y); o.y = pk2bf(v.z, v.w); return o; }
#define LNC(j) (8 * lane + 512 * ((j) >> 1) + 4 * ((j) & 1))
constexpr int NJ4 = D_MODEL / 256;
__device__ __forceinline__ void ld8bf(const bf16_t* q, u32x2_t& a, u32x2_t& b) { const u32x4_t v = *(const u32x4_t*)q; a.x = v.x; a.y = v.y; b.x = v.z; b.y = v.w; }
__device__ __forceinline__ void st8bf(bf16_t* q, u32x2_t a, u32x2_t b) { *(u32x4_t*)q = (u32x4_t){a.x, a.y, b.x, b.y}; }

__device__ __forceinline__ void cvt_item(const float* W, int K, int N, bf16_t* WT, int k0, int n0, int dst_row0, LAS float* scr, int lane) {
    float tv[32];
#pragma unroll
    for (int i = 0; i < 32; ++i) tv[i] = W[(size_t)(k0 + 2 * i + (lane >> 5)) * N + n0 + (lane & 31)];
#pragma unroll
    for (int i = 0; i < 32; ++i) scr[(2 * i + (lane >> 5)) * 33 + (lane & 31)] = tv[i];
    LDS_WAIT_();
    const int c = lane & 7;
#pragma unroll
    for (int j = 0; j < 4; ++j) { const int n = (lane >> 3) + 8 * j; const LAS float* s = scr + (8 * c) * 33 + n;
        u32x4_t o; o.x = pk2bf(s[0 * 33], s[1 * 33]); o.y = pk2bf(s[2 * 33], s[3 * 33]); o.z = pk2bf(s[4 * 33], s[5 * 33]); o.w = pk2bf(s[6 * 33], s[7 * 33]);
        *(u32x4_t*)(WT + (size_t)(dst_row0 + n) * K + k0 + 8 * c) = o; }
    LDS_WAIT_();
}
constexpr int CVT_I_IN = (D_MODEL / 64) * (IN_W / 256), CVT_I_OUT = (MIX_W / 64) * (D_MODEL / 256), CVT_I_GU1 = (D_MODEL / 64) * (EXP_FF / 256), CVT_I_D1 = (EXP_FF / 64) * (D_MODEL / 256);
constexpr int CVT_NIT = CVT_I_IN + CVT_I_OUT + N_EXP * (2 * CVT_I_GU1 + CVT_I_D1);
struct CvtItem { const float* W; bf16_t* WT; int K, N, k0, n0, kind; };
__device__ __forceinline__ CvtItem cvt_decode(const P& p, int l, int it) {
    CvtItem c; bf16_t* wb = p.WB[l & 1]; int r = it;
    if (r < CVT_I_IN) { const int nb = IN_W / 256; c.W = p.w_in + (size_t)l * D_MODEL * IN_W; c.WT = WB_WIN(wb); c.K = D_MODEL; c.N = IN_W; c.k0 = 64 * (r % (D_MODEL / 64)); c.n0 = 256 * (r / (D_MODEL / 64)); c.kind = 1; (void)nb; return c; } r -= CVT_I_IN;
    if (r < CVT_I_OUT) { const int nb = D_MODEL / 256; c.W = p.w_out + (size_t)l * MIX_W * D_MODEL; c.WT = WB_WOUT(wb); c.K = MIX_W; c.N = D_MODEL; c.k0 = 64 * (r % (MIX_W / 64)); c.n0 = 256 * (r / (MIX_W / 64)); c.kind = 0; (void)nb; return c; } r -= CVT_I_OUT;
    const int per_e = 2 * CVT_I_GU1 + CVT_I_D1, e = r / per_e; r -= e * per_e;
    if (r < 2 * CVT_I_GU1) { const int half = r / CVT_I_GU1; r -= half * CVT_I_GU1; const int nb = EXP_FF / 256;
        c.W = (half ? p.exp_w_up : p.exp_w_gate) + ((size_t)l * N_EXP + e) * D_MODEL * EXP_FF; c.WT = WB_WGU(wb) + (size_t)e * 2 * EXP_FF * D_MODEL; c.K = D_MODEL; c.N = EXP_FF; c.k0 = 64 * (r % (D_MODEL / 64)); c.n0 = 256 * (r / (D_MODEL / 64)); c.kind = 2 + half; (void)nb; return c; }
    r -= 2 * CVT_I_GU1;
    { const int nb = D_MODEL / 256; c.W = p.exp_w_down + ((size_t)l * N_EXP + e) * EXP_FF * D_MODEL; c.WT = WB_WD(wb) + (size_t)e * D_MODEL * EXP_FF; c.K = EXP_FF; c.N = D_MODEL; c.k0 = 64 * (r % (EXP_FF / 64)); c.n0 = 256 * (r / (EXP_FF / 64)); c.kind = 0; (void)nb; }
    return c;
}
__device__ __forceinline__ int cvt_drow(int kind, int n) {
    if (kind == 1) { if (n < 512) return n; const int sc = n % 256; return (n - sc) + 128 * ((sc % 64) / 32) + 32 * (sc / 64) + (sc % 32); }
    if (kind >= 2) return gu_row(kind - 2, n);
    return n;
}
__device__ __forceinline__ void cvt_load(const CvtItem& c, f32x4_t (&v)[8], int wave, int lane) {
#pragma unroll
    for (int i = 0; i < 8; ++i) v[i] = *(const f32x4_t*)(c.W + (size_t)(c.k0 + wave * 8 + i) * c.N + c.n0 + 4 * lane);
}
template <int MODE = 0> __device__ __forceinline__ void ph_cvt_range(const P& p, int l, unsigned char* lds, int it0, int it1, int start, int stride, int tid) {
    LAS float* scr = (LAS float*)(LAS unsigned char*)lds;
    const int wave = tid >> 6, lane = tid & 63;
    if (it0 + start >= it1) return;
    CvtItem c = cvt_decode(p, l, it0 + start); f32x4_t v[8]; cvt_load(c, v, wave, lane);
    for (int it = it0 + start; it < it1; it += stride) {
#pragma unroll
        for (int i = 0; i < 8; ++i) { const int k = wave * 8 + i;
            scr[(4 * lane + 0) * 65 + k] = v[i].x; scr[(4 * lane + 1) * 65 + k] = v[i].y; scr[(4 * lane + 2) * 65 + k] = v[i].z; scr[(4 * lane + 3) * 65 + k] = v[i].w; }
        const CvtItem cur = c;
        if (it + stride < it1) { c = cvt_decode(p, l, it + stride); cvt_load(c, v, wave, lane); }
        __syncthreads();
        const int ch = lane & 7;
#pragma unroll
        for (int j = 0; j < 4; ++j) { const int n = wave * 32 + j * 8 + (lane >> 3); const LAS float* s = scr + n * 65 + 8 * ch;
            u32x4_t o; o.x = pk2bf(s[0], s[1]); o.y = pk2bf(s[2], s[3]); o.z = pk2bf(s[4], s[5]); o.w = pk2bf(s[6], s[7]);
            *(u32x4_t*)(cur.WT + (size_t)cvt_drow(cur.kind, cur.n0 + n) * cur.K + cur.k0 + 8 * ch) = o; }
        __syncthreads();
    }
}
__device__ __forceinline__ void ph_cvt(const P& p, int l, unsigned char* lds, int vcu, int G, int tid) { ph_cvt_range<0>(p, l, lds, 0, CVT_NIT, vcu, G, tid); }

__device__ __forceinline__ void ph_ada(const P& p, unsigned char* lds, int vcu, int G, int wave, int lane) {
    LAS float* red = (LAS float*)(LAS unsigned char*)lds;
    LAS float* sl = red + 8 * 3 * 64;
    for (int i = wave * 64 + lane; i < 3 * D_MODEL; i += NTHR) { const float x = i < 2 * D_MODEL ? p.c[i] : p.c_ctx[i - 2 * D_MODEL]; sl[i] = siluf_(x); }
    __syncthreads();
    constexpr int UPL = 6 * D_MODEL / 32, NU = DEPTH * UPL;
    const int cl = lane & 31, kh = lane >> 5;
    for (int u = vcu; u < NU; u += G) {
        const int l = u / UPL, col = (u % UPL) * 32 + cl;
        const float* W = p.ada_w + (size_t)l * D_MODEL * 6 * D_MODEL + col;
        float a0 = 0.f, a1 = 0.f, a2 = 0.f;
        const int kb = wave * (D_MODEL / 8) + kh * (D_MODEL / 16);
#pragma unroll 16
        for (int k = 0; k < D_MODEL / 16; ++k) { const float wv = W[(size_t)(kb + k) * 6 * D_MODEL];
            a0 += sl[kb + k] * wv; a1 += sl[D_MODEL + kb + k] * wv; a2 += sl[2 * D_MODEL + kb + k] * wv; }
        a0 += __shfl_xor(a0, 32); a1 += __shfl_xor(a1, 32); a2 += __shfl_xor(a2, 32);
        if (kh == 0) { red[(wave * 3 + 0) * 32 + cl] = a0; red[(wave * 3 + 1) * 32 + cl] = a1; red[(wave * 3 + 2) * 32 + cl] = a2; }
        __syncthreads();
        if (wave < 3 && lane < 32) { float s = 0.f;
#pragma unroll
            for (int w = 0; w < 8; ++w) s += red[(w * 3 + wave) * 32 + lane];
            p.MOD[((size_t)l * 3 + wave) * 6 * D_MODEL + col] = s + p.ada_b[l * 6 * D_MODEL + col]; }
        __syncthreads();
    }
}

__device__ __forceinline__ void ph_mod0(const P& p, int gw, int NGW, int lane) {
    f32x4_t sc[NJ4], sh[NJ4], va[NJ4], vn[NJ4]; int cur_who = -1;
#define MOD0_LOAD(V, ROW) do { const int rr_ = (ROW); const float* src_ = rr_ < NLAT ? p.x + (size_t)rr_ * D_MODEL : p.ctx + (size_t)(rr_ - NLAT) * D_MODEL; \
        _Pragma("unroll") for (int j = 0; j < NJ4; ++j) V[j] = *(const f32x4_t*)(src_ + LNC(j)); } while (0)
    if (gw < NROW) MOD0_LOAD(vn, gw);
    for (int r = gw; r < NROW; r += NGW) {
        const int who = row_who(r);
#pragma unroll
        for (int j = 0; j < NJ4; ++j) va[j] = vn[j];
        if (r + NGW < NROW) MOD0_LOAD(vn, r + NGW);
        if (who != cur_who) { cur_who = who;
#pragma unroll
            for (int j = 0; j < NJ4; ++j) { sh[j] = *(const f32x4_t*)(modp(p, 0, who, 0) + LNC(j)); sc[j] = *(const f32x4_t*)(modp(p, 0, who, 1) + LNC(j)); } }
#pragma unroll
        for (int j = 0; j < NJ4; j += 2) { const int c = LNC(j);
            st8bf((bf16_t*)p.XR + (size_t)r * D_MODEL + c, pk4bf(va[j]), pk4bf(va[j + 1]));
            st8bf(p.H + (size_t)r * D_MODEL + c, pk4bf(va[j] * (1.f + sc[j]) + sh[j]), pk4bf(va[j + 1] * (1.f + sc[j + 1]) + sh[j + 1])); }
    }
#undef MOD0_LOAD
}
__device__ __forceinline__ void route_tail(float lgt, const float* router_b, int lane, int& e1, int& e2, float& gw1, float& gw2);
__device__ __forceinline__ void route_wave(const float (&lg)[N_EXP], const float* router_b, int lane, int& e1, int& e2, float& gw1, float& gw2) {
    static_assert(N_EXP == 16, "lane layout");
    const bool b5 = (lane >> 5) & 1, b4 = (lane >> 4) & 1, b3 = (lane >> 3) & 1, b2 = (lane >> 2) & 1;
    float r8[8], r4[4], r2[2];
#pragma unroll
    for (int i = 0; i < 8; ++i) { const float a = b5 ? lg[i + 8] : lg[i], b = b5 ? lg[i] : lg[i + 8]; r8[i] = a + __shfl_xor(b, 32); }
#pragma unroll
    for (int i = 0; i < 4; ++i) { const float a = b4 ? r8[i + 4] : r8[i], b = b4 ? r8[i] : r8[i + 4]; r4[i] = a + __shfl_xor(b, 16); }
#pragma unroll
    for (int i = 0; i < 2; ++i) { const float a = b3 ? r4[i + 2] : r4[i], b = b3 ? r4[i] : r4[i + 2]; r2[i] = a + __shfl_xor(b, 8); }
    float lgt = (b2 ? r2[1] : r2[0]) + __shfl_xor(b2 ? r2[0] : r2[1], 4);
    lgt += __shfl_xor(lgt, 2); lgt += __shfl_xor(lgt, 1);
    route_tail(lgt, router_b, lane, e1, e2, gw1, gw2);
}
__device__ __forceinline__ void route_tail(float lgt, const float* router_b, int lane, int& e1, int& e2, float& gw1, float& gw2) {
    const int e = lane >> 2;
    float mx = lgt; mx = fmaxf(mx, dpp_mov<DPP_HMIR>(mx)); mx = fmaxf(mx, dpp_mov<DPP_MIR>(mx)); mx = swap16_max(mx); mx = swap32_max(mx);
    const float pe = expf(lgt - mx);
    float sm = pe; sm += dpp_mov<DPP_HMIR>(sm); sm += dpp_mov<DPP_MIR>(sm); sm = swap16_sum(sm); sm = swap32_sum(sm);
    const float prob = pe * (1.f / sm), sel = prob + router_b[e];
    const int rb = lane & 48;
    float sj[4], pj[4];
#pragma unroll
    for (int j = 0; j < 4; ++j) { sj[j] = __shfl(sel, rb + 4 * j); pj[j] = __shfl(prob, rb + 4 * j); }
    float s1 = -1e30f, p1 = 0.f; int i1 = 0;
#pragma unroll
    for (int j = 0; j < 4; ++j) if (sj[j] > s1) { s1 = sj[j]; i1 = j; p1 = pj[j]; }
    float s2 = -1e30f, p2 = 0.f; int i2 = 0;
#pragma unroll
    for (int j = 0; j < 4; ++j) if (j != i1 && sj[j] > s2) { s2 = sj[j]; i2 = j; p2 = pj[j]; }
    const float sc = s1 + s2;
    float bs = -1e30f; int bg = 0;
#pragma unroll
    for (int g = 0; g < 4; ++g) { const float sg = __shfl(sc, 16 * g); if (sg > bs) { bs = sg; bg = g; } }
    const int src = 16 * bg;
    const int ri1 = __shfl(i1, src), ri2 = __shfl(i2, src); const float rp1 = __shfl(p1, src), rp2 = __shfl(p2, src);
    e1 = bg * 4 + ri1; e2 = bg * 4 + ri2; const float ws = rp1 + rp2; gw1 = rp1 / ws; gw2 = rp2 / ws;
}
constexpr int LNR_MAXR = 16;
static_assert(NROW < 65536, "row index is packed in 16 bits");
__device__ __forceinline__ void ph_lnroute(const P& p, int l, unsigned char* lds, int gw, int NGW, int tid, int lane, const int nrow) {
    typedef short bf16x8_t __attribute__((ext_vector_type(8)));
    constexpr int AST = D_MODEL * 2 + 16;
    LAS unsigned char* AH = (LAS unsigned char*)lds; LAS unsigned char* AL = AH + 8 * AST;
    LAS float* PART = (LAS float*)(AL + 8 * AST);
    LAS int* LC = (LAS int*)(PART + 8 * 16 * 16);
    LAS int* REC = LC + 2 * N_EXP;
    const int wave = __builtin_amdgcn_readfirstlane(tid >> 6); int nrec = 0;
    if (tid < 2 * N_EXP) LC[tid] = 0;
    f32x4_t lng[NJ4], lnb[NJ4], mg1[NJ4], msc[NJ4], msh[NJ4]; int cur_who = -1;
#pragma unroll
    for (int j = 0; j < NJ4; ++j) { const int c = LNC(j); lng[j] = *(const f32x4_t*)(p.ln1_g + l * D_MODEL + c); lnb[j] = *(const f32x4_t*)(p.ln1_b + l * D_MODEL + c); }
    u32x2_t xa[NJ4], ya[NJ4], xn[NJ4], yn[NJ4];
    if (gw < nrow) {
#pragma unroll
        for (int j = 0; j < NJ4; j += 2) { const int c = LNC(j); ld8bf((const bf16_t*)p.XR + (size_t)gw * D_MODEL + c, xn[j], xn[j + 1]); ld8bf((const bf16_t*)p.YO + (size_t)gw * D_MODEL + c, yn[j], yn[j + 1]); } }
    bf16x8_t Bhi[4], Blo[4];
    { const int e = lane & 15, kq = lane >> 4;
#pragma unroll
      for (int s = 0; s < 4; ++s) { unsigned hh[4], ll[4];
#pragma unroll
          for (int j2 = 0; j2 < 4; ++j2) { const int k = 128 * wave + 32 * s + 8 * kq + 2 * j2; const float w0 = p.router_w[k * N_EXP + e], w1 = p.router_w[(k + 1) * N_EXP + e];
              hh[j2] = pk2bf(w0, w1); ll[j2] = pk2bf(w0 - __uint_as_float(hh[j2] << 16), w1 - __uint_as_float(hh[j2] & 0xffff0000u)); }
          Bhi[s] = __builtin_bit_cast(bf16x8_t, (u32x4_t){hh[0], hh[1], hh[2], hh[3]}); Blo[s] = __builtin_bit_cast(bf16x8_t, (u32x4_t){ll[0], ll[1], ll[2], ll[3]}); } }
    __syncthreads();
    for (int r = gw; r < nrow; r += NGW) {
        const int who = row_who(r);
#pragma unroll
        for (int j = 0; j < NJ4; ++j) { xa[j] = xn[j]; ya[j] = yn[j]; }
        if (r + NGW < nrow) {
#pragma unroll
            for (int j = 0; j < NJ4; j += 2) { const int c = LNC(j); ld8bf((const bf16_t*)p.XR + (size_t)(r + NGW) * D_MODEL + c, xn[j], xn[j + 1]); ld8bf((const bf16_t*)p.YO + (size_t)(r + NGW) * D_MODEL + c, yn[j], yn[j + 1]); } }
        if (who != cur_who) { cur_who = who;
#pragma unroll
            for (int j = 0; j < NJ4; ++j) { const int c = LNC(j); mg1[j] = *(const f32x4_t*)(modp(p, l, who, 2) + c); msh[j] = *(const f32x4_t*)(modp(p, l, who, 3) + c); msc[j] = *(const f32x4_t*)(modp(p, l, who, 4) + c); } }
        f32x4_t t[NJ4]; float s = 0.f;
#pragma unroll
        for (int j = 0; j < NJ4; ++j) { t[j] = unpk4bf(xa[j]) * DN_ALPHA + mg1[j] * unpk4bf(ya[j]); s += (t[j].x + t[j].y) + (t[j].z + t[j].w); }
        const float mean = wave_sum(s) * (1.f / D_MODEL); float s2 = 0.f;
#pragma unroll
        for (int j = 0; j < NJ4; ++j) { t[j] = t[j] - mean; s2 += (t[j].x * t[j].x + t[j].y * t[j].y) + (t[j].z * t[j].z + t[j].w * t[j].w); }
        const float rstd = 1.0f / sqrtf(wave_sum(s2) * (1.f / D_MODEL) + 1e-6f);
#pragma unroll
        for (int j = 0; j < NJ4; j += 2) { const int c = LNC(j); u32x2_t xo[2], hi[2], lo[2];
#pragma unroll
            for (int q = 0; q < 2; ++q) { const f32x4_t x1 = t[j + q] * rstd * lng[j + q] + lnb[j + q]; xo[q] = pk4bf(x1);
                const f32x4_t h2 = x1 * (1.f + msc[j + q]) + msh[j + q]; hi[q] = pk4bf(h2); lo[q] = pk4bf(h2 - unpk4bf(hi[q])); }
            st8bf((bf16_t*)p.XRo + (size_t)r * D_MODEL + c, xo[0], xo[1]); st8bf(p.Ho + (size_t)r * D_MODEL + c, hi[0], hi[1]);
            *(LAS u32x4_t*)(AH + wave * AST + c * 2) = (u32x4_t){hi[0].x, hi[0].y, hi[1].x, hi[1].y}; *(LAS u32x4_t*)(AL + wave * AST + c * 2) = (u32x4_t){lo[0].x, lo[0].y, lo[1].x, lo[1].y}; }
        __syncthreads();
        {
            f32x4_t acc = (f32x4_t){0.f, 0.f, 0.f, 0.f};
            const int arow = lane & 7, kq = lane >> 4;
#pragma unroll
            for (int s4 = 0; s4 < 4; ++s4) { const int off = arow * AST + (128 * wave + 32 * s4 + 8 * kq) * 2;
                const bf16x8_t ah = *(const LAS bf16x8_t*)(AH + off), al = *(const LAS bf16x8_t*)(AL + off);
                acc = __builtin_amdgcn_mfma_f32_16x16x32_bf16(ah, Bhi[s4], acc, 0, 0, 0);
                acc = __builtin_amdgcn_mfma_f32_16x16x32_bf16(ah, Blo[s4], acc, 0, 0, 0);
                acc = __builtin_amdgcn_mfma_f32_16x16x32_bf16(al, Bhi[s4], acc, 0, 0, 0); }
            if (lane < 32) {
#pragma unroll
                for (int i = 0; i < 4; ++i) PART[(wave * 16 + 4 * (lane >> 4) + i) * 16 + (lane & 15)] = acc[i]; }
        }
        __syncthreads();
        float lgt = 0.f;
#pragma unroll
        for (int w = 0; w < 8; ++w) lgt += PART[(w * 16 + wave) * 16 + (lane >> 2)];
        int e1, e2; float gw1, gw2; route_tail(lgt, p.router_b, lane, e1, e2, gw1, gw2);
        if (lane == 0) { p.TGo[r * 2 + 0] = gw1; p.TGo[r * 2 + 1] = gw2;
            const int k1 = __hip_atomic_fetch_add((LAS int*)&LC[e1], 1, __ATOMIC_RELAXED, __HIP_MEMORY_SCOPE_WORKGROUP), k2 = __hip_atomic_fetch_add((LAS int*)&LC[e2], 1, __ATOMIC_RELAXED, __HIP_MEMORY_SCOPE_WORKGROUP);
            REC[(wave * LNR_MAXR + nrec) * 2 + 0] = (r << 16) | (e1 << 12) | k1; REC[(wave * LNR_MAXR + nrec) * 2 + 1] = (r << 16) | (e2 << 12) | k2; }
        ++nrec;
    }
    __syncthreads();
    if (tid < N_EXP) { const int c = LC[tid]; LC[N_EXP + tid] = c ? atomicAdd(p.cnto + CNT_IDX(l, tid), c) : 0; }
    __syncthreads();
    if (lane < 2 * nrec) { const int rec = REC[wave * LNR_MAXR * 2 + lane]; const int r = (unsigned)rec >> 16, e = (rec >> 12) & 15, k = rec & 4095;
        p.SLOTTOKo[(size_t)e * NROW + LC[N_EXP + e] + k] = r * 2 + (lane & 1); }
    __syncthreads();
}

__device__ __forceinline__ void ph_lnfinal(const P& p, int l, int gw, int NGW, int lane, const int nrow) {
    f32x4_t lng[NJ4], lnb[NJ4], mg2[NJ4], nsc[NJ4], nsh[NJ4]; int cur_who = -1;
#pragma unroll
    for (int j = 0; j < NJ4; ++j) { const int c = LNC(j); lng[j] = *(const f32x4_t*)(p.ln2_g + l * D_MODEL + c); lnb[j] = *(const f32x4_t*)(p.ln2_b + l * D_MODEL + c); }
    u32x2_t xa[NJ4], xn[NJ4], xm[NJ4]; u32x2_t fa0[NJ4], fa1[NJ4], fn0[NJ4], fn1[NJ4], fm0[NJ4], fm1[NJ4];
#define LNF_LOAD(X, F0, F1, ROW) do { const int rr_ = (ROW); _Pragma("unroll") for (int j = 0; j < NJ4; j += 2) { const int c = LNC(j); ld8bf((const bf16_t*)p.XR + (size_t)rr_ * D_MODEL + c, X[j], X[j + 1]); \
            ld8bf(p.FO + (size_t)(rr_ * 2) * D_MODEL + c, F0[j], F0[j + 1]); ld8bf(p.FO + (size_t)(rr_ * 2 + 1) * D_MODEL + c, F1[j], F1[j + 1]); } } while (0)
    if (gw < nrow) LNF_LOAD(xn, fn0, fn1, gw);
    if (gw + NGW < nrow) LNF_LOAD(xm, fm0, fm1, gw + NGW);
    for (int r = gw; r < nrow; r += NGW) {
        const int who = row_who(r);
#pragma unroll
        for (int j = 0; j < NJ4; ++j) { xa[j] = xn[j]; fa0[j] = fn0[j]; fa1[j] = fn1[j]; xn[j] = xm[j]; fn0[j] = fm0[j]; fn1[j] = fm1[j]; }
        if (r + 2 * NGW < nrow) LNF_LOAD(xm, fm0, fm1, r + 2 * NGW);
        if (who != cur_who) { cur_who = who;
#pragma unroll
            for (int j = 0; j < NJ4; ++j) { const int c = LNC(j); mg2[j] = *(const f32x4_t*)(modp(p, l, who, 5) + c);
                if (l + 1 < DEPTH) { nsh[j] = *(const f32x4_t*)(modp(p, l + 1, who, 0) + c); nsc[j] = *(const f32x4_t*)(modp(p, l + 1, who, 1) + c); } } }
        f32x4_t t[NJ4]; float s = 0.f;
#pragma unroll
        for (int j = 0; j < NJ4; ++j) { const u32x2_t u0 = fa0[j], u1 = fa1[j];
            f32x4_t f; f.x = __uint_as_float(u0.x << 16) + __uint_as_float(u1.x << 16); f.y = __uint_as_float(u0.x & 0xffff0000u) + __uint_as_float(u1.x & 0xffff0000u);
            f.z = __uint_as_float(u0.y << 16) + __uint_as_float(u1.y << 16); f.w = __uint_as_float(u0.y & 0xffff0000u) + __uint_as_float(u1.y & 0xffff0000u);
            t[j] = unpk4bf(xa[j]) * DN_ALPHA + mg2[j] * f; s += (t[j].x + t[j].y) + (t[j].z + t[j].w); }
        const float mean = wave_sum(s) * (1.f / D_MODEL); float s2 = 0.f;
#pragma unroll
        for (int j = 0; j < NJ4; ++j) { t[j] = t[j] - mean; s2 += (t[j].x * t[j].x + t[j].y * t[j].y) + (t[j].z * t[j].z + t[j].w * t[j].w); }
        const float rstd = 1.0f / sqrtf(wave_sum(s2) * (1.f / D_MODEL) + 1e-6f);
#pragma unroll
        for (int j = 0; j < NJ4; j += 2) { const int c = LNC(j);
            const f32x4_t xa2 = t[j] * rstd * lng[j] + lnb[j], xb2 = t[j + 1] * rstd * lng[j + 1] + lnb[j + 1];
            if (l + 1 < DEPTH) { st8bf((bf16_t*)p.XRo + (size_t)r * D_MODEL + c, pk4bf(xa2), pk4bf(xb2));
                st8bf(p.Ho + (size_t)r * D_MODEL + c, pk4bf(xa2 * (1.f + nsc[j]) + nsh[j]), pk4bf(xb2 * (1.f + nsc[j + 1]) + nsh[j + 1])); }
            else if (r < NLAT) { *(f32x4_t*)(p.out + (size_t)r * D_MODEL + c) = xa2; *(f32x4_t*)(p.out + (size_t)r * D_MODEL + c + 4) = xb2; } }
    }
#undef LNF_LOAD
}
constexpr int LCH = 64, CCH = 32;
constexpr int NLCH = SEQ / LCH, NCCH = CTX_LEN / CCH, NSEQC = NCCH + NLCH;
constexpr int LRU_UNITS = BATCH * (NLCH + NCCH);
struct LruChunk { int b, row0, ntok, seg0, seglen, sf, sr; };
__device__ __forceinline__ LruChunk lru_chunk(int u) {
    LruChunk k;
    if (u < BATCH * NLCH) { k.b = u / NLCH; const int c = u % NLCH; k.seg0 = k.b * SEQ; k.seglen = SEQ; k.row0 = k.seg0 + c * LCH; k.ntok = LCH; k.sf = NCCH + c; k.sr = NCCH + (NLCH - 1 - c); }
    else { const int q = u - BATCH * NLCH; k.b = q / NCCH; const int c = q % NCCH; k.seg0 = NLAT + k.b * CTX_LEN; k.seglen = CTX_LEN; k.row0 = k.seg0 + c * CCH; k.ntok = CCH; k.sf = c; k.sr = NCCH - 1 - c; }
    return k;
}
__device__ __forceinline__ float* agg_ptr(float* AGG, int b, int dir, int s) { return AGG + (((size_t)b * 2 + dir) * NSEQC + s) * 2 * LRU_W; }

__device__ __forceinline__ void lru_stage_rows(const float* AX, LAS float* Rw, unsigned rw_lds, int row0, int ntok, int seg0, int seglen, int wave, int lane) {
    const int nr = ntok + 3; asm volatile("" : "+v"(lane));
    for (int rr = wave; rr < nr; rr += 8) { const int r = row0 - 1 + rr;
        if (r >= seg0 && r < seg0 + seglen) attn_body::glds16(AX + (size_t)r * LRU_W + 4 * lane, (unsigned)__builtin_amdgcn_readfirstlane(rw_lds + (unsigned)rr * (LRU_W * 4)));
        else *(LAS f32x4_t*)(Rw + rr * LRU_W + 4 * lane) = (f32x4_t){0.f, 0.f, 0.f, 0.f}; }
}
__device__ __forceinline__ void ph_lru1(const P& p, int l, float* AGG, unsigned char* lds, int vcu, int G, int tid) {
    typedef short bf16x8_t __attribute__((ext_vector_type(8)));
    typedef float f32x16_t __attribute__((ext_vector_type(16)));
    constexpr int UST = LRU_W + 8;
    LAS bf16_t* Ub = (LAS bf16_t*)(LAS unsigned char*)lds;
    const int wave = __builtin_amdgcn_readfirstlane(tid >> 6), lane = tid & 63, col = lane & 31, hi = lane >> 5;
    const int n = wave >> 1, dir = wave & 1;
    LAS float* Rw = (LAS float*)((LAS unsigned char*)lds + LCH * UST * 2);
    const unsigned rw_lds = (unsigned)(uintptr_t)lds + (unsigned)(LCH * UST * 2);
    if (vcu < LRU_UNITS) { const LruChunk k0 = lru_chunk(vcu); lru_stage_rows(p.AX, Rw, rw_lds, k0.row0, k0.ntok, k0.seg0, k0.seglen, wave, lane); }
    bf16x8_t Bf[2][2][4];
    {
#pragma unroll
        for (int g = 0; g < 2; ++g) { const float* Wg = (g ? p.rg_wx : p.rg_wa) + ((size_t)(l * 2 + dir) * 4 + n) * LRU_BLK * LRU_BLK;
#pragma unroll
            for (int dh = 0; dh < 2; ++dh)
#pragma unroll
                for (int ks = 0; ks < 4; ++ks) { unsigned w4[4];
#pragma unroll
                    for (int j2 = 0; j2 < 4; ++j2) { const int c0 = 16 * ks + 8 * hi + 2 * j2; w4[j2] = pk2bf(Wg[c0 * LRU_BLK + 32 * dh + col], Wg[(c0 + 1) * LRU_BLK + 32 * dh + col]); }
                    Bf[g][dh][ks] = __builtin_bit_cast(bf16x8_t, (u32x4_t){w4[0], w4[1], w4[2], w4[3]}); } }
    }
    float ba[2], bx[2], nsp8[2];
#pragma unroll
    for (int dh = 0; dh < 2; ++dh) { const int ch = n * LRU_BLK + 32 * dh + col; ba[dh] = p.rg_ba[(l * 2 + dir) * LRU_W + ch]; bx[dh] = p.rg_bx[(l * 2 + dir) * LRU_W + ch];
        nsp8[dh] = -8.0f * __logf(1.f + __expf(-p.rg_lam[(l * 2 + dir) * LRU_W + ch])); }
    const int cch = tid & 255, cpar = tid >> 8;
    const float cw0 = p.conv_w[(l * 4 + 0) * LRU_W + cch], cw1 = p.conv_w[(l * 4 + 1) * LRU_W + cch], cw2 = p.conv_w[(l * 4 + 2) * LRU_W + cch], cw3 = p.conv_w[(l * 4 + 3) * LRU_W + cch], cb = p.conv_b[l * LRU_W + cch];
    for (int u = vcu; u < LRU_UNITS; u += G) {
        const LruChunk k = lru_chunk(u);
        asm volatile("s_waitcnt vmcnt(0)" ::: "memory");
        __syncthreads();
        for (int tt = cpar; tt < k.ntok; tt += 2) { const LAS float* ax = Rw + (tt + 1) * LRU_W + cch;
            Ub[tt * UST + cch] = f2bf(cb + cw0 * ax[-LRU_W] + cw1 * ax[0] + cw2 * ax[LRU_W] + cw3 * ax[2 * LRU_W]); }
        __syncthreads();
        if (u + G < LRU_UNITS) { const LruChunk kn = lru_chunk(u + G); lru_stage_rows(p.AX, Rw, rw_lds, kn.row0, kn.ntok, kn.seg0, kn.seglen, wave, lane); }
        float ap[2] = {1.f, 1.f}, hh[2] = {0.f, 0.f};
        const int nmt = k.ntok / 32;
        for (int im = 0; im < nmt; ++im) { const int mt = dir ? nmt - 1 - im : im;
            f32x16_t acc[2][2];
#pragma unroll
            for (int g = 0; g < 2; ++g)
#pragma unroll
                for (int dh = 0; dh < 2; ++dh) acc[g][dh] = (f32x16_t){0.f, 0.f, 0.f, 0.f, 0.f, 0.f, 0.f, 0.f, 0.f, 0.f, 0.f, 0.f, 0.f, 0.f, 0.f, 0.f};
#pragma unroll
            for (int ks = 0; ks < 4; ++ks) { const bf16x8_t af = *(const LAS bf16x8_t*)(Ub + (mt * 32 + col) * UST + n * LRU_BLK + 16 * ks + 8 * hi);
#pragma unroll
                for (int g = 0; g < 2; ++g)
#pragma unroll
                    for (int dh = 0; dh < 2; ++dh) acc[g][dh] = __builtin_amdgcn_mfma_f32_32x32x16_bf16(af, Bf[g][dh][ks], acc[g][dh], 0, 0, 0); }
#pragma unroll
            for (int dh = 0; dh < 2; ++dh) { const int ch = n * LRU_BLK + 32 * dh + col;
                float GA_[4], GB_[4];
#pragma unroll
                for (int g4 = 0; g4 < 4; ++g4) { float av[4], bv[4];
#pragma unroll
                    for (int i = 0; i < 4; ++i) { const int reg = 4 * g4 + i, tok = mt * 32 + 8 * g4 + 4 * hi + i;
                        const float uc = bf2f(Ub[tok * UST + ch]);
                        const float rg = __builtin_amdgcn_rcpf(1.f + __expf(-(acc[0][dh][reg] + ba[dh]))), ig = __builtin_amdgcn_rcpf(1.f + __expf(-(acc[1][dh][reg] + bx[dh])));
                        const float log_a = nsp8[dh] * rg; const float a = __expf(log_a); const float mult = sqrtf(fmaxf(1.f - __expf(2.f * log_a), 0.f));
                        const float b = mult * ig * uc; av[i] = a; bv[i] = b;
                        const size_t gi = ((size_t)(k.row0 + tok) * 2 + dir) * LRU_W + ch; p.LA[gi] = a; p.LB[gi] = b; }
                    float A_, B_;
                    if (dir == 0) { A_ = av[0]; B_ = bv[0];
#pragma unroll
                        for (int i = 1; i < 4; ++i) { B_ = av[i] * B_ + bv[i]; A_ *= av[i]; } }
                    else { A_ = av[3]; B_ = bv[3];
#pragma unroll
                        for (int i = 2; i >= 0; --i) { B_ = av[i] * B_ + bv[i]; A_ *= av[i]; } }
                    GA_[g4] = A_; GB_[g4] = B_; }
#pragma unroll
                for (int s = 0; s < 8; ++s) { const int q = dir ? 7 - s : s; const int g4 = q >> 1, qh = q & 1;
                    const float oa = __shfl_xor(GA_[g4], 32), ob = __shfl_xor(GB_[g4], 32);
                    const float A_ = (qh == hi) ? GA_[g4] : oa, B_ = (qh == hi) ? GB_[g4] : ob;
                    hh[dh] = A_ * hh[dh] + B_; ap[dh] *= A_; } }
        }
        if (hi == 0) { float* ag = agg_ptr(AGG, k.b, dir, dir ? k.sr : k.sf);
#pragma unroll
            for (int dh = 0; dh < 2; ++dh) { const int ch = n * LRU_BLK + 32 * dh + col; ag[ch] = ap[dh]; ag[LRU_W + ch] = hh[dh]; } }
        __syncthreads();
    }
}
__device__ __forceinline__ void ph_lru2(const P& p, const float* AGG, unsigned char* lds, int vcu, int G, int tid, const int nunits) {
    LAS float* HF = (LAS float*)(LAS unsigned char*)lds;
    const int dir = tid >> 8, ch = tid & 255;
    for (int u = vcu; u < nunits; u += G) {
        const LruChunk k = lru_chunk(u);
        const int me = dir ? k.sr : k.sf;
        const float* ag = AGG + (((size_t)k.b * 2 + dir) * NSEQC) * 2 * LRU_W + ch;
        f32x4_t gq[4][2];
#pragma unroll
        for (int i = 0; i < 4; ++i) { const int it = tid + i * NTHR, tt = it >> 5, c8 = (it & 31) * 8;
            if (tt < k.ntok) { const float* gp = p.GA + (size_t)(k.row0 + tt) * LRU_W + c8; gq[i][0] = *(const f32x4_t*)gp; gq[i][1] = *(const f32x4_t*)(gp + 4); }
            else { gq[i][0] = (f32x4_t){0.f, 0.f, 0.f, 0.f}; gq[i][1] = (f32x4_t){0.f, 0.f, 0.f, 0.f}; } }
        float an[8], bn[8];
#pragma unroll
        for (int q = 0; q < 8; ++q) { const int tt = dir ? k.ntok - 1 - q : q; const size_t gi = ((size_t)(k.row0 + tt) * 2 + dir) * LRU_W + ch; an[q] = p.LA[gi]; bn[q] = p.LB[gi]; }
        float h = 0.f;
        for (int s = 0; s < me; s += 16) { float av[16], hv[16];
#pragma unroll
            for (int q = 0; q < 16; ++q) { const bool ok = s + q < me; const int si = ok ? s + q : me - 1; av[q] = ag[(size_t)si * 2 * LRU_W]; hv[q] = ag[(size_t)si * 2 * LRU_W + LRU_W]; av[q] = ok ? av[q] : 1.f; hv[q] = ok ? hv[q] : 0.f; }
#pragma unroll
            for (int q = 0; q < 16; ++q) h = av[q] * h + hv[q]; }
        for (int i0 = 0; i0 < k.ntok; i0 += 8) { float av[8], bv[8];
#pragma unroll
            for (int q = 0; q < 8; ++q) { av[q] = an[q]; bv[q] = bn[q]; }
            if (i0 + 8 < k.ntok) {
#pragma unroll
                for (int q = 0; q < 8; ++q) { const int tt = dir ? k.ntok - 1 - (i0 + 8 + q) : i0 + 8 + q; const size_t gi = ((size_t)(k.row0 + tt) * 2 + dir) * LRU_W + ch; an[q] = p.LA[gi]; bn[q] = p.LB[gi]; } }
#pragma unroll
            for (int q = 0; q < 8; ++q) { const int tt = dir ? k.ntok - 1 - (i0 + q) : i0 + q; h = av[q] * h + bv[q]; HF[(dir * LCH + tt) * LRU_W + ch] = h; } }
        __syncthreads();
#pragma unroll
        for (int i = 0; i < 4; ++i) { const int it = tid + i * NTHR, tt = it >> 5, c8 = (it & 31) * 8;
            if (tt < k.ntok) { const LAS float* hf = HF + tt * LRU_W + c8; const LAS float* hb = HF + (LCH + tt) * LRU_W + c8;
                const f32x4_t f0 = *(const LAS f32x4_t*)hf, f1 = *(const LAS f32x4_t*)(hf + 4), b0 = *(const LAS f32x4_t*)hb, b1 = *(const LAS f32x4_t*)(hb + 4);
                const f32x4_t y0 = gq[i][0] * (f0 + b0), y1 = gq[i][1] * (f1 + b1);
                u32x4_t w; w.x = pk2bf(y0.x, y0.y); w.y = pk2bf(y0.z, y0.w); w.z = pk2bf(y1.x, y1.y); w.w = pk2bf(y1.z, y1.w);
                *(u32x4_t*)(p.Y + (size_t)(k.row0 + tt) * MIX_W + c8) = w; } }
        __syncthreads();
    }
}
__device__ __forceinline__ void ph_diffcomb(const P& p, int l, int gw, int NGW, int lane) {
    static_assert(DIFF_H == 4, "lane mapping assumes 4 diff heads (8 branch outputs of 64)");
    const float lam = diff_lam(p, l), lam_init = 0.8f - 0.6f * expf(-0.3f * (float)l);
    const int hb = lane >> 3, sub = lane & 7, head = hb >> 1;
    float g[8];
#pragma unroll
    for (int j = 0; j < 8; ++j) g[j] = p.diff_subln_g[l * 64 + sub * 8 + j] * (1.f - lam_init);
    for (int r = gw; r < NROW; r += NGW) {
        const u32x4_t v = *(const u32x4_t*)(p.OD + (size_t)r * ODP + hb * 64 + sub * 8);
        float o[8]; o[0] = __uint_as_float(v.x << 16); o[1] = __uint_as_float(v.x & 0xffff0000u); o[2] = __uint_as_float(v.y << 16); o[3] = __uint_as_float(v.y & 0xffff0000u);
        o[4] = __uint_as_float(v.z << 16); o[5] = __uint_as_float(v.z & 0xffff0000u); o[6] = __uint_as_float(v.w << 16); o[7] = __uint_as_float(v.w & 0xffff0000u);
        float ss = 0.f;
#pragma unroll
        for (int j = 0; j < 8; ++j) { const float o2 = __shfl_down(o[j], 8); o[j] = o[j] - lam * o2; ss += o[j] * o[j]; }
        ss += __shfl_xor(ss, 1); ss += __shfl_xor(ss, 2); ss += __shfl_xor(ss, 4);
        const float rs = 1.0f / sqrtf(ss * (1.f / 64.f) + 1e-6f);
        if ((hb & 1) == 0) { u32x4_t w; w.x = pk2bf(o[0] * rs * g[0], o[1] * rs * g[1]); w.y = pk2bf(o[2] * rs * g[2], o[3] * rs * g[3]); w.z = pk2bf(o[4] * rs * g[4], o[5] * rs * g[5]); w.w = pk2bf(o[6] * rs * g[6], o[7] * rs * g[7]);
            *(u32x4_t*)(p.Y + (size_t)r * MIX_W + LRU_W + GQA_H * 64 + head * 64 + sub * 8) = w; }
    }
}
#define FOR_GID(n) for (long gid = (long)blockIdx.x * NTHR + tid_; gid < (long)(n); gid += (long)gridDim.x * NTHR)
#define GRID_SYNC() do { XcdBarrier b2_ = bar; asm volatile("" : "+s"(b2_.bar), "+s"(b2_.x)); xcd_barrier(b2_); } while (0)
#define CTL_NB_WORD 16384
#define PHASE_P() int tid_ = threadIdx.x; asm volatile("" : "+v"(tid_)); const P& q = p

struct AttnWork { const attn_body::bf16* Qu; const attn_body::bf16* Kh; const attn_body::bf16* Vh; attn_body::bf16* Ou; int nt; };
__device__ __forceinline__ AttnWork attn_decode(const P& p, int b, int vh, int row0, int nt) {
    AttnWork w;
    const int kh = vh < GQA_H ? vh / (GQA_H / GQA_KV) : GQA_KV + (vh - GQA_H);
    const int vv = vh < GQA_H ? vh / (GQA_H / GQA_KV) : GQA_KV + (vh - GQA_H) / 2;
    w.Qu = (const attn_body::bf16*)(p.ZQ + (size_t)row0 * QP + vh * 64);
    w.Kh = (const attn_body::bf16*)(p.ZK + (size_t)b * SKEY * KP + kh * 64);
    w.Vh = (const attn_body::bf16*)(p.ZV + (size_t)b * SKEY * VP + vv * 64);
    if (vh < GQA_H) { w.Ou = (attn_body::bf16*)(p.Y + (size_t)row0 * MIX_W + LRU_W + vh * 64); }
    else { w.Ou = (attn_body::bf16*)(p.OD + (size_t)row0 * ODP + (vh - GQA_H) * 64); }
    w.nt = nt; return w;
}
__device__ __forceinline__ void diffcomb_wave(const P& p, int l, float lam, int row_first, int h, int lane) {
    asm volatile("s_waitcnt vmcnt(0)" ::: "memory");
    const float lam_init = 0.8f - 0.6f * expf(-0.3f * (float)l);
    const int rs = lane >> 5, dp = lane & 31;
    const float g0 = p.diff_subln_g[l * 64 + 2 * dp] * (1.f - lam_init), g1 = p.diff_subln_g[l * 64 + 2 * dp + 1] * (1.f - lam_init);
    unsigned u1[16], u2[16];
#pragma unroll
    for (int it = 0; it < 16; ++it) { const size_t r = (size_t)(row_first + 2 * it + rs);
        u1[it] = __hip_atomic_load((const unsigned*)(p.OD + r * ODP + (2 * h) * 64 + 2 * dp), __ATOMIC_RELAXED, __HIP_MEMORY_SCOPE_AGENT);
        u2[it] = __hip_atomic_load((const unsigned*)(p.OD + r * ODP + (2 * h + 1) * 64 + 2 * dp), __ATOMIC_RELAXED, __HIP_MEMORY_SCOPE_AGENT); }
#pragma unroll
    for (int it = 0; it < 16; ++it) { const size_t r = (size_t)(row_first + 2 * it + rs);
        const float a0 = __uint_as_float(u1[it] << 16) - lam * __uint_as_float(u2[it] << 16), a1 = __uint_as_float(u1[it] & 0xffff0000u) - lam * __uint_as_float(u2[it] & 0xffff0000u);
        const float ss = half32_sum(a0 * a0 + a1 * a1);
        const float rsq = 1.0f / sqrtf(ss * (1.f / 64.f) + 1e-6f);
        *(unsigned*)(p.Y + r * MIX_W + LRU_W + GQA_H * 64 + h * 64 + 2 * dp) = pk2bf(a0 * rsq * g0, a1 * rsq * g1); }
}
__device__ __forceinline__ void attn_one(const P& p, int l, float lam, char* lds, int b, int vh, int row0, int nt, int wid, int lane, const attn_body::bf16* knext = nullptr, const bool kpre = false) {
    const AttnWork w = attn_decode(p, b, vh, row0, nt);
    if (vh < GQA_H) attn_body::attn_unit<8, QP, KP, VP, MIX_W, false, true>(w.Qu, w.Kh, w.Vh, w.Ou, w.nt, lds, knext, kpre);
    else {
        const int* nb = (const int*)p.ctl + CTL_NB_WORD + 64 * l + b * 16 + (vh - GQA_H);
        const float q2 = __int_as_float(__builtin_amdgcn_readfirstlane(nb[0])), k2 = __int_as_float(__builtin_amdgcn_readfirstlane(nb[8]));
        if (sqrtf(q2 * k2) * 1.05f < 64.f) attn_body::attn_unit<8, QP, KP, VP, MIX_W, true, true>(w.Qu, w.Kh, w.Vh, w.Ou, w.nt, lds, knext, kpre);
        else attn_body::attn_unit<8, QP, KP, VP, MIX_W, true, false>(w.Qu, w.Kh, w.Vh, w.Ou, w.nt, lds, knext, kpre);
        if ((vh - GQA_H) & 1) diffcomb_wave(p, l, lam, row0 + wid * 32, (vh - GQA_H) >> 1, lane); }
}
__device__ __forceinline__ void attn_phase_all(const P& p, int l, char* lds, int vcu, int G, int tid, const bool need_ctx) {
    constexpr int NQB = SEQ / 256, NLU = BATCH * NVH * NQB;
    static_assert(NLU % 256 == 0 && NVH == 16 && CTX_LEN == 256, "unit deal");
    const int wid = __builtin_amdgcn_readfirstlane(tid >> 6), lane = tid & 63;
    const float lam = diff_lam(p, l);
    bool kpre = false;
    for (int u = vcu; u < NLU; u += G) { const int i = u / 256, v = u % 256, x = v / 32, j = v % 32; const int b = x / 4, g = x % 4; const int vh = (i == 0) ? 2 * g : (i == 1) ? GQA_H + 2 * g : (i == 2) ? GQA_H + 2 * g + 1 : 2 * g + 1;
        const attn_body::bf16* knext = nullptr;
        if (u + G < NLU) { const int u2 = u + G, i2 = u2 / 256, v2 = u2 % 256, x2 = v2 / 32; const int b2 = x2 / 4, g2 = x2 % 4; const int vh2 = (i2 == 0) ? 2 * g2 : (i2 == 1) ? GQA_H + 2 * g2 : (i2 == 2) ? GQA_H + 2 * g2 + 1 : 2 * g2 + 1;
            knext = attn_decode(p, b2, vh2, b2 * SEQ, SKEY / 64).Kh; }
        attn_one(p, l, lam, lds, b, vh, b * SEQ + j * 256, SKEY / 64, wid, lane, knext, kpre); kpre = knext != nullptr; }
    if (need_ctx) for (int k = 0; k < BATCH * NVH / 2; ++k) if ((k * 16) % G == vcu) {
#pragma unroll 1
        for (int c = 2 * k; c < 2 * k + 2; ++c) { const int b = c / NVH, vh = c % NVH; attn_one(p, l, lam, lds, b, vh, NLAT + b * CTX_LEN, CTX_LEN / 64, wid, lane); } }
}

__global__ void __launch_bounds__(NTHR, 2) k_mega(P p) {
    extern __shared__ __attribute__((aligned(16))) unsigned char lds[];
    if (threadIdx.x < 4) ((volatile LAS unsigned*)(lds + LDS_MISC))[threadIdx.x] = 0u;
    __syncthreads();
    XcdBarrier bar = xcd_barrier_post(p.ctl, (volatile LAS unsigned*)(lds + LDS_MISC));
    const int G = gridDim.x; const int vcu = (G % 8 == 0) ? ((int)blockIdx.x % 8) * (G / 8) + (int)blockIdx.x / 8 : (int)blockIdx.x;
    const int wave_ = __builtin_amdgcn_readfirstlane((int)threadIdx.x >> 6);
    { PHASE_P(); ph_ada(q, lds, vcu, G, wave_, tid_ & 63); }
    GRID_SYNC();
    { PHASE_P(); ph_mod0(q, vcu * 8 + wave_, G * 8, tid_ & 63); }
    for (int l = 0; l < DEPTH; ++l) {
        const bool need_ctx = l + 1 < DEPTH; const int nrow = need_ctx ? NROW : NLAT;
        { PHASE_P(); ph_cvt(q, l, lds, vcu, G, tid_); }
        GRID_SYNC();
        {
            pg8::DenseOrder S; S.init(p.H, WB_WIN(p.WB[l & 1]), NROW, IN_W, D_MODEL, G, (int)blockIdx.x);
            pg8::EpiInProj E{p.AX, p.GA, p.ZQ, p.ZK, p.ZV, p.q_norm_g + l * 64, p.k_norm_g + l * 64, (int*)p.ctl + CTL_NB_WORD + 64 * l};
            pg8::gemm_phase<pg8::EpiInProj, pg8::DenseOrder, true, true>((LAS unsigned char*)lds, D_MODEL, S, E); }
        GRID_SYNC();
        { PHASE_P(); ph_lru1(q, l, q.HS, lds, vcu, G, tid_); }
        GRID_SYNC();
        { PHASE_P(); ph_lru2(q, q.HS, lds, vcu, G, tid_, need_ctx ? LRU_UNITS : BATCH * NLCH); __syncthreads(); }
        { PHASE_P(); attn_phase_all(q, l, (char*)lds, vcu, G, tid_, need_ctx); }
        GRID_SYNC();
        {
            pg8::DenseOrder S; S.init(p.Y, WB_WOUT(p.WB[l & 1]), nrow, D_MODEL, MIX_W, G, (int)blockIdx.x);
            pg8::EpiBf16Plain E{(bf16_t*)p.YO, D_MODEL};
            pg8::gemm_phase<pg8::EpiBf16Plain, pg8::DenseOrder, true, true>((LAS unsigned char*)lds, MIX_W, S, E); }
        GRID_SYNC();
        { PHASE_P(); ph_lnroute(q, l, lds, vcu * 8 + wave_, G * 8, tid_, tid_ & 63, nrow); }
        GRID_SYNC();
        {
            pg8::MoeOrder S; S.init(p.H, WB_WGU(p.WB[l & 1]), p.cnt + CNT_IDX(l, 0), p.SLOTTOK, 2 * EXP_FF, D_MODEL, true, G, (int)blockIdx.x);
            pg8::EpiSwiGLU E{p.HM};
            pg8::gemm_phase<pg8::EpiSwiGLU, pg8::MoeOrder, true, true>((LAS unsigned char*)lds, D_MODEL, S, E); }
        GRID_SYNC();
        {
            pg8::MoeOrder S; S.init(p.HM, WB_WD(p.WB[l & 1]), p.cnt + CNT_IDX(l, 0), p.SLOTTOK, D_MODEL, EXP_FF, false, G, (int)blockIdx.x);
            pg8::EpiMoeDown E{p.FO, p.TG, p.SLOTTOK, S.pl};
            pg8::gemm_phase<pg8::EpiMoeDown, pg8::MoeOrder, true, true>((LAS unsigned char*)lds, EXP_FF, S, E); }
        GRID_SYNC();
        { PHASE_P(); ph_lnfinal(q, l, vcu * 8 + wave_, G * 8, tid_ & 63, nrow); }
    }
}
extern "C" void kernel_launch(void* const* d_in, const int* in_sizes, int n_in, void* d_out, int out_size, void* d_ws, size_t ws_size, hipStream_t stream) {
    (void)in_sizes; (void)n_in; (void)out_size;
    WsMap m = ws_map();
    if (ws_size < m.total) { fprintf(stderr, "ws too small: %zu < %zu\n", ws_size, m.total); return; }
    static int grid = 0;
    if (!grid) { int dev = 0, cus = 0; (void)hipGetDevice(&dev); (void)hipDeviceGetAttribute(&cus, hipDeviceAttributeMultiprocessorCount, dev);
        if (hipFuncSetAttribute((const void*)k_mega, hipFuncAttributeMaxDynamicSharedMemorySize, LDS_BYTES) != hipSuccess) { fprintf(stderr, "hipFuncSetAttribute failed\n"); grid = -1; return; }
        int per_cu = 0; (void)hipOccupancyMaxActiveBlocksPerMultiprocessor(&per_cu, (const void*)k_mega, NTHR, LDS_BYTES); (void)hipGetLastError();
        if (per_cu < 1) fprintf(stderr, "note: occupancy query says %d\n", per_cu);
        grid = cus; }
    if (grid < 0) return;
    P p; memset(&p, 0, sizeof(p)); fill_inputs(p, d_in, d_out); fill_ws(p, (unsigned char*)d_ws);
    (void)hipMemsetAsync(p.ctl, 0, 1 << 17, stream);
    k_mega<<<dim3(grid), dim3(NTHR), LDS_BYTES, stream>>>(p);
}
```

```cpp
#include <hip/hip_runtime.h>
#include <cstdio>
#include <stdint.h>
#include <math.h>
#include <string.h>

#ifdef CPU_TEST
#define HD inline
#define UNROLL
#else
#define HD __host__ __device__ __forceinline__
#define UNROLL _Pragma("unroll")
#endif
#if defined(__HIP_DEVICE_COMPILE__)
#define LAUNDER_V(x) asm volatile("" : "+v"(x))
#else
#define LAUNDER_V(x) do {} while (0)
#endif

#ifndef D_MODEL
#define D_MODEL 1024
#define BATCH 2
#define SEQ 8192
#define DEPTH 4
#define GRID_W 64
#define CTX_LEN 256
#define LRU_W 256
#define GQA_H 8
#define GQA_KV 2
#define DIFF_H 4
#define EXP_FF 512
#endif
#define LRU_BLK (LRU_W / 4)
#define N_EXP 16
#define CNT_STRIDE 32
#define CNT_IDX(l, e) ((((l) * N_EXP) + (e)) * CNT_STRIDE)
#define OFF_AX 0
#define OFF_AG (LRU_W)
#define OFF_GQ (2 * LRU_W)
#define OFF_GK (OFF_GQ + GQA_H * 64)
#define OFF_GV (OFF_GK + GQA_KV * 64)
#define OFF_DQ (OFF_GV + GQA_KV * 64)
#define OFF_DK (OFF_DQ + DIFF_H * 64)
#define OFF_DV (OFF_DK + DIFF_H * 64)
#define IN_W (OFF_DV + DIFF_H * 64)
#define MIX_W (LRU_W + GQA_H * 64 + DIFF_H * 64)
#define NLAT (BATCH * SEQ)
#define NCTX (BATCH * CTX_LEN)
#define NROW (NLAT + NCTX)
#define SKEY (CTX_LEN + SEQ)
#define NVH (GQA_H + 2 * DIFF_H)
#define NKH (GQA_KV + 2 * DIFF_H)
#define NVV (GQA_KV + DIFF_H)
#define QP (NVH * 64)
#define KP (NKH * 64)
#define VP (NVV * 64)
#define ODP MIX_W
#define GUB (EXP_FF < 128 ? EXP_FF : 128)
#define MOE_TM 256
#define MOE_ROWS (2 * NROW + N_EXP * MOE_TM)
#define DN_ALPHA 1.681792830507429f
#define LOG2E 1.4426950408889634f
#define QS_G (0.125f * LOG2E)
#define QS_D (0.17677669529663687f * LOG2E)

#ifdef EXACT_TEST
typedef float bf16_t;
HD float bf2f(bf16_t h) { return h; }
HD bf16_t f2bf(float f) { return f; }
#else
typedef unsigned short bf16_t;
HD float bf2f(bf16_t h) { unsigned u = ((unsigned)h) << 16; float f; memcpy(&f, &u, 4); return f; }
HD bf16_t f2bf(float f) { unsigned u; memcpy(&u, &f, 4); return (bf16_t)((u + 0x7fffu + ((u >> 16) & 1u)) >> 16); }
#endif

struct P {
    const float *x, *c, *ctx, *c_ctx, *ada_w, *ada_b, *w_in, *conv_w, *conv_b, *rg_wa, *rg_ba, *rg_wx, *rg_bx, *rg_lam,
        *q_norm_g, *k_norm_g, *diff_lambda, *diff_subln_g, *w_out, *ln1_g, *ln1_b, *ln2_g, *ln2_b, *router_w, *router_b,
        *exp_w_gate, *exp_w_up, *exp_w_down;
    float* out;
    unsigned* ctl;
    int* cnt;
    float* MOD;
    bf16_t* WB[2];
    float* XR;
    bf16_t* H;
    float* Z;
    float *LA, *LB, *HS;
    float* YO;
    bf16_t* FO;
    bf16_t *ZQ, *ZK, *ZV;
    float *AX, *GA;
    bf16_t* Y;
    bf16_t* OD;
    float* TG;
    int* SLOTTOK;
    bf16_t* HM;
    float* XRo; bf16_t* Ho; float* TGo; int* SLOTTOKo; int* cnto;
    int pad_[2];
};
#define WB_WIN(wb) (wb)
#define WB_WOUT(wb) ((wb) + (size_t)IN_W * D_MODEL)
#define WB_WGU(wb) (WB_WOUT(wb) + (size_t)D_MODEL * MIX_W)
#define WB_WD(wb) (WB_WGU(wb) + (size_t)N_EXP * 2 * EXP_FF * D_MODEL)
#define WB_ELEMS ((size_t)IN_W * D_MODEL + (size_t)D_MODEL * MIX_W + (size_t)N_EXP * 3 * EXP_FF * D_MODEL)

HD float sigmoidf_(float x) { return 1.f / (1.f + expf(-x)); }
HD float siluf_(float x) { return x / (1.f + expf(-x)); }
HD float gelu_tanhf_(float x) { return 0.5f * x * (1.f + tanhf(0.7978845608028654f * (x + 0.044715f * x * x * x))); }
HD float softplusf_(float x) { return x > 20.f ? x : log1pf(expf(x)); }

HD int row_who(int r) { return r < NLAT ? r / SEQ : BATCH; }
HD int row_kidx(int r) { if (r < NLAT) { int b = r / SEQ, t = r % SEQ; return b * SKEY + CTX_LEN + t; } int q = r - NLAT; int b = q / CTX_LEN, j = q % CTX_LEN; return b * SKEY + j; }
HD int gu_row(int half, int j) { return (j / GUB) * 2 * GUB + half * GUB + (j % GUB); }

HD long n_cvt() { return (long)WB_ELEMS; }
HD void st_cvt(const P& p, int l, long gid) {
    bf16_t* wb = p.WB[l & 1];
    size_t i = (size_t)gid;
    const size_t n_in = (size_t)IN_W * D_MODEL, n_out = (size_t)D_MODEL * MIX_W, n_gu = (size_t)N_EXP * 2 * EXP_FF * D_MODEL;
    if (i < n_in) { int n = (int)(i / D_MODEL), k = (int)(i % D_MODEL); wb[i] = f2bf(p.w_in[((size_t)l * D_MODEL + k) * IN_W + n]); return; }
    i -= n_in;
    if (i < n_out) { int n = (int)(i / MIX_W), k = (int)(i % MIX_W); WB_WOUT(wb)[i] = f2bf(p.w_out[((size_t)l * MIX_W + k) * D_MODEL + n]); return; }
    i -= n_out;
    if (i < n_gu) {
        int e = (int)(i / ((size_t)2 * EXP_FF * D_MODEL)); size_t q = i % ((size_t)2 * EXP_FF * D_MODEL); int r = (int)(q / D_MODEL), k = (int)(q % D_MODEL);
        int t = r / (2 * GUB), w = r % (2 * GUB), half = w / GUB, cc = w % GUB, j = t * GUB + cc;
        const float* src = half ? p.exp_w_up : p.exp_w_gate;
        WB_WGU(wb)[i] = f2bf(src[(((size_t)l * N_EXP + e) * D_MODEL + k) * EXP_FF + j]); return; }
    i -= n_gu;
    { int e = (int)(i / ((size_t)D_MODEL * EXP_FF)); size_t q = i % ((size_t)D_MODEL * EXP_FF); int n = (int)(q / EXP_FF), k = (int)(q % EXP_FF);
      WB_WD(wb)[i] = f2bf(p.exp_w_down[(((size_t)l * N_EXP + e) * EXP_FF + k) * D_MODEL + n]); }
}

HD long n_ada() { return (long)DEPTH * 6 * D_MODEL; }
HD void st_ada(const P& p, long gid) {
    int l = (int)(gid / (6 * D_MODEL)), col = (int)(gid % (6 * D_MODEL));
    float acc[BATCH + 1]; UNROLL for (int w = 0; w <= BATCH; ++w) acc[w] = 0.f;
    const float* W = p.ada_w + (size_t)l * D_MODEL * 6 * D_MODEL + col;
    for (int k = 0; k < D_MODEL; ++k) { float wv = W[(size_t)k * 6 * D_MODEL];
        for (int b = 0; b < BATCH; ++b) acc[b] += siluf_(p.c[b * D_MODEL + k]) * wv;
        acc[BATCH] += siluf_(p.c_ctx[k]) * wv; }
    float bias = p.ada_b[l * 6 * D_MODEL + col];
    UNROLL for (int w = 0; w <= BATCH; ++w) p.MOD[((size_t)l * 3 + w) * 6 * D_MODEL + col] = acc[w] + bias;
}
HD const float* modp(const P& p, int l, int who, int chunk) { return p.MOD + ((size_t)l * 3 + who) * 6 * D_MODEL + chunk * D_MODEL; }

HD long n_mod0() { return (long)NROW * D_MODEL; }
HD void st_mod0(const P& p, long gid) {
    int r = (int)(gid / D_MODEL), cc = (int)(gid % D_MODEL); int who = row_who(r);
    float v = r < NLAT ? p.x[(size_t)r * D_MODEL + cc] : p.ctx[(size_t)(r - NLAT) * D_MODEL + cc];
    p.XR[gid] = v;
    p.H[gid] = f2bf(v * (1.f + modp(p, 0, who, 1)[cc]) + modp(p, 0, who, 0)[cc]);
}

HD void dot4x4(const bf16_t* const a[4], const bf16_t* const b[4], int K, float acc[4][4]) {
    UNROLL for (int i = 0; i < 4; ++i) UNROLL for (int j = 0; j < 4; ++j) acc[i][j] = 0.f;
    for (int k = 0; k < K; k += 4) {
        float av[4][4], bv[4][4];
        UNROLL for (int i = 0; i < 4; ++i) UNROLL for (int q = 0; q < 4; ++q) { av[i][q] = bf2f(a[i][k + q]); bv[i][q] = bf2f(b[i][k + q]); }
        UNROLL for (int i = 0; i < 4; ++i) UNROLL for (int j = 0; j < 4; ++j) UNROLL for (int q = 0; q < 4; ++q) acc[i][j] += av[i][q] * bv[j][q];
    }
}
HD long n_gemm_in() { return (long)(NROW / 4) * (IN_W / 4); }
HD void st_gemm_in(const P& p, int l, long gid) {
    int m0 = (int)(gid / (IN_W / 4)) * 4, n0 = (int)(gid % (IN_W / 4)) * 4;
    const bf16_t* wb = WB_WIN(p.WB[l & 1]); const bf16_t *a[4], *b[4];
    UNROLL for (int i = 0; i < 4; ++i) { a[i] = p.H + (size_t)(m0 + i) * D_MODEL; b[i] = wb + (size_t)(n0 + i) * D_MODEL; }
    float acc[4][4]; dot4x4(a, b, D_MODEL, acc);
    UNROLL for (int i = 0; i < 4; ++i) UNROLL for (int j = 0; j < 4; ++j) p.Z[(size_t)(m0 + i) * IN_W + n0 + j] = acc[i][j];
}
HD long n_gemm_out() { return (long)(NROW / 4) * (D_MODEL / 4); }
HD void st_gemm_out(const P& p, int l, long gid) {
    int m0 = (int)(gid / (D_MODEL / 4)) * 4, n0 = (int)(gid % (D_MODEL / 4)) * 4;
    const bf16_t* wb = WB_WOUT(p.WB[l & 1]); const bf16_t *a[4], *b[4];
    UNROLL for (int i = 0; i < 4; ++i) { a[i] = p.Y + (size_t)(m0 + i) * MIX_W; b[i] = wb + (size_t)(n0 + i) * MIX_W; }
    float acc[4][4]; dot4x4(a, b, MIX_W, acc);
    UNROLL for (int i = 0; i < 4; ++i) UNROLL for (int j = 0; j < 4; ++j) p.YO[(size_t)(m0 + i) * D_MODEL + n0 + j] = acc[i][j];
}

HD void rope_cs(int t, int i, int nfreq, float& cs, float& sn) {
    int rowp = t / GRID_W, colp = t % GRID_W;
    float pos = (float)(i < nfreq ? rowp : colp); int j = i % nfreq;
    float inv = exp2f(-(float)j / (float)nfreq * 13.287712379549449f);
    float ang = pos * inv;
#if defined(__HIP_DEVICE_COMPILE__)
    cs = __cosf(ang); sn = __sinf(ang);
#else
    cs = cosf(ang); sn = sinf(ang);
#endif
}
HD long n_post() { return (long)NROW * (IN_W / 64); }
HD void st_post(const P& p, int l, long gid) {
    int r = (int)(gid / (IN_W / 64)), job = (int)(gid % (IN_W / 64)); int c0 = job * 64;
    const float* z = p.Z + (size_t)r * IN_W + c0;
    bool lat = r < NLAT; int t = lat ? r % SEQ : 0; int kidx = row_kidx(r);
    float v[64]; UNROLL for (int d = 0; d < 64; ++d) v[d] = z[d];
    unsigned zz_ = 0; LAUNDER_V(zz_); const bf16_t zz = (bf16_t)zz_;
    if (c0 < OFF_AG) { UNROLL for (int d = 0; d < 64; ++d) p.AX[(size_t)r * LRU_W + c0 + d] = v[d]; return; }
    if (c0 < OFF_GQ) { UNROLL for (int d = 0; d < 64; ++d) p.GA[(size_t)r * LRU_W + (c0 - OFF_AG) + d] = gelu_tanhf_(v[d]); return; }
    if (c0 < OFF_GV) {
        bool isq = c0 < OFF_GK; int h = isq ? (c0 - OFF_GQ) / 64 : (c0 - OFF_GK) / 64;
        const float* g = (isq ? p.q_norm_g : p.k_norm_g) + l * 64;
        float ss = 0.f; UNROLL for (int d = 0; d < 64; ++d) ss += v[d] * v[d];
        float rs = 1.0f / sqrtf(ss / 64.f + 1e-6f);
        UNROLL for (int d = 0; d < 64; ++d) v[d] = v[d] * rs * g[d];
        if (lat) UNROLL for (int i = 0; i < 32; ++i) { float cs, sn; rope_cs(t, i, 16, cs, sn); float x0 = v[2 * i], x1 = v[2 * i + 1]; v[2 * i] = x0 * cs - x1 * sn; v[2 * i + 1] = x0 * sn + x1 * cs; }
        if (isq) { UNROLL for (int d = 0; d < 64; ++d) p.ZQ[(size_t)r * QP + h * 64 + d] = f2bf(v[d] * QS_G); }
        else { UNROLL for (int d = 0; d < 64; ++d) p.ZK[(size_t)kidx * KP + h * 64 + d] = f2bf(v[d]); }
        return; }
    if (c0 < OFF_DQ) { int h = (c0 - OFF_GV) / 64; UNROLL for (int d = 0; d < 64; ++d) p.ZV[(size_t)kidx * VP + h * 64 + d] = f2bf(v[d]); return; }
    if (c0 < OFF_DV) {
        bool isq = c0 < OFF_DK; int h = isq ? (c0 - OFF_DQ) / 64 : (c0 - OFF_DK) / 64;
        UNROLL for (int m = 0; m < 2; ++m) {
            float* w = v + m * 32;
            if (lat) UNROLL for (int i = 0; i < 16; ++i) { float cs, sn; rope_cs(t, i, 8, cs, sn); float x0 = w[2 * i], x1 = w[2 * i + 1]; w[2 * i] = x0 * cs - x1 * sn; w[2 * i + 1] = x0 * sn + x1 * cs; }
            if (isq) { bf16_t* o = p.ZQ + (size_t)r * QP + (GQA_H + 2 * h + m) * 64; UNROLL for (int d = 0; d < 32; ++d) { o[d] = f2bf(w[d] * QS_D); o[32 + d] = zz; } }
            else { bf16_t* o = p.ZK + (size_t)kidx * KP + (GQA_KV + 2 * h + m) * 64; UNROLL for (int d = 0; d < 32; ++d) { o[d] = f2bf(w[d]); o[32 + d] = zz; } }
        }
        return; }
    { int h = (c0 - OFF_DV) / 64; UNROLL for (int d = 0; d < 64; ++d) p.ZV[(size_t)kidx * VP + (GQA_KV + h) * 64 + d] = f2bf(v[d]); }
}

HD float conv_u(const P& p, int l, int r, int ch) {
    int base, pos, len;
    if (r < NLAT) { base = (r / SEQ) * SEQ; pos = r % SEQ; len = SEQ; } else { int q = r - NLAT; base = NLAT + (q / CTX_LEN) * CTX_LEN; pos = q % CTX_LEN; len = CTX_LEN; }
    float y = p.conv_b[l * LRU_W + ch];
    UNROLL for (int k = 0; k < 4; ++k) { int pp = pos + k - 1; if (pp >= 0 && pp < len) y += p.AX[(size_t)(base + pp) * LRU_W + ch] * p.conv_w[(l * 4 + k) * LRU_W + ch]; }
    return y;
}
HD long n_lru_ab() { return (long)NROW * 2 * LRU_W; }
HD void st_lru_ab(const P& p, int l, long gid) {
    int r = (int)(gid / (2 * LRU_W)), dir = (int)((gid / LRU_W) % 2), ch = (int)(gid % LRU_W);
    int n = ch / LRU_BLK, d = ch % LRU_BLK;
    const float* wa = p.rg_wa + ((size_t)(l * 2 + dir) * 4 + n) * LRU_BLK * LRU_BLK;
    const float* wx = p.rg_wx + ((size_t)(l * 2 + dir) * 4 + n) * LRU_BLK * LRU_BLK;
    float sa = 0.f, sx = 0.f, uc = 0.f;
    for (int c = 0; c < LRU_BLK; ++c) { float u = conv_u(p, l, r, n * LRU_BLK + c); if (c == d) uc = u; sa += u * wa[c * LRU_BLK + d]; sx += u * wx[c * LRU_BLK + d]; }
    float rg = sigmoidf_(sa + p.rg_ba[(l * 2 + dir) * LRU_W + ch]), ig = sigmoidf_(sx + p.rg_bx[(l * 2 + dir) * LRU_W + ch]);
    float log_a = -8.0f * rg * softplusf_(-p.rg_lam[(l * 2 + dir) * LRU_W + ch]);
    float a = expf(log_a), mult = sqrtf(-expm1f(2.f * log_a));
    p.LA[gid] = a; p.LB[gid] = mult * (ig * uc);
}
HD long n_lru_scan() { return (long)BATCH * 2 * LRU_W; }
HD void st_lru_scan(const P& p, long gid) {
    int b = (int)(gid / (2 * LRU_W)), dir = (int)((gid / LRU_W) % 2), ch = (int)(gid % LRU_W);
    float h = 0.f;
    for (int s = 0; s < SKEY; ++s) {
        int r;
        if (dir == 0) r = s < CTX_LEN ? NLAT + b * CTX_LEN + s : b * SEQ + (s - CTX_LEN);
        else r = s < CTX_LEN ? NLAT + b * CTX_LEN + (CTX_LEN - 1 - s) : b * SEQ + (SEQ - 1 - (s - CTX_LEN));
        size_t i = ((size_t)r * 2 + dir) * LRU_W + ch;
        h = p.LA[i] * h + p.LB[i]; p.HS[i] = h;
    }
}

HD long n_att() { return (long)NROW * NVH; }
HD void st_att(const P& p, long gid) {
    int vh = (int)(gid / NROW), r = (int)(gid % NROW);
    int b = r < NLAT ? r / SEQ : (r - NLAT) / CTX_LEN; int nk = r < NLAT ? SKEY : CTX_LEN;
    int kh = vh < GQA_H ? vh / (GQA_H / GQA_KV) : GQA_KV + (vh - GQA_H);
    int vv = vh < GQA_H ? vh / (GQA_H / GQA_KV) : GQA_KV + (vh - GQA_H) / 2;
    float q[64], o[64]; UNROLL for (int d = 0; d < 64; ++d) { q[d] = bf2f(p.ZQ[(size_t)r * QP + vh * 64 + d]); o[d] = 0.f; }
    float m = -1e30f, lsum = 0.f;
    const bf16_t* K = p.ZK + (size_t)b * SKEY * KP + kh * 64; const bf16_t* V = p.ZV + (size_t)b * SKEY * VP + vv * 64;
    for (int j = 0; j < nk; ++j) {
        float s = 0.f; UNROLL for (int d = 0; d < 64; ++d) s += q[d] * bf2f(K[(size_t)j * KP + d]);
        if (s > m) { float f = exp2f(m - s); lsum *= f; UNROLL for (int d = 0; d < 64; ++d) o[d] *= f; m = s; }
        float pr = exp2f(s - m); lsum += pr;
        UNROLL for (int d = 0; d < 64; ++d) o[d] += pr * bf2f(V[(size_t)j * VP + d]);
    }
    float inv = 1.f / lsum;
    if (vh < GQA_H) { UNROLL for (int d = 0; d < 64; ++d) p.Y[(size_t)r * MIX_W + LRU_W + vh * 64 + d] = f2bf(o[d] * inv); }
    else { UNROLL for (int d = 0; d < 64; ++d) p.OD[(size_t)r * ODP + (vh - GQA_H) * 64 + d] = f2bf(o[d] * inv); }
}

HD float diff_lam(const P& p, int l) {
    const float* dl = p.diff_lambda + l * 4 * 32; float s0 = 0.f, s1 = 0.f;
    UNROLL for (int i = 0; i < 32; ++i) { s0 += dl[i] * dl[32 + i]; s1 += dl[64 + i] * dl[96 + i]; }
    float lam_init = 0.8f - 0.6f * expf(-0.3f * (float)l);
    return expf(s0) - expf(s1) + lam_init;
}
HD long n_yasm() { return (long)NROW * (LRU_W / 64 + DIFF_H); }
HD void st_yasm(const P& p, int l, long gid) {
    const int NJ = LRU_W / 64 + DIFF_H; int r = (int)(gid / NJ), job = (int)(gid % NJ);
    if (job < LRU_W / 64) {
        UNROLL for (int d = 0; d < 64; ++d) { int ch = job * 64 + d;
            float h = p.HS[((size_t)r * 2 + 0) * LRU_W + ch] + p.HS[((size_t)r * 2 + 1) * LRU_W + ch];
            p.Y[(size_t)r * MIX_W + ch] = f2bf(p.GA[(size_t)r * LRU_W + ch] * h); }
        return; }
    int h = job - LRU_W / 64; float lam = diff_lam(p, l); float lam_init = 0.8f - 0.6f * expf(-0.3f * (float)l);
    float o[64], ss = 0.f;
    UNROLL for (int d = 0; d < 64; ++d) { o[d] = bf2f(p.OD[(size_t)r * ODP + (2 * h) * 64 + d]) - lam * bf2f(p.OD[(size_t)r * ODP + (2 * h + 1) * 64 + d]); ss += o[d] * o[d]; }
    float rs = 1.0f / sqrtf(ss / 64.f + 1e-6f);
    UNROLL for (int d = 0; d < 64; ++d) p.Y[(size_t)r * MIX_W + LRU_W + GQA_H * 64 + h * 64 + d] = f2bf(o[d] * rs * p.diff_subln_g[l * 64 + d] * (1.f - lam_init));
}

#ifdef CPU_TEST
HD int atomic_inc(int* p_) { int v; _Pragma("omp atomic capture") { v = *p_; *p_ += 1; } return v; }
#else
__device__ __forceinline__ int atomic_inc(int* p_) { return atomicAdd(p_, 1); }
#endif
HD void route_select(const float (&lg)[N_EXP], const float* router_b, int& e1, int& e2, float& gw1, float& gw2) {
    float mx = lg[0]; UNROLL for (int e = 1; e < N_EXP; ++e) mx = fmaxf(mx, lg[e]);
    float pr[N_EXP], sum = 0.f; UNROLL for (int e = 0; e < N_EXP; ++e) { pr[e] = expf(lg[e] - mx); sum += pr[e]; }
    float inv = 1.f / sum;
    UNROLL for (int e = 0; e < N_EXP; ++e) pr[e] *= inv;
    float bs = -1e30f; e1 = 0; e2 = 1; float bp1 = 0.f, bp2 = 0.f;
    UNROLL for (int g = 0; g < 4; ++g) {
        float s1 = -1e30f, p1 = 0.f; int i1 = 0;
        UNROLL for (int i = 0; i < 4; ++i) { float sv = pr[g * 4 + i] + router_b[g * 4 + i]; if (sv > s1) { s1 = sv; i1 = i; p1 = pr[g * 4 + i]; } }
        float s2 = -1e30f, p2 = 0.f; int i2 = 0;
        UNROLL for (int i = 0; i < 4; ++i) { float sv = pr[g * 4 + i] + router_b[g * 4 + i]; if (i != i1 && sv > s2) { s2 = sv; i2 = i; p2 = pr[g * 4 + i]; } }
        float sc = s1 + s2;
        if (sc > bs) { bs = sc; e1 = g * 4 + i1; e2 = g * 4 + i2; bp1 = p1; bp2 = p2; } }
    float ws = bp1 + bp2; gw1 = bp1 / ws; gw2 = bp2 / ws;
}
HD long n_lnroute() { return (long)NROW; }
HD void st_lnroute(const P& p, int l, long gid) {
    int r = (int)gid, who = row_who(r);
    float* xr = p.XR + (size_t)r * D_MODEL; const float* yo = p.YO + (size_t)r * D_MODEL;
    const float *g1 = modp(p, l, who, 2), *sh2 = modp(p, l, who, 3), *sc2 = modp(p, l, who, 4);
    float mu = 0.f; for (int c = 0; c < D_MODEL; ++c) mu += DN_ALPHA * xr[c] + g1[c] * yo[c];
    mu /= D_MODEL; float var = 0.f;
    for (int c = 0; c < D_MODEL; ++c) { float t = DN_ALPHA * xr[c] + g1[c] * yo[c] - mu; var += t * t; }
    float rstd = 1.0f / sqrtf(var / D_MODEL + 1e-6f);
    float lg[N_EXP]; UNROLL for (int e = 0; e < N_EXP; ++e) lg[e] = 0.f;
    for (int c = 0; c < D_MODEL; ++c) {
        float t = DN_ALPHA * xr[c] + g1[c] * yo[c];
        float x1 = (t - mu) * rstd * p.ln1_g[l * D_MODEL + c] + p.ln1_b[l * D_MODEL + c];
        xr[c] = x1; float h2 = x1 * (1.f + sc2[c]) + sh2[c]; p.H[(size_t)r * D_MODEL + c] = f2bf(h2);
        UNROLL for (int e = 0; e < N_EXP; ++e) lg[e] += h2 * p.router_w[c * N_EXP + e]; }
    int e1, e2; float gw1, gw2; route_select(lg, p.router_b, e1, e2, gw1, gw2);
    p.TG[r * 2 + 0] = gw1; p.TG[r * 2 + 1] = gw2;
    int s1 = atomic_inc(p.cnt + CNT_IDX(l, e1)); p.SLOTTOK[(size_t)e1 * NROW + s1] = r * 2 + 0;
    int s2 = atomic_inc(p.cnt + CNT_IDX(l, e2)); p.SLOTTOK[(size_t)e2 * NROW + s2] = r * 2 + 1;
}

HD bool moe_row(const P& p, int l, int i, int& e, int& tok2) {
    int off = 0;
    UNROLL for (int q = 0; q < N_EXP; ++q) { int c = p.cnt[CNT_IDX(l, q)]; int pc = (c + MOE_TM - 1) / MOE_TM * MOE_TM;
        if (i < off + pc) { e = q; int s = i - off; if (s >= c) return false; tok2 = p.SLOTTOK[(size_t)q * NROW + s]; return true; }
        off += pc; }
    return false;
}
HD long n_moe_up() { return (long)MOE_ROWS * (EXP_FF / 4); }
HD void st_moe_up(const P& p, int l, long gid) {
    int i = (int)(gid / (EXP_FF / 4)), j0 = (int)(gid % (EXP_FF / 4)) * 4; int e, tok2;
    if (!moe_row(p, l, i, e, tok2)) return;
    const bf16_t* a = p.H + (size_t)(tok2 >> 1) * D_MODEL; const bf16_t* W = WB_WGU(p.WB[l & 1]) + (size_t)e * 2 * EXP_FF * D_MODEL;
    for (int j = j0; j < j0 + 4; ++j) {
        const bf16_t* wg = W + (size_t)gu_row(0, j) * D_MODEL; const bf16_t* wu = W + (size_t)gu_row(1, j) * D_MODEL;
        float g = 0.f, u = 0.f; for (int k = 0; k < D_MODEL; ++k) { float av = bf2f(a[k]); g += av * bf2f(wg[k]); u += av * bf2f(wu[k]); }
        p.HM[(size_t)i * EXP_FF + j] = f2bf(siluf_(g) * u); }
}
HD long n_moe_down() { return (long)MOE_ROWS * (D_MODEL / 4); }
HD void st_moe_down(const P& p, int l, long gid) {
    int i = (int)(gid / (D_MODEL / 4)), n0 = (int)(gid % (D_MODEL / 4)) * 4; int e, tok2;
    if (!moe_row(p, l, i, e, tok2)) return;
    const bf16_t* a = p.HM + (size_t)i * EXP_FF; const bf16_t* W = WB_WD(p.WB[l & 1]) + (size_t)e * D_MODEL * EXP_FF;
    float gate = p.TG[tok2];
    for (int n = n0; n < n0 + 4; ++n) { const bf16_t* w = W + (size_t)n * EXP_FF; float acc = 0.f; for (int k = 0; k < EXP_FF; ++k) acc += bf2f(a[k]) * bf2f(w[k]);
        p.FO[(size_t)tok2 * D_MODEL + n] = f2bf(acc * gate); }
}

HD long n_lnfinal() { return (long)NROW; }
HD void st_lnfinal(const P& p, int l, long gid) {
    int r = (int)gid, who = row_who(r);
    float* xr = p.XR + (size_t)r * D_MODEL; const bf16_t* f0 = p.FO + (size_t)(r * 2) * D_MODEL; const bf16_t* f1 = f0 + D_MODEL;
    const float* g2 = modp(p, l, who, 5);
    float mu = 0.f; for (int c = 0; c < D_MODEL; ++c) mu += DN_ALPHA * xr[c] + g2[c] * (bf2f(f0[c]) + bf2f(f1[c]));
    mu /= D_MODEL; float var = 0.f;
    for (int c = 0; c < D_MODEL; ++c) { float t = DN_ALPHA * xr[c] + g2[c] * (bf2f(f0[c]) + bf2f(f1[c])) - mu; var += t * t; }
    float rstd = 1.0f / sqrtf(var / D_MODEL + 1e-6f);
    for (int c = 0; c < D_MODEL; ++c) {
        float t = DN_ALPHA * xr[c] + g2[c] * (bf2f(f0[c]) + bf2f(f1[c]));
        float x2 = (t - mu) * rstd * p.ln2_g[l * D_MODEL + c] + p.ln2_b[l * D_MODEL + c];
        xr[c] = x2;
        if (l + 1 < DEPTH) p.H[(size_t)r * D_MODEL + c] = f2bf(x2 * (1.f + modp(p, l + 1, who, 1)[c]) + modp(p, l + 1, who, 0)[c]);
        else if (r < NLAT) p.out[(size_t)r * D_MODEL + c] = x2; }
}
#define NPH_PRE 2
#define NPH_LAYER 11
#define NPH_TOTAL (NPH_PRE + DEPTH * NPH_LAYER)

#define RUN_PHASE(IDX, N, CALL) do { if ((IDX) >= ph_lo && (IDX) < ph_hi) { FOR_GID(N) { CALL; } PHASE_END(); } } while (0)

#define PHASE_PROGRAM(p, ph_lo, ph_hi) do { \
    RUN_PHASE(0, n_ada(), st_ada(p, gid)); \
    RUN_PHASE(1, n_mod0(), st_mod0(p, gid)); \
    for (int l = 0; l < DEPTH; ++l) { const int pb = NPH_PRE + l * NPH_LAYER; \
        RUN_PHASE(pb + 0, n_cvt(), st_cvt(p, l, gid)); \
        RUN_PHASE(pb + 1, n_gemm_in(), st_gemm_in(p, l, gid)); \
        RUN_PHASE(pb + 2, n_post(), st_post(p, l, gid)); \
        RUN_PHASE(pb + 3, n_lru_ab(), st_lru_ab(p, l, gid)); \
        RUN_PHASE(pb + 4, n_lru_scan() + n_att(), { if (gid < n_lru_scan()) st_lru_scan(p, gid); else st_att(p, gid - n_lru_scan()); }); \
        RUN_PHASE(pb + 5, n_yasm(), st_yasm(p, l, gid)); \
        RUN_PHASE(pb + 6, n_gemm_out(), st_gemm_out(p, l, gid)); \
        RUN_PHASE(pb + 7, n_lnroute(), st_lnroute(p, l, gid)); \
        RUN_PHASE(pb + 8, n_moe_up(), st_moe_up(p, l, gid)); \
        RUN_PHASE(pb + 9, n_moe_down(), st_moe_down(p, l, gid)); \
        RUN_PHASE(pb + 10, n_lnfinal(), st_lnfinal(p, l, gid)); \
    } } while (0)

struct WsMap { size_t ctl, mod, wb0, wb1, xr, h, u, zq, zk, zv, ax, ga, y, od, tg, slottok, hm, total; };
static inline size_t al256(size_t v) { return (v + 255) & ~(size_t)255; }
static inline WsMap ws_map() {
    WsMap m; size_t o = 0;
    m.ctl = o; o += al256(1 << 20);
    m.mod = o; o += al256((size_t)DEPTH * 3 * 6 * D_MODEL * 4);
    m.wb0 = o; o += al256(WB_ELEMS * sizeof(bf16_t));
    m.wb1 = o; o += al256(WB_ELEMS * sizeof(bf16_t));
    m.xr = o; o += al256((size_t)NROW * D_MODEL * 4);
    m.h = o; o += al256((size_t)NROW * D_MODEL * sizeof(bf16_t));
    size_t usz = (size_t)NROW * IN_W * 4; size_t u2 = (size_t)NROW * 2 * LRU_W * 4 * 3; if (u2 > usz) usz = u2; size_t u3 = (size_t)NROW * D_MODEL * 4 + (size_t)NROW * 2 * D_MODEL * sizeof(bf16_t); if (u3 > usz) usz = u3;
    m.u = o; o += al256(usz);
    m.zq = o; o += al256((size_t)NROW * QP * sizeof(bf16_t));
    m.zk = o; o += al256((size_t)BATCH * SKEY * KP * sizeof(bf16_t));
    m.zv = o; o += al256((size_t)BATCH * SKEY * VP * sizeof(bf16_t));
    m.ax = o; o += al256((size_t)NROW * LRU_W * 4);
    m.ga = o; o += al256((size_t)NROW * LRU_W * 4);
    m.y = o; o += al256((size_t)NROW * MIX_W * sizeof(bf16_t));
    m.od = o; o += al256((size_t)NROW * ODP * sizeof(bf16_t));
    m.tg = o; o += al256((size_t)NROW * 2 * 4);
    m.slottok = o; o += al256((size_t)N_EXP * NROW * 4);
    m.hm = o; o += al256((size_t)MOE_ROWS * EXP_FF * sizeof(bf16_t));
    m.total = o; return m;
}
#define CTL_CNT_WORD 8192
static inline void fill_ws(P& p, unsigned char* ws) {
    WsMap m = ws_map();
    p.ctl = (unsigned*)(ws + m.ctl); p.cnt = (int*)(p.ctl + CTL_CNT_WORD);
    p.MOD = (float*)(ws + m.mod); p.WB[0] = (bf16_t*)(ws + m.wb0); p.WB[1] = (bf16_t*)(ws + m.wb1);
    p.XR = (float*)(ws + m.xr); p.H = (bf16_t*)(ws + m.h);
    p.Z = (float*)(ws + m.u);
    p.LA = (float*)(ws + m.u); p.LB = p.LA + (size_t)NROW * 2 * LRU_W; p.HS = p.LB + (size_t)NROW * 2 * LRU_W;
    p.YO = (float*)(ws + m.u); p.FO = (bf16_t*)(ws + m.u + (size_t)NROW * D_MODEL * 4);
    p.ZQ = (bf16_t*)(ws + m.zq); p.ZK = (bf16_t*)(ws + m.zk); p.ZV = (bf16_t*)(ws + m.zv);
    p.AX = (float*)(ws + m.ax); p.GA = (float*)(ws + m.ga); p.Y = (bf16_t*)(ws + m.y); p.OD = (bf16_t*)(ws + m.od);
    p.TG = (float*)(ws + m.tg); p.SLOTTOK = (int*)(ws + m.slottok); p.HM = (bf16_t*)(ws + m.hm); p.XRo = p.XR; p.Ho = p.H; p.TGo = p.TG; p.SLOTTOKo = p.SLOTTOK; p.cnto = p.cnt; p.pad_[0] = 0; p.pad_[1] = 0;
}
static inline void fill_inputs(P& p, void* const* d_in, void* d_out) {
    const float** f = (const float**)d_in;
    p.x = f[0]; p.c = f[1]; p.ctx = f[2]; p.c_ctx = f[3]; p.ada_w = f[4]; p.ada_b = f[5]; p.w_in = f[6]; p.conv_w = f[7]; p.conv_b = f[8];
    p.rg_wa = f[9]; p.rg_ba = f[10]; p.rg_wx = f[11]; p.rg_bx = f[12]; p.rg_lam = f[13]; p.q_norm_g = f[14]; p.k_norm_g = f[15];
    p.diff_lambda = f[16]; p.diff_subln_g = f[17]; p.w_out = f[18]; p.ln1_g = f[19]; p.ln1_b = f[20]; p.ln2_g = f[21]; p.ln2_b = f[22];
    p.router_w = f[23]; p.router_b = f[24]; p.exp_w_gate = f[25]; p.exp_w_up = f[26]; p.exp_w_down = f[27]; p.out = (float*)d_out;
}
constexpr int NTHR = 512;
constexpr int LDS_RING = 131072;
constexpr int LDS_BYTES = 147456;
constexpr int LDS_MISC = LDS_RING;
template <int CTRL> __device__ __forceinline__ float dpp_mov(float v) { return __builtin_bit_cast(float, __builtin_amdgcn_update_dpp(0, __builtin_bit_cast(int, v), CTRL, 0xf, 0xf, true)); }
#define DPP_XOR1 0xB1
#define DPP_XOR2 0x4E
#define DPP_HMIR 0x141
#define DPP_MIR  0x140
__device__ __forceinline__ float swap16_sum(float v) { auto rr = __builtin_amdgcn_permlane16_swap(__float_as_uint(v), __float_as_uint(v), false, false); return __uint_as_float(rr[0]) + __uint_as_float(rr[1]); }
__device__ __forceinline__ float swap32_sum(float v) { auto rr = __builtin_amdgcn_permlane32_swap(__float_as_uint(v), __float_as_uint(v), false, false); return __uint_as_float(rr[0]) + __uint_as_float(rr[1]); }
__device__ __forceinline__ float swap16_max(float v) { auto rr = __builtin_amdgcn_permlane16_swap(__float_as_uint(v), __float_as_uint(v), false, false); return fmaxf(__uint_as_float(rr[0]), __uint_as_float(rr[1])); }
__device__ __forceinline__ float swap32_max(float v) { auto rr = __builtin_amdgcn_permlane32_swap(__float_as_uint(v), __float_as_uint(v), false, false); return fmaxf(__uint_as_float(rr[0]), __uint_as_float(rr[1])); }
__device__ __forceinline__ float row16_sum(float v) { v += dpp_mov<DPP_XOR1>(v); v += dpp_mov<DPP_XOR2>(v); v += dpp_mov<DPP_HMIR>(v); v += dpp_mov<DPP_MIR>(v); return v; }
__device__ __forceinline__ float half32_sum(float v) { return swap16_sum(row16_sum(v)); }
__device__ __forceinline__ float wave_sum(float v) { return swap32_sum(swap16_sum(row16_sum(v))); }
__device__ __forceinline__ float xor32_get(float v, bool upper) { auto rr = __builtin_amdgcn_permlane32_swap(__float_as_uint(v), __float_as_uint(v), false, false); return __uint_as_float(upper ? rr[0] : rr[1]); }
#define XB_TMO      128
#define XB_XCNT(j)  (256  + 64 * (j))
#define XB_XSUB(j)  (1280 + 64 * (j))
#define XB_XGEN(j)  (2304 + 64 * (j))
#define XB_TOP      3328
#define XB_TOPGEN   3392
#define XCD_BAR_WORDS 3456
#define XB_SPIN_CAP (1u << 21)
#define LAS __attribute__((address_space(3)))

__device__ __forceinline__ unsigned xb_ld(unsigned* p)              { return __hip_atomic_load(p, __ATOMIC_RELAXED, __HIP_MEMORY_SCOPE_AGENT); }
__device__ __forceinline__ unsigned xb_add(unsigned* p, unsigned v) { return __hip_atomic_fetch_add(p, v, __ATOMIC_RELAXED, __HIP_MEMORY_SCOPE_AGENT); }
__device__ __forceinline__ unsigned xb_xcc_id() { return (unsigned)__builtin_amdgcn_s_getreg((3 << 11) | 20) & 0xFu; }
#define XB_SPIN(cond, bar) do { unsigned _sp = 0; while (cond) { __builtin_amdgcn_s_sleep(1); \
    if ((++_sp & 255u) == 0u) { if (xb_ld(&(bar)[XB_TMO])) break; if (_sp > XB_SPIN_CAP) { atomicAdd(&(bar)[XB_TMO], 1u); break; } } } } while (0)

struct XcdBarrier {
    unsigned* bar; unsigned x;
    volatile LAS unsigned* st;
};

__device__ __forceinline__ XcdBarrier xcd_barrier_post(unsigned* bar, volatile LAS unsigned* st) {
    XcdBarrier b; b.bar = bar; b.x = xb_xcc_id(); b.st = st;
    if (threadIdx.x == 0) (void)xb_add(&bar[XB_XCNT(b.x)], 1u);
    return b;
}
__device__ __forceinline__ void xcd_barrier_complete(unsigned* bar, unsigned x, unsigned& nloc, unsigned& nx) {
    const unsigned G = gridDim.x * gridDim.y * gridDim.z;
    unsigned sum, cnt, mine, sp = 0u;
    for (;;) {
        sum = 0u; cnt = 0u; mine = 0u;
#pragma unroll
        for (unsigned j = 0; j < 16; ++j) { const unsigned c = xb_ld(&bar[XB_XCNT(j)]); sum += c; cnt += (c > 0u) ? 1u : 0u; mine = (j == x) ? c : mine; }
        if (sum == G) break;
        __builtin_amdgcn_s_sleep(1);
        if ((++sp & 255u) == 0u) { if (xb_ld(&bar[XB_TMO])) break; if (sp > XB_SPIN_CAP) { atomicAdd(&bar[XB_TMO], 1u); break; } }
    }
    nloc = mine > 0u ? mine : 1u; nx = cnt > 0u ? cnt : 1u;
}

__device__ __forceinline__ void xcd_barrier(const XcdBarrier& b) {
    asm volatile("s_waitcnt vmcnt(0)" ::: "memory");
    __syncthreads();
    if (threadIdx.x == 0) {
        unsigned* bar = b.bar;
        __builtin_amdgcn_s_waitcnt(0);
        unsigned nloc = b.st[0], nx = b.st[1];
        if (nloc == 0u) { xcd_barrier_complete(bar, b.x, nloc, nx); b.st[0] = nloc; b.st[1] = nx; }
        const unsigned old = xb_add(&bar[XB_XSUB(b.x)], 1u);
        const unsigned gen = old / nloc;
        if (old + 1u == (gen + 1u) * nloc) {
            __builtin_amdgcn_fence(__ATOMIC_RELEASE, "agent");
            asm volatile("s_waitcnt vmcnt(0)" ::: "memory");
            const unsigned og = xb_add(&bar[XB_TOP], 1u);
            const unsigned tg = og / nx;
            if (og + 1u == (tg + 1u) * nx) xb_add(&bar[XB_TOPGEN], 1u);
            else XB_SPIN(xb_ld(&bar[XB_TOPGEN]) == tg, bar);
            __builtin_amdgcn_fence(__ATOMIC_ACQUIRE, "agent");
            xb_add(&bar[XB_XGEN(b.x)], 1u);
            asm volatile("s_waitcnt vmcnt(0)" ::: "memory");
        } else {
            XB_SPIN(xb_ld(&bar[XB_XGEN(b.x)]) == gen, bar);
            __builtin_amdgcn_fence(__ATOMIC_ACQUIRE, "agent");
            asm volatile("s_waitcnt vmcnt(0)" ::: "memory");
        }
    }
    __syncthreads();
}

#include <hip/hip_bf16.h>
#include <cmath>
namespace attn_body {
using bf16=__hip_bfloat16;
using bf16x8=__attribute__((ext_vector_type(8)))short;
using s16x4=__attribute__((ext_vector_type(4)))short;
using f32x16=__attribute__((ext_vector_type(16)))float;
using u32x4=__attribute__((ext_vector_type(4)))unsigned;
constexpr int D=64;
constexpr int NW=8,QBLK=32,QB=QBLK*NW,KVBLK=64;
constexpr int ATTN_UNIT_ROWS=QB;
__device__ __forceinline__ int crow(int r,int hi){return (r&3)+8*(r>>2)+4*hi;}
#define SBAR() __builtin_amdgcn_sched_barrier(0)
__device__ __forceinline__ void cmask(f32x16&p0,f32x16&p1,int jb,int qrel,int hi){
  const float NEG=-INFINITY; int kb=64*jb+4*hi;
  #pragma unroll
  for(int r=0;r<16;++r){int kv=kb+(r&3)+8*(r>>2); if(kv>qrel)p0[r]=NEG; if(kv+32>qrel)p1[r]=NEG;}
}

constexpr int NSLOT=3, SLOTB=8192;
constexpr int LDS_K=0, LDS_V=NSLOT*SLOTB, LDS_WS=2*NSLOT*SLOTB, LDS_OST=LDS_WS+NW*64*4, LDS_BYTES=LDS_OST+NW*4096;
constexpr float C2=0.125f*1.4426950408889634f;
__device__ __forceinline__ void glds16(const void*gsrc,unsigned lds_dst){unsigned keep;
  asm volatile("s_mov_b32 %0, m0\n\ts_mov_b32 m0, %2\n\ts_nop 0\n\tglobal_load_lds_dwordx4 %1, off\n\ts_mov_b32 m0, %0":"=&s"(keep):"v"(gsrc),"s"(lds_dst):"memory");}
__device__ __forceinline__ float max3f(float a,float b,float c){float r;asm("v_max3_f32 %0, %1, %2, %3":"=v"(r):"v"(a),"v"(b),"v"(c));return r;}
__device__ __forceinline__ float max2f(float a,float b){float r;asm("v_max_f32_e32 %0, %1, %2":"=v"(r):"v"(a),"v"(b));return r;}
__device__ __forceinline__ float fadd_s(float a,float b){float r;asm("v_add_f32_e32 %0, %1, %2":"=v"(r):"v"(a),"v"(b));return r;}
__device__ __forceinline__ float fsub_s(float a,float b){float r;asm("v_sub_f32_e32 %0, %1, %2":"=v"(r):"v"(a),"v"(b));return r;}
typedef float f32x2_t __attribute__((ext_vector_type(2))); typedef __bf16 bf16x2_t __attribute__((ext_vector_type(2)));
__device__ __forceinline__ unsigned cvtpk_s(float lo,float hi){f32x2_t v={lo,hi};bf16x2_t b=__builtin_convertvector(v,bf16x2_t);return __builtin_bit_cast(unsigned,b);}
#define WAIT_BAR(N) asm volatile("s_waitcnt vmcnt(" #N ") lgkmcnt(0)\n\ts_barrier":::"memory")

template<int ND> __device__ __forceinline__ void qkt(f32x16&p0,f32x16&p1,const char*Kslot,const bf16x8*qr,const f32x16&negm,int r32,int hi){
  const char*kb=Kslot+hi*1024+r32*16;
  #pragma unroll
  for(int d0=0;d0<ND;++d0){
    const bf16x8 b0=*reinterpret_cast<const bf16x8*>(kb+d0*2048);
    const bf16x8 b1=*reinterpret_cast<const bf16x8*>(kb+d0*2048+512);
    if(d0==0){p0=__builtin_amdgcn_mfma_f32_32x32x16_bf16(b0,qr[0],negm,0,0,0);p1=__builtin_amdgcn_mfma_f32_32x32x16_bf16(b1,qr[0],negm,0,0,0);}
    else{p0=__builtin_amdgcn_mfma_f32_32x32x16_bf16(b0,qr[d0],p0,0,0,0);p1=__builtin_amdgcn_mfma_f32_32x32x16_bf16(b1,qr[d0],p1,0,0,0);}}
}
typedef __attribute__((address_space(3))) const char* lds_cptr;
typedef short v4i16_t __attribute__((ext_vector_type(4)));
__device__ __forceinline__ void kload8(bf16x8*kf,lds_cptr kp){
  kf[0]=*(const __attribute__((address_space(3))) bf16x8*)(kp);      kf[1]=*(const __attribute__((address_space(3))) bf16x8*)(kp+512);
  kf[2]=*(const __attribute__((address_space(3))) bf16x8*)(kp+2048); kf[3]=*(const __attribute__((address_space(3))) bf16x8*)(kp+2560);
  kf[4]=*(const __attribute__((address_space(3))) bf16x8*)(kp+4096); kf[5]=*(const __attribute__((address_space(3))) bf16x8*)(kp+4608);
  kf[6]=*(const __attribute__((address_space(3))) bf16x8*)(kp+6144); kf[7]=*(const __attribute__((address_space(3))) bf16x8*)(kp+6656);
}
__device__ __forceinline__ void kload2(bf16x8*kf,lds_cptr kp,int j){ kf[2*j]=*(const __attribute__((address_space(3))) bf16x8*)(kp+j*2048); kf[2*j+1]=*(const __attribute__((address_space(3))) bf16x8*)(kp+j*2048+512); }
__device__ __forceinline__ s16x4 vtr(lds_cptr p){ return __builtin_bit_cast(s16x4,__builtin_amdgcn_ds_read_tr16_b64_v4i16((__attribute__((address_space(3))) v4i16_t*)p)); }
__device__ __forceinline__ float rowmax(const f32x16&p0,const f32x16&p1){
  float a=max3f(p0[0],p0[1],p1[0]),b=max3f(p0[2],p0[3],p1[1]);a=max3f(a,p1[2],p1[3]);
  #pragma unroll
  for(int r=4;r<16;r+=4){a=max3f(a,p0[r],p0[r+1]);b=max3f(b,p0[r+2],p0[r+3]);a=max3f(a,p1[r],p1[r+1]);b=max3f(b,p1[r+2],p1[r+3]);}
  const float m=max2f(a,b);
  auto rr=__builtin_amdgcn_permlane32_swap(__float_as_uint(m),__float_as_uint(m),false,false);
  return max2f(__uint_as_float(rr[0]),__uint_as_float(rr[1]));
}
__device__ __forceinline__ void pv(f32x16*o,int vb,bf16x8 pa0,bf16x8 pa1,bf16x8 pa2,bf16x8 pa3){
  #pragma unroll
  for(int d0=0;d0<2;++d0){s16x4 lo[4],hi[4];
    #pragma unroll
    for(int ks=0;ks<4;++ks){
      asm volatile("ds_read_b64_tr_b16 %0,%1 offset:%c2":"=&v"(lo[ks]):"v"(vb),"i"(d0*4096+ks*1024):"memory");
      asm volatile("ds_read_b64_tr_b16 %0,%1 offset:%c2":"=&v"(hi[ks]):"v"(vb),"i"(d0*4096+ks*1024+512):"memory");}
    asm volatile("s_waitcnt lgkmcnt(0)":::"memory");SBAR();
    #define PK(k) (bf16x8){lo[k][0],lo[k][1],lo[k][2],lo[k][3],hi[k][0],hi[k][1],hi[k][2],hi[k][3]}
    o[d0]=__builtin_amdgcn_mfma_f32_32x32x16_bf16(pa0,PK(0),o[d0],0,0,0);
    o[d0]=__builtin_amdgcn_mfma_f32_32x32x16_bf16(pa1,PK(1),o[d0],0,0,0);
    o[d0]=__builtin_amdgcn_mfma_f32_32x32x16_bf16(pa2,PK(2),o[d0],0,0,0);
    o[d0]=__builtin_amdgcn_mfma_f32_32x32x16_bf16(pa3,PK(3),o[d0],0,0,0);
    #undef PK
  }
}

#ifndef ATTN_STORE16
#define ATTN_STORE16(p,v) (*(u32x4*)(p)=(v))
#endif
template<int THRL,int QPITCH,int KPITCH,int VPITCH,int OPITCH,bool HALFK,bool NOMAX> __device__ __forceinline__ void attn_unit(const bf16*Qu,const bf16*__restrict__ Kh,const bf16*__restrict__ Vh,bf16*Ou,const int NT,char*shm,const bf16*Knext=nullptr,const bool kpre=false){
  int tid_l=threadIdx.x; asm volatile("":"+v"(tid_l)); const int tid=tid_l,lane=tid&63,r32=lane&31,hi=lane>>5; const int wid=__builtin_amdgcn_readfirstlane(tid>>6);
  const bf16*Qw=Qu+(long)(wid*QBLK)*QPITCH;
  const unsigned lds0=(unsigned)(uintptr_t)shm;
  float*wsf=(float*)(shm+LDS_WS)+wid*64;
  const bf16*ksrc=Kh+(long)lane*KPITCH+wid*8;
  const bf16*vsrc=Vh+(long)(16*(wid&3)+(lane>>2))*VPITCH+(wid>>2)*32+(lane&3)*8;
  const unsigned kdst=lds0+LDS_K+wid*1024, vdst=lds0+LDS_V+wid*1024;
  #define DMA_K(t,slot) glds16(ksrc+(long)(t)*KVBLK*KPITCH,(unsigned)__builtin_amdgcn_readfirstlane(kdst+(slot)))
  #define DMA_V(t,slot) glds16(vsrc+(long)(t)*KVBLK*VPITCH,(unsigned)__builtin_amdgcn_readfirstlane(vdst+(slot)))
  const int vb0=(int)(lds0+LDS_V)+((lane>>4)&1)*32+(lane&3)*8+(4*hi+((lane&15)>>2))*64;
  const char*Kbase=shm+LDS_K; bf16x8 kf[8];
  const lds_cptr shm3=(lds_cptr)shm; const lds_cptr kp0=shm3+LDS_K+hi*1024+r32*16; const lds_cptr vp0=shm3+LDS_V+((lane>>4)&1)*32+(lane&3)*8+(4*hi+((lane&15)>>2))*64;
  if(!kpre){DMA_K(0,0);DMA_V(0,0);DMA_K(1,SLOTB);}
  bf16x8 qr[4];
  #pragma unroll
  for(int d0=0;d0<4;++d0)qr[d0]=*reinterpret_cast<const bf16x8*>(&Qw[(long)r32*QPITCH+d0*16+hi*8]);
  float mhat=0.f,l_reg=0.f;f32x16 o[2];o[0]=f32x16{};o[1]=f32x16{};f32x16 negm=f32x16{};asm volatile("":"+v"(negm));
  #define CMASK(P0,P1,t) do{}while(0)
  bool resc=false;
  #define START(P0,P1) do{ resc=false; \
    if constexpr(!NOMAX){ const float rm=rowmax(P0,P1); const float dl=rm; mhat=fadd_s(mhat,dl); \
      _Pragma("unroll") for(int r=0;r<16;++r){P0[r]=fsub_s(P0[r],dl);P1[r]=fsub_s(P1[r],dl);} \
      _Pragma("unroll") for(int r=0;r<16;++r)negm[r]=-mhat; asm volatile("":"+v"(negm)); } \
    _Pragma("unroll") for(int r=0;r<16;++r)P0[r]=__builtin_amdgcn_exp2f(P0[r]); }while(0)
  #define RESC() do{ if(resc){ asm volatile("s_waitcnt lgkmcnt(0)":::"memory"); \
      _Pragma("unroll") for(int d_=0;d_<2;++d_) _Pragma("unroll") for(int r=0;r<16;++r)o[d_][r]*=wsf[crow(r,hi)]; } }while(0)
  f32x16 pA0,pA1,pB0,pB1;
  int sl_prev=0,sl_cur=0,sl_next=SLOTB;
  #define ROT() do{sl_prev=sl_cur;sl_cur=sl_next;sl_next=(sl_next==(NSLOT-1)*SLOTB)?0:sl_next+SLOTB;}while(0)
  if(!kpre){ DMA_K(2,2*SLOTB);
    WAIT_BAR(3); }
  else{ DMA_V(0,0); WAIT_BAR(1); }
  qkt<(HALFK?2:4)>(pA0,pA1,Kbase,qr,negm,r32,hi);asm volatile("s_nop 15\n\ts_nop 7":"+v"(pA0),"+v"(pA1));CMASK(pA0,pA1,0);
  START(pA0,pA1);
  _Pragma("unroll") for(int r=0;r<16;++r)pA1[r]=__builtin_amdgcn_exp2f(pA1[r]);
  WAIT_BAR(0);
  DMA_K(3,0);DMA_V(1,SLOTB);
  ROT();
  if constexpr(HALFK){kload2(kf,kp0+sl_cur,0);kload2(kf,kp0+sl_cur,1);}else kload8(kf,kp0+sl_cur);
  WAIT_BAR(2);
  s16x4 vlo[8],vhi[8]; u32x4 pw0,pw1,pw2,pw3;
  #define PKW(P,B) cvtpk_s(P[B],P[B+1])
  #define PAF(k) __builtin_bit_cast(bf16x8,pw##k)
  #define VFR(i) (bf16x8){vlo[i][0],vlo[i][1],vlo[i][2],vlo[i][3],vhi[i][0],vhi[i][1],vhi[i][2],vhi[i][3]}
  #define PIN(x) asm volatile("":"+v"(x))
  #define MX3(a,b,c) __builtin_fmaxf(__builtin_fmaxf((a),(b)),(c))
  #define GAPA(MF,A0,A1,A2,A3,W0,W1,PW) do{ MF; sacc+=A0; sacc+=A1; sacc+=A2; sacc+=A3; PIN(sacc); W0; W1; PIN(PW); SBAR(); }while(0)
  #define EX(v) __builtin_amdgcn_exp2f(v)
  #define GAPB(MF,X,B) do{ MF; X[B]=EX(X[B]); X[B+1]=EX(X[B+1]); X[B+2]=EX(X[B+2]); X[B+3]=EX(X[B+3]); PIN(X); SBAR(); }while(0)
  #define VRD(i) do{ vlo[i]=vtr(vp_+(((i)>>2)*4096+((i)&3)*1024)); vhi[i]=vtr(vp_+(((i)>>2)*4096+((i)&3)*1024+512)); }while(0)
  #define KRD(G,j) do{ if(G){ kload2(kf,kp0+sl_next,j); SBAR(); } }while(0)
  #define STEP(C0,C1,P0,P1,t,GK,GV,GL) do{ SBAR(); \
    const lds_cptr vp_=vp0+sl_prev; \
    VRD(0); SBAR(); float sacc=(P0[0]+P0[1]); \
    GAPA(C0=__builtin_amdgcn_mfma_f32_32x32x16_bf16(kf[0],qr[0],negm,0,0,0), P0[2],P0[3],P0[4],P0[5],     pw0[0]=PKW(P0,0), pw0[1]=PKW(P0,2), pw0); \
    VRD(4); SBAR(); GAPA(C1=__builtin_amdgcn_mfma_f32_32x32x16_bf16(kf[1],qr[0],negm,0,0,0), P0[6],P0[7],P0[8],P0[9],     pw0[2]=PKW(P0,4), pw0[3]=PKW(P0,6), pw0); \
    VRD(1); SBAR(); GAPA(C0=__builtin_amdgcn_mfma_f32_32x32x16_bf16(kf[2],qr[1],C0,0,0,0),   P0[10],P0[11],P0[12],P0[13], pw1[0]=PKW(P0,8), pw1[1]=PKW(P0,10), pw1); \
    VRD(5); SBAR(); GAPA(C1=__builtin_amdgcn_mfma_f32_32x32x16_bf16(kf[3],qr[1],C1,0,0,0),   P0[14],P0[15],P1[0],P1[1],   pw1[2]=PKW(P0,12),pw1[3]=PKW(P0,14), pw1); \
    VRD(2); SBAR(); GAPA(if constexpr(!HALFK)C0=__builtin_amdgcn_mfma_f32_32x32x16_bf16(kf[4],qr[2],C0,0,0,0),   P1[2],P1[3],P1[4],P1[5],     pw2[0]=PKW(P1,0), pw2[1]=PKW(P1,2), pw2); \
    VRD(6); SBAR(); GAPA(if constexpr(!HALFK)C1=__builtin_amdgcn_mfma_f32_32x32x16_bf16(kf[5],qr[2],C1,0,0,0),   P1[6],P1[7],P1[8],P1[9],     pw2[2]=PKW(P1,4), pw2[3]=PKW(P1,6), pw2); \
    VRD(3); SBAR(); GAPA(if constexpr(!HALFK)C0=__builtin_amdgcn_mfma_f32_32x32x16_bf16(kf[6],qr[3],C0,0,0,0),   P1[10],P1[11],P1[12],P1[13], pw3[0]=PKW(P1,8), pw3[1]=PKW(P1,10), pw3); \
    VRD(7); SBAR(); GAPA(if constexpr(!HALFK)C1=__builtin_amdgcn_mfma_f32_32x32x16_bf16(kf[7],qr[3],C1,0,0,0),   P1[14],P1[15],0.f,0.f,       pw3[2]=PKW(P1,12),pw3[3]=PKW(P1,14), pw3); \
    l_reg+=sacc; \
    if(GK){DMA_K((t)+3,sl_cur);} if(GV){DMA_V((t)+1,sl_next);} \
    CMASK(C0,C1,t); \
    if constexpr(!NOMAX){ float a=MX3(C0[0],C0[1],C1[0]),b=MX3(C0[2],C0[3],C1[1]); a=MX3(a,C1[2],C1[3]); \
      _Pragma("unroll") for(int r=4;r<16;r+=4){a=MX3(a,C0[r],C0[r+1]);b=MX3(b,C0[r+2],C0[r+3]);a=MX3(a,C1[r],C1[r+1]);b=MX3(b,C1[r+2],C1[r+3]);} \
      float rm=__builtin_fmaxf(a,b); { auto rr=__builtin_amdgcn_permlane32_swap(__float_as_uint(rm),__float_as_uint(rm),false,false); rm=__builtin_fmaxf(__uint_as_float(rr[0]),__uint_as_float(rr[1])); } \
      resc=false; \
      if(__builtin_expect(__any(rm>(float)THRL),0)){ const float dl=__builtin_fmaxf(rm,0.f); mhat+=dl; \
        _Pragma("unroll") for(int r=0;r<16;++r){C0[r]-=dl;C1[r]-=dl;} \
        _Pragma("unroll") for(int r=0;r<16;++r)negm[r]=-mhat; asm volatile("":"+v"(negm)); \
        const float f=__builtin_amdgcn_exp2f(-dl); l_reg*=f; if(hi==0)wsf[r32]=f; resc=true; } } \
    SBAR(); \
    GAPB(o[0]=__builtin_amdgcn_mfma_f32_32x32x16_bf16(PAF(0),VFR(0),o[0],0,0,0), C0,0); \
    GAPB(o[1]=__builtin_amdgcn_mfma_f32_32x32x16_bf16(PAF(0),VFR(4),o[1],0,0,0), C0,4); \
    KRD(GL,0); GAPB(o[0]=__builtin_amdgcn_mfma_f32_32x32x16_bf16(PAF(1),VFR(1),o[0],0,0,0), C0,8); \
    KRD(GL,1); GAPB(o[1]=__builtin_amdgcn_mfma_f32_32x32x16_bf16(PAF(1),VFR(5),o[1],0,0,0), C0,12); \
    KRD(GL&&!HALFK,2); GAPB(o[0]=__builtin_amdgcn_mfma_f32_32x32x16_bf16(PAF(2),VFR(2),o[0],0,0,0), C1,0); \
    KRD(GL&&!HALFK,3); GAPB(o[1]=__builtin_amdgcn_mfma_f32_32x32x16_bf16(PAF(2),VFR(6),o[1],0,0,0), C1,4); \
    GAPB(o[0]=__builtin_amdgcn_mfma_f32_32x32x16_bf16(PAF(3),VFR(3),o[0],0,0,0), C1,8); \
    GAPB(o[1]=__builtin_amdgcn_mfma_f32_32x32x16_bf16(PAF(3),VFR(7),o[1],0,0,0), C1,12); \
    }while(0)
  int t=1;
  #undef CMASK
  #define CMASK(P0,P1,t) do{}while(0)
  for(;t+5<NT;t+=2){
    STEP(pB0,pB1,pA0,pA1,t,true,true,true);     WAIT_BAR(2); RESC(); ROT();
    STEP(pA0,pA1,pB0,pB1,t+1,true,true,true);   WAIT_BAR(2); RESC(); ROT();
  }
  #undef CMASK
  #define CMASK(P0,P1,t) do{}while(0)
  #define ENDW(tt) do{ if((tt)+3<NT){WAIT_BAR(2);} else if((tt)+2<NT){WAIT_BAR(1);} else {WAIT_BAR(0);} }while(0)
  for(;t+1<NT;t+=2){
    STEP(pB0,pB1,pA0,pA1,t,(t+3<NT),(t+1<NT),(t+1<NT));       ENDW(t);   RESC(); ROT();
    STEP(pA0,pA1,pB0,pB1,t+1,(t+4<NT),(t+2<NT),(t+2<NT));     ENDW(t+1); RESC(); ROT();
  }
  STEP(pB0,pB1,pA0,pA1,NT-1,false,false,false); RESC();
  if(Knext){ const bf16*kn=Knext+(long)lane*KPITCH+wid*8;
    glds16(kn,(unsigned)__builtin_amdgcn_readfirstlane(kdst)); glds16(kn+(long)KVBLK*KPITCH,(unsigned)__builtin_amdgcn_readfirstlane(kdst+SLOTB)); glds16(kn+(long)2*KVBLK*KPITCH,(unsigned)__builtin_amdgcn_readfirstlane(kdst+2*SLOTB)); }
  { float sacc=pB0[0]+pB0[1]; _Pragma("unroll") for(int r=2;r<16;++r)sacc+=pB0[r]; _Pragma("unroll") for(int r=0;r<16;++r)sacc+=pB1[r]; l_reg+=sacc;
    pw0=(u32x4){PKW(pB0,0),PKW(pB0,2),PKW(pB0,4),PKW(pB0,6)};pw1=(u32x4){PKW(pB0,8),PKW(pB0,10),PKW(pB0,12),PKW(pB0,14)};pw2=(u32x4){PKW(pB1,0),PKW(pB1,2),PKW(pB1,4),PKW(pB1,6)};pw3=(u32x4){PKW(pB1,8),PKW(pB1,10),PKW(pB1,12),PKW(pB1,14)};
    SBAR(); pv(o,vb0+sl_cur,PAF(0),PAF(1),PAF(2),PAF(3)); }
  #undef PKW
  #undef PAF
  #undef VFR
  #undef PIN
  #undef MX3
  #undef GAPA
  #undef GAPB
  #undef EX
  #undef VRD
  #undef KRD
  #undef STEP
  #undef ENDW
  {auto rr=__builtin_amdgcn_permlane32_swap(__float_as_uint(l_reg),__float_as_uint(l_reg),false,false);l_reg=__uint_as_float(rr[0])+__uint_as_float(rr[1]);}
  if(hi==0)wsf[32+r32]=l_reg;asm volatile("s_waitcnt lgkmcnt(0)":::"memory");
  float rli[16];
  #pragma unroll
  for(int r=0;r<16;++r)rli[r]=__builtin_amdgcn_rcpf(wsf[32+crow(r,hi)]);
  bf16*Ow=Ou+(long)(wid*QBLK)*OPITCH;
  { bf16*stg=(bf16*)(shm+LDS_OST)+wid*2048;
    #pragma unroll
    for(int r=0;r<16;++r){const int orow=crow(r,hi);
      #pragma unroll
      for(int d0=0;d0<2;++d0)stg[orow*64+d0*32+r32]=__float2bfloat16(o[d0][r]*rli[r]);}
    asm volatile("s_waitcnt lgkmcnt(0)":::"memory");
    #pragma unroll
    for(int i=0;i<4;++i){const int row=i*8+(lane>>3),ch=lane&7; const u32x4 v=*(const u32x4*)(stg+row*64+ch*8); ATTN_STORE16(Ow+(long)row*OPITCH+ch*8,v);} }
  asm volatile("s_waitcnt lgkmcnt(0)\n\ts_barrier":::"memory");
  #undef DMA_K
  #undef DMA_V
  #undef CMASK
  #undef START
  #undef RESC
  #undef ROT
}
constexpr int ATTN_LDS_BYTES=LDS_BYTES;
#undef SBAR
#undef WAIT_BAR
}
namespace pg8 {
#define PG8_LAS __attribute__((address_space(3)))
typedef unsigned short bf16_t;
typedef short bf16x8 __attribute__((ext_vector_type(8)));
typedef float f32x4 __attribute__((ext_vector_type(4)));
typedef unsigned u32x4 __attribute__((ext_vector_type(4)));
constexpr int BM = 256, BK = 64, HALF = 128, HTB = HALF * BK * 2  , STAGE_BYTES = 8 * HTB, NXCD = 8, WGM = 8;

__host__ __device__ __forceinline__ int lds_byte(int r, int c) { const int st = (r >> 4) * 2 + (c >> 5), rr = r & 15, cc = c & 31, ob = rr * 64 + cc * 2; return st * 1024 + (ob ^ (((ob >> 9) & 1) << 5)); }
__host__ __device__ __forceinline__ void stage_rc(int b, int& R, int& C) { const int st = b / 1024, sb = b % 1024, swz = sb ^ (((sb >> 9) & 1) << 5); R = (st >> 1) * 16 + swz / 64; C = (st & 1) * 32 + (swz % 64) / 2; }
__host__ __device__ __forceinline__ int perm32(int rho) { const int n = rho >> 4, i = rho & 15; return 8 * (i >> 2) + 4 * n + (i & 3); }

struct Unit { int pm, pn, aux; };
__device__ __forceinline__ unsigned cvt_pk_bf16(float lo, float hi) { unsigned r; asm volatile("v_cvt_pk_bf16_f32 %0, %1, %2" : "=v"(r) : "v"(lo), "v"(hi)); return r; }
typedef float f32x2 __attribute__((ext_vector_type(2)));
template <class Epi, class Sched, bool ALIGN_EPI = false, bool SP2 = false>
__device__ __forceinline__ void gemm_phase(PG8_LAS unsigned char* lds, const int K, const Sched& S, const Epi& E) {
    int tid_l = threadIdx.x; asm volatile("" : "+v"(tid_l));
    const int tid = tid_l, wid = __builtin_amdgcn_readfirstlane(tid >> 6), lane = tid & 63, wr = wid >> 2, wc = wid & 3, fr = lane & 15, fq = lane >> 4;
    const int nt = K / BK;
    unsigned voffB[2]; int stR[2], stC[2];
#pragma unroll
    for (int i = 0; i < 2; ++i) { int R, C; stage_rc(tid * 16 + i * 8192, R, C); const int Rb = Epi::PERM ? ((R & ~31) + perm32(R & 31)) : R;
        stR[i] = R; stC[i] = C; voffB[i] = (unsigned)(Rb * K + C) * 2u; }
    const size_t kstep = (size_t)(BK * 2);
    const size_t hstep = (size_t)HALF * K * 2;
    const unsigned ldsw = (unsigned)wid * 1024u;
    const int aoff = lds_byte(wr * 64 + fr, fq * 8), boff = lds_byte(wc * 32 + fr, fq * 8);
#define PG8_SA(b, h) (((b) * 2 + (h)) * HTB)
#define PG8_SB(b, h) ((4 + (b) * 2 + (h)) * HTB)
#define PG8_STAGE(bufoff, gbase, voff) do { _Pragma("unroll") for (int _i = 0; _i < 2; ++_i) \
        __builtin_amdgcn_global_load_lds((const unsigned*)((const char*)(gbase) + (voff)[_i]), (PG8_LAS unsigned*)(lds + (bufoff) + ldsw + _i * 8192), 16, 0, 0); } while (0)
#define PG8_LDA(dst, b, h) do { _Pragma("unroll") for (int m = 0; m < 4; ++m) _Pragma("unroll") for (int k = 0; k < 2; ++k) dst[m][k] = *(const PG8_LAS bf16x8*)(lds + PG8_SA(b, h) + aoff + m * 2048 + k * 1024); } while (0)
#define PG8_LDB(dst, b, h) do { _Pragma("unroll") for (int n = 0; n < 2; ++n) _Pragma("unroll") for (int k = 0; k < 2; ++k) dst[n][k] = *(const PG8_LAS bf16x8*)(lds + PG8_SB(b, h) + boff + n * 2048 + k * 1024); } while (0)
#define PG8_MMA(ai, bj, At, Bt) do { __builtin_amdgcn_s_setprio(1); _Pragma("unroll") for (int m = 0; m < 4; ++m) _Pragma("unroll") for (int n = 0; n < 2; ++n) _Pragma("unroll") for (int k = 0; k < 2; ++k) \
        acc[ai][bj][m][n] = __builtin_amdgcn_mfma_f32_16x16x32_bf16(Bt[n][k], At[m][k], acc[ai][bj][m][n], 0, 0, 0); __builtin_amdgcn_s_setprio(0); } while (0)
#define PG8_WAIT_V(n) asm volatile("s_waitcnt vmcnt(" #n ")" ::: "memory")
#define PG8_WAIT_L(n) asm volatile("s_waitcnt lgkmcnt(" #n ")" ::: "memory")
#define PG8_BAR __builtin_amdgcn_s_barrier()
#define PG8_SCHED __builtin_amdgcn_sched_barrier(0)
    Unit cur, nxt; int ui = 0;
    if (!S.next(0, cur)) return;
    f32x4 acc[2][2][4][2];
#pragma unroll
    for (int a = 0; a < 2; ++a)
#pragma unroll
        for (int b = 0; b < 2; ++b)
#pragma unroll
            for (int m = 0; m < 4; ++m)
#pragma unroll
                for (int n = 0; n < 2; ++n) acc[a][b][m][n] = (f32x4){0.f, 0.f, 0.f, 0.f};
    bf16x8 At[4][2], B0[2][2], B1[2][2];
    const char* cA = S.a_ptr(cur); const char* cB = S.b_ptr(cur);
    unsigned cv0[2], cv1[2]; S.a_offs(cur, stR, stC, cv0, cv1);
    S.a_ready(cur);
    if constexpr (SP2) {
        PG8_STAGE(PG8_SB(0, 0), cB, voffB); PG8_STAGE(PG8_SB(0, 1), cB + hstep, voffB); PG8_STAGE(PG8_SA(0, 0), cA, cv0); PG8_STAGE(PG8_SA(0, 1), cA, cv1);
        if (wr == 1) PG8_BAR;
        PG8_WAIT_V(2); PG8_BAR;
        PG8_STAGE(PG8_SB(1, 0), cB + kstep, voffB); PG8_STAGE(PG8_SA(1, 0), cA + kstep, cv0); PG8_STAGE(PG8_SB(1, 1), cB + hstep + kstep, voffB);
        PG8_WAIT_V(6); PG8_BAR;
    } else {
        PG8_STAGE(PG8_SB(0, 0), cB, voffB); PG8_STAGE(PG8_SA(0, 0), cA, cv0); PG8_STAGE(PG8_SB(0, 1), cB + hstep, voffB); PG8_STAGE(PG8_SA(0, 1), cA, cv1);
        if (wr == 1) PG8_BAR;
        PG8_WAIT_V(4); PG8_BAR;
        PG8_STAGE(PG8_SB(1, 0), cB + kstep, voffB); PG8_STAGE(PG8_SA(1, 0), cA + kstep, cv0); PG8_STAGE(PG8_SB(1, 1), cB + hstep + kstep, voffB);
        PG8_WAIT_V(6); PG8_BAR;
    }
    for (;;) {
        const bool has_next = S.next(ui + 1, nxt);
        const char* nA = has_next ? S.a_ptr(nxt) : cA; const char* nB = has_next ? S.b_ptr(nxt) : cB;
        for (int t = 0; t < nt; t += 2) {
            const bool last = (t == nt - 2);
            const char* a1 = cA + (size_t)(t + 1) * kstep;
            const char* a2 = last ? nA : cA + (size_t)(t + 2) * kstep; const char* b2 = last ? nB : cB + (size_t)(t + 2) * kstep;
            const char* a3 = a2 + kstep; const char* b3 = b2 + kstep;
            unsigned c0_[2], c1[2], x0[2], x1[2];
            { int rr[2] = {stR[0], stR[1]}; asm volatile("" : "+v"(rr[0]), "+v"(rr[1])); Unit cu = cur, xu = (last && has_next) ? nxt : cur; asm volatile("" : "+s"(cu.aux), "+s"(xu.aux));
              S.a_offs(cu, rr, stC, c0_, c1); S.a_offs(xu, rr, stC, x0, x1); }
            if (last && has_next) S.a_ready(nxt);
            if constexpr (SP2) {
            PG8_LDB(B0, 0, 0); PG8_LDB(B1, 0, 1); PG8_SCHED; PG8_LDA(At, 0, 0); PG8_STAGE(PG8_SA(1, 1), a1, c1);
            PG8_WAIT_V(8); PG8_WAIT_L(0); PG8_BAR; PG8_MMA(0, 0, At, B0); PG8_MMA(0, 1, At, B1); PG8_BAR; PG8_SCHED;
            PG8_LDA(At, 0, 1); PG8_STAGE(PG8_SB(0, 0), b2, voffB); PG8_STAGE(PG8_SB(0, 1), b2 + hstep, voffB); PG8_STAGE(PG8_SA(0, 0), a2, x0);
            PG8_WAIT_V(8); PG8_WAIT_L(0); PG8_BAR; PG8_MMA(1, 0, At, B0); PG8_MMA(1, 1, At, B1); PG8_BAR; PG8_SCHED;
            PG8_LDB(B0, 1, 0); PG8_LDB(B1, 1, 1); PG8_SCHED; PG8_LDA(At, 1, 0); PG8_STAGE(PG8_SA(0, 1), a2, x1);
            PG8_WAIT_V(8); PG8_WAIT_L(0); PG8_BAR; PG8_MMA(0, 0, At, B0); PG8_MMA(0, 1, At, B1); PG8_BAR; PG8_SCHED;
            PG8_LDA(At, 1, 1); PG8_STAGE(PG8_SB(1, 0), b3, voffB); PG8_STAGE(PG8_SB(1, 1), b3 + hstep, voffB); PG8_STAGE(PG8_SA(1, 0), a3, x0);
            PG8_WAIT_V(8); PG8_WAIT_L(0); PG8_BAR; PG8_MMA(1, 0, At, B0); PG8_MMA(1, 1, At, B1); PG8_BAR; PG8_SCHED;
            } else {
            PG8_LDB(B0, 0, 0); PG8_SCHED; PG8_LDA(At, 0, 0); PG8_STAGE(PG8_SA(1, 1), a1, c1);
            PG8_WAIT_L(8); PG8_BAR; PG8_WAIT_L(0); PG8_MMA(0, 0, At, B0); PG8_BAR; PG8_SCHED;
            PG8_LDB(B1, 0, 1); PG8_STAGE(PG8_SB(0, 0), b2, voffB);
            PG8_BAR; PG8_WAIT_L(0); PG8_MMA(0, 1, At, B1); PG8_BAR;
            PG8_LDA(At, 0, 1); PG8_STAGE(PG8_SA(0, 0), a2, x0);
            PG8_BAR; PG8_WAIT_L(0); PG8_MMA(1, 0, At, B0); PG8_BAR; PG8_SCHED;
            PG8_STAGE(PG8_SB(0, 1), b2 + hstep, voffB);
            PG8_WAIT_V(6); PG8_BAR; PG8_MMA(1, 1, At, B1); PG8_BAR;
            PG8_LDB(B0, 1, 0); PG8_SCHED; PG8_LDA(At, 1, 0); PG8_STAGE(PG8_SA(0, 1), a2, x1);
            PG8_WAIT_L(8); PG8_BAR; PG8_WAIT_L(0); PG8_MMA(0, 0, At, B0); PG8_BAR; PG8_SCHED;
            PG8_LDB(B1, 1, 1); PG8_STAGE(PG8_SB(1, 0), b3, voffB);
            PG8_BAR; PG8_WAIT_L(0); PG8_MMA(0, 1, At, B1); PG8_BAR;
            PG8_LDA(At, 1, 1); PG8_STAGE(PG8_SA(1, 0), a3, x0);
            PG8_BAR; PG8_WAIT_L(0); PG8_MMA(1, 0, At, B0); PG8_BAR; PG8_SCHED;
            PG8_STAGE(PG8_SB(1, 1), b3 + hstep, voffB);
            PG8_WAIT_V(6); PG8_BAR; PG8_MMA(1, 1, At, B1); PG8_BAR;
            }
        }
        if constexpr (ALIGN_EPI) { if (wr == 0) PG8_BAR; }
        if constexpr (!Epi::AFTER_DRAIN) { E(acc, cur, wr, wc, fr, fq); S.done(cur); }
        if (!has_next) break;
#pragma unroll
        for (int a = 0; a < 2; ++a)
#pragma unroll
            for (int b = 0; b < 2; ++b)
#pragma unroll
                for (int m = 0; m < 4; ++m)
#pragma unroll
                    for (int n = 0; n < 2; ++n) acc[a][b][m][n] = (f32x4){0.f, 0.f, 0.f, 0.f};
        cur = nxt; cA = nA; cB = nB; ++ui;
        if constexpr (ALIGN_EPI) { if (wr == 1) PG8_BAR; }
    }
    PG8_WAIT_V(0);
    if constexpr (!ALIGN_EPI) { if (wr == 0) PG8_BAR; }
    PG8_BAR;
    if constexpr (Epi::AFTER_DRAIN) { E.fused(acc, cur, wr, wc, fr, fq, lds, wid, lane); S.done(cur); }
#undef PG8_SA
#undef PG8_SB
#undef PG8_STAGE
#undef PG8_LDA
#undef PG8_LDB
#undef PG8_MMA
#undef PG8_WAIT_V
#undef PG8_WAIT_L
#undef PG8_BAR
#undef PG8_SCHED
}
}
namespace pg8 {
struct DenseOrder {
    const char* A; const char* Bt; int K; int nM, nN, nwg, G, c;
    __device__ __forceinline__ void init(const void* A_, const void* Bt_, int M, int N, int K_, int G_, int c_) { A = (const char*)A_; Bt = (const char*)Bt_; K = K_; nM = M / BM; nN = N / BM; nwg = nM * nN; G = G_; c = c_; }
    __device__ __forceinline__ bool next(int i, Unit& u) const {
        const long L = (long)i * G + c; if (L >= nwg) return false;
        int wgid = (int)L; { const int q = nwg / NXCD, r = nwg % NXCD, xcd = wgid % NXCD, off = wgid / NXCD; wgid = (xcd < r ? xcd * (q + 1) : r * (q + 1) + (xcd - r) * q) + off; }
        const int nig = WGM * nN, gid = wgid / nig, fm = gid * WGM, gsz = (nM - fm) < WGM ? (nM - fm) : WGM;
        u.pm = fm + ((wgid % nig) % gsz); u.pn = (wgid % nig) / gsz; u.aux = i; return true;
    }
    __device__ __forceinline__ const char* a_ptr(const Unit& u) const { return A + (size_t)u.pm * BM * K * 2; }
    __device__ __forceinline__ const char* b_ptr(const Unit& u) const { return Bt + (size_t)u.pn * BM * K * 2; }
    __device__ __forceinline__ void a_offs(const Unit&, const int (&R)[2], const int (&C)[2], unsigned (&v0)[2], unsigned (&v1)[2]) const {
#pragma unroll
        for (int i = 0; i < 2; ++i) { v0[i] = (unsigned)(R[i] * K + C[i]) * 2u; v1[i] = v0[i] + (unsigned)(HALF * K * 2); } }
    __device__ __forceinline__ void a_ready(const Unit&) const {}
    __device__ __forceinline__ void done(const Unit&) const {}
};
struct EpiF32 {
    static constexpr bool PERM = false, AFTER_DRAIN = false;
    float* C; int ldc;
    __device__ __forceinline__ void operator()(const f32x4 (&acc)[2][2][4][2], const Unit& u, int wr, int wc, int fr, int fq) const {
        const int row0 = u.pm * BM + wr * 64 + fr, col0 = u.pn * BM + wc * 32 + 4 * fq;
#pragma unroll
        for (int ai = 0; ai < 2; ++ai)
#pragma unroll
            for (int m = 0; m < 4; ++m) { float* rowp = C + (size_t)(row0 + ai * HALF + m * 16) * ldc + col0;
#pragma unroll
                for (int bj = 0; bj < 2; ++bj)
#pragma unroll
                    for (int n = 0; n < 2; ++n) *(f32x4*)(rowp + bj * HALF + n * 16) = acc[ai][bj][m][n]; }
    }
};
struct EpiBf16Plain {
    static constexpr bool PERM = true, AFTER_DRAIN = false;
    bf16_t* O; int ldc;
    __device__ __forceinline__ void operator()(const f32x4 (&acc)[2][2][4][2], const Unit& u, int wr, int wc, int fr, int fq) const {
        const int row0 = u.pm * BM + wr * 64 + fr, col0 = u.pn * BM + wc * 32 + 8 * fq;
#pragma unroll
        for (int ai = 0; ai < 2; ++ai)
#pragma unroll
            for (int m = 0; m < 4; ++m) { bf16_t* rowp = O + (size_t)(row0 + ai * HALF + m * 16) * ldc + col0;
#pragma unroll
                for (int bj = 0; bj < 2; ++bj) { const f32x4 v0 = acc[ai][bj][m][0], v1 = acc[ai][bj][m][1];
                    u32x4 w; w.x = cvt_pk_bf16(v0[0], v0[1]); w.y = cvt_pk_bf16(v0[2], v0[3]); w.z = cvt_pk_bf16(v1[0], v1[1]); w.w = cvt_pk_bf16(v1[2], v1[3]);
                    *(u32x4*)(rowp + bj * HALF) = w; } }
    }
};
}
namespace pg8 {
constexpr int MOE_MAXU = 3;
typedef int i32x16 __attribute__((ext_vector_type(16)));
typedef unsigned u32x16 __attribute__((ext_vector_type(16)));
struct MoePlan {
    i32x16 toff, cnt; int TT;
    __device__ __forceinline__ void init(const int* cntp) { int acc = 0;
#pragma unroll
        for (int q = 0; q < N_EXP; ++q) { const int cq = __builtin_amdgcn_readfirstlane(cntp[q * CNT_STRIDE]); cnt[q] = cq; toff[q] = acc; acc += (cq + BM - 1) / BM; }
        TT = acc; }
    __device__ __forceinline__ void decode(int pm, int& e, int& lt, int& ce) const { int ee = 0, base = 0, cc = cnt[0];
#pragma unroll
        for (int q = 1; q < N_EXP; ++q) { const bool ge = pm >= toff[q]; ee = ge ? q : ee; base = ge ? toff[q] : base; cc = ge ? cnt[q] : cc; }
        e = ee; lt = pm - base; ce = cc; }
};
struct MoeOrder {
    const char* A; const char* W; const int* slottok; int K; size_t wexp; int nN, TT, nwg, G, c; bool gather;
    MoePlan pl;
    u32x16 goff;
    __device__ __forceinline__ bool next(int i, Unit& u) const {
        const long L = (long)i * G + c; if (L >= nwg) return false;
        int wgid = (int)L; { const int q = nwg / NXCD, r = nwg % NXCD, xcd = wgid % NXCD, off = wgid / NXCD; wgid = (xcd < r ? xcd * (q + 1) : r * (q + 1) + (xcd - r) * q) + off; }
        const int nig = WGM * nN, gid = wgid / nig, fm = gid * WGM, gsz = (TT - fm) < WGM ? (TT - fm) : WGM;
        u.pm = fm + ((wgid % nig) % gsz); u.pn = (wgid % nig) / gsz; u.aux = i; return true;
    }
    __device__ __forceinline__ void init(const void* A_, const void* W_, const int* cntp, const int* slottok_, int N, int K_, bool gather_, int G_, int c_) {
        A = (const char*)A_; W = (const char*)W_; slottok = slottok_; K = K_; wexp = (size_t)N * K_ * 2; nN = N / BM; G = G_; c = c_; gather = gather_;
        pl.init(cntp); TT = pl.TT; nwg = TT * nN;
        if (gather) {
            int tid_l = threadIdx.x; asm volatile("" : "+v"(tid_l));
#pragma unroll
            for (int ui = 0; ui < MOE_MAXU; ++ui) { Unit u; u.pm = 0; u.pn = 0; u.aux = 0; const bool ok = next(ui, u); int e, lt, ce; pl.decode(ok ? u.pm : 0, e, lt, ce);
#pragma unroll
                for (int i = 0; i < 2; ++i) { int R, C; stage_rc(tid_l * 16 + i * 8192, R, C);
#pragma unroll
                    for (int h = 0; h < 2; ++h) { int slot = lt * BM + h * HALF + R; if (slot >= ce) slot = 0;
                        const int tok2 = ok ? slottok[(size_t)e * NROW + slot] : 0;
                        goff[ui * 4 + h * 2 + i] = (unsigned)((tok2 >> 1) * K + C) * 2u; } } }
        }
    }
    __device__ __forceinline__ const char* a_ptr(const Unit& u) const { return gather ? A : A + (size_t)u.pm * BM * K * 2; }
    __device__ __forceinline__ const char* b_ptr(const Unit& u) const { int e, lt, ce; pl.decode(u.pm, e, lt, ce); return W + (size_t)e * wexp + (size_t)u.pn * BM * K * 2; }
    __device__ __forceinline__ void a_offs(const Unit& u, const int (&R)[2], const int (&C)[2], unsigned (&v0)[2], unsigned (&v1)[2]) const {
        if (gather) {
#pragma unroll
            for (int i = 0; i < 2; ++i) { unsigned a = goff[i], b = goff[2 + i];
#pragma unroll
                for (int q = 1; q < MOE_MAXU; ++q) { const bool is = (u.aux == q); a = is ? goff[q * 4 + i] : a; b = is ? goff[q * 4 + 2 + i] : b; }
                v0[i] = a; v1[i] = b; }
        } else {
#pragma unroll
            for (int i = 0; i < 2; ++i) { v0[i] = (unsigned)(R[i] * K + C[i]) * 2u; v1[i] = v0[i] + (unsigned)(HALF * K * 2); } }
    }
    __device__ __forceinline__ void a_ready(const Unit&) const {}
    __device__ __forceinline__ void done(const Unit&) const {}
};
struct EpiSwiGLU {
    static constexpr bool PERM = true, AFTER_DRAIN = false;
    bf16_t* HMp;
    __device__ __forceinline__ void operator()(const f32x4 (&acc)[2][2][4][2], const Unit& u, int wr, int wc, int fr, int fq) const {
        const int row0 = u.pm * BM + wr * 64 + fr, col0 = u.pn * HALF + wc * 32 + 8 * fq;
#pragma unroll
        for (int ai = 0; ai < 2; ++ai)
#pragma unroll
            for (int m = 0; m < 4; ++m) { bf16_t* rowp = HMp + (size_t)(row0 + ai * HALF + m * 16) * EXP_FF + col0;
                float h[8];
#pragma unroll
                for (int n = 0; n < 2; ++n)
#pragma unroll
                    for (int j = 0; j < 4; ++j) { const float g = acc[ai][0][m][n][j], uu = acc[ai][1][m][n][j]; h[n * 4 + j] = g * __builtin_amdgcn_rcpf(1.f + __expf(-g)) * uu; }
                u32x4 w; w.x = cvt_pk_bf16(h[0], h[1]); w.y = cvt_pk_bf16(h[2], h[3]); w.z = cvt_pk_bf16(h[4], h[5]); w.w = cvt_pk_bf16(h[6], h[7]);
                *(u32x4*)rowp = w; }
    }
};
struct EpiMoeDown {
    static constexpr bool PERM = true, AFTER_DRAIN = false;
    bf16_t* FOp; const float* TGp; const int* slottok; MoePlan pl;
    __device__ __forceinline__ void operator()(const f32x4 (&acc)[2][2][4][2], const Unit& u, int wr, int wc, int fr, int fq) const {
        int e, lt, ce; pl.decode(u.pm, e, lt, ce);
        const int col0 = u.pn * BM + wc * 32 + 8 * fq;
#pragma unroll
        for (int ai = 0; ai < 2; ++ai)
#pragma unroll
            for (int m = 0; m < 4; ++m) { const int slot = lt * BM + ai * HALF + wr * 64 + m * 16 + fr;
                if (slot < ce) { const int tok2 = slottok[(size_t)e * NROW + slot]; const float gate = TGp[tok2];
                    bf16_t* rowp = FOp + (size_t)tok2 * D_MODEL + col0;
#pragma unroll
                    for (int bj = 0; bj < 2; ++bj) { const f32x4 v0 = acc[ai][bj][m][0] * gate, v1 = acc[ai][bj][m][1] * gate;
                        u32x4 w; w.x = cvt_pk_bf16(v0[0], v0[1]); w.y = cvt_pk_bf16(v0[2], v0[3]); w.z = cvt_pk_bf16(v1[0], v1[1]); w.w = cvt_pk_bf16(v1[2], v1[3]);
                        *(u32x4*)(rowp + bj * HALF) = w; } } }
    }
};
}
namespace pg8 {
static_assert(IN_W == 8 * BM && LRU_W == BM && GQA_H == 8 && GQA_KV == 2 && DIFF_H == 4 && NLAT % BM == 0 && CTX_LEN == BM, "EpiInProj is written for this problem's column partition");
struct EpiInProj {
    static constexpr bool PERM = true, AFTER_DRAIN = false;
    float* AX; float* GA; bf16_t* ZQ; bf16_t* ZK; bf16_t* ZV; const float* qg; const float* kg;
    int* nb;
    __device__ __forceinline__ void operator()(const f32x4 (&acc)[2][2][4][2], const Unit& u, int wr, int wc, int fr, int fq) const {
        const int pn = u.pn, pm = u.pm;
        const bool lat = pm < NLAT / BM;
        const int b = lat ? pm / (SEQ / BM) : pm - NLAT / BM;
        const int rt0 = wr * 64 + fr;
        const int t0 = lat ? (pm % (SEQ / BM)) * BM : 0;
        const size_t kbase = (size_t)b * SKEY + (lat ? CTX_LEN + t0 : 0);
        const size_t row_base = (size_t)pm * BM;
        if (pn < 2) {
            float* dst = pn == 0 ? AX : GA;
#pragma unroll
            for (int ai = 0; ai < 2; ++ai)
#pragma unroll
                for (int m = 0; m < 4; ++m) { float* rowp = dst + (row_base + rt0 + ai * HALF + m * 16) * LRU_W + wc * 32 + 8 * fq;
#pragma unroll
                    for (int bj = 0; bj < 2; ++bj)
#pragma unroll
                        for (int n = 0; n < 2; ++n) { f32x4 v = acc[ai][bj][m][n];
                            if (pn == 1) {
#pragma unroll
                                for (int j = 0; j < 4; ++j) { const float x = v[j]; const float tt = 0.7978845608028654f * (x + 0.044715f * x * x * x); const float e2 = __expf(2.f * tt); v[j] = x - x * __builtin_amdgcn_rcpf(e2 + 1.f); } }
                            *(f32x4*)(rowp + bj * HALF + n * 4) = v; } }
            return;
        }
        const bool isq_g = (pn == 2 || pn == 3), is4 = (pn == 4), isdq = (pn == 5), isdk = (pn == 6), isdv = (pn == 7);
        const bool norm = isq_g || (is4 && wc < 2);
        const bool rope64 = norm && lat, rope32 = (isdq || isdk) && lat;
        const float* gains = isq_g ? qg : kg;
        float g16[2][8];
        if (norm) {
#pragma unroll
            for (int bj = 0; bj < 2; ++bj)
#pragma unroll
                for (int k = 0; k < 8; ++k) g16[bj][k] = gains[32 * bj + 8 * fq + k];
        }
        float inv[4]; bool usecol32 = false;
#pragma unroll
        for (int pp = 0; pp < 4; ++pp) {
            if (rope64) inv[pp] = exp2f(-(float)(4 * fq + pp) * (13.287712379549449f / 16.f));
            else { const int i = 4 * fq + pp; inv[pp] = exp2f(-(float)(i & 7) * (13.287712379549449f / 8.f)); }
        }
        usecol32 = fq >= 2;
        bf16_t* dbase; int dpitch; bool keyrow; float qs = 1.f; bool pad32 = false;
        if (isq_g) { dbase = ZQ + (4 * (pn - 2) + wc) * 64; dpitch = QP; keyrow = false; qs = QS_G; }
        else if (is4) { if (wc < 2) { dbase = ZK + wc * 64; dpitch = KP; } else { dbase = ZV + (wc - 2) * 64; dpitch = VP; } keyrow = true; }
        else if (isdq) { dbase = ZQ + (GQA_H + 2 * wc) * 64; dpitch = QP; keyrow = false; qs = QS_D; pad32 = true; }
        else if (isdk) { dbase = ZK + (GQA_KV + 2 * wc) * 64; dpitch = KP; keyrow = true; pad32 = true; }
        else { dbase = ZV + (GQA_KV + wc) * 64; dpitch = VP; keyrow = true; }
        (void)isdv;
        float nmx[2] = {0.f, 0.f};
#pragma unroll
        for (int ai = 0; ai < 2; ++ai)
#pragma unroll
            for (int m = 0; m < 4; ++m) {
                const int rin = rt0 + ai * HALF + m * 16;
                float v[2][8];
#pragma unroll
                for (int bj = 0; bj < 2; ++bj)
#pragma unroll
                    for (int n = 0; n < 2; ++n)
#pragma unroll
                        for (int j = 0; j < 4; ++j) v[bj][n * 4 + j] = acc[ai][bj][m][n][j];
                if (norm) { float ss = 0.f;
#pragma unroll
                    for (int bj = 0; bj < 2; ++bj)
#pragma unroll
                        for (int k = 0; k < 8; ++k) ss += v[bj][k] * v[bj][k];
                    ss = swap32_sum(swap16_sum(ss));
                    const float rs = 1.0f / sqrtf(ss * (1.f / 64.f) + 1e-6f);
#pragma unroll
                    for (int bj = 0; bj < 2; ++bj)
#pragma unroll
                        for (int k = 0; k < 8; ++k) v[bj][k] = v[bj][k] * rs * g16[bj][k]; }
                if (rope64 || rope32) { const int t = t0 + rin; const float prow = (float)(t / GRID_W), pcol = (float)(t % GRID_W);
#pragma unroll
                    for (int bj = 0; bj < 2; ++bj) { const float pos = rope64 ? (bj ? pcol : prow) : (usecol32 ? pcol : prow);
#pragma unroll
                        for (int pp = 0; pp < 4; ++pp) { const float ang = pos * inv[pp]; const float cs = __cosf(ang), sn = __sinf(ang);
                            const float x0 = v[bj][2 * pp], x1 = v[bj][2 * pp + 1]; v[bj][2 * pp] = x0 * cs - x1 * sn; v[bj][2 * pp + 1] = x0 * sn + x1 * cs; } } }
                if (pad32) {
#pragma unroll
                    for (int bj = 0; bj < 2; ++bj) { float ss = 0.f;
#pragma unroll
                        for (int k = 0; k < 8; ++k) ss += (v[bj][k] * qs) * (v[bj][k] * qs);
                        ss = swap32_sum(swap16_sum(ss)); nmx[bj] = fmaxf(nmx[bj], ss); } }
                bf16_t* rowp = dbase + (keyrow ? (kbase + rin) : (row_base + rin)) * (size_t)dpitch;
#pragma unroll
                for (int bj = 0; bj < 2; ++bj) { u32x4 w; w.x = cvt_pk_bf16(v[bj][0] * qs, v[bj][1] * qs); w.y = cvt_pk_bf16(v[bj][2] * qs, v[bj][3] * qs); w.z = cvt_pk_bf16(v[bj][4] * qs, v[bj][5] * qs); w.w = cvt_pk_bf16(v[bj][6] * qs, v[bj][7] * qs);
                    if (pad32) { bf16_t* q = rowp + bj * 64 + 8 * fq; *(u32x4*)q = w; unsigned z_ = 0u; asm volatile("" : "+v"(z_)); *(u32x4*)(q + 32) = (u32x4){z_, z_, z_, z_}; }
                    else *(u32x4*)(rowp + 32 * bj + 8 * fq) = w; }
            }
        if (pad32) {
#pragma unroll
            for (int bj = 0; bj < 2; ++bj) { float mxv = nmx[bj]; mxv = fmaxf(mxv, dpp_mov<DPP_XOR1>(mxv)); mxv = fmaxf(mxv, dpp_mov<DPP_XOR2>(mxv)); mxv = fmaxf(mxv, dpp_mov<DPP_HMIR>(mxv)); mxv = fmaxf(mxv, dpp_mov<DPP_MIR>(mxv));
                if (fr == 0 && fq == 0) atomicMax(nb + b * 16 + (isdk ? 8 : 0) + 2 * wc + bj, __float_as_int(mxv)); } }
    }
};
}
typedef float f32x4_t __attribute__((ext_vector_type(4)));
typedef unsigned u32x2_t __attribute__((ext_vector_type(2)));
typedef float f32x2_t_ __attribute__((ext_vector_type(2)));
typedef unsigned u32x4_t __attribute__((ext_vector_type(4)));
__device__ __forceinline__ unsigned pk2bf(float lo, float hi) { unsigned r; asm volatile("v_cvt_pk_bf16_f32 %0, %1, %2" : "=v"(r) : "v"(lo), "v"(hi)); return r; }
#define LDS_WAIT_() asm volatile("s_waitcnt lgkmcnt(0)" ::: "memory")
__device__ __forceinline__ f32x4_t unpk4bf(u32x2_t u) { f32x4_t f; f.x = __uint_as_float(u.x << 16); f.y = __uint_as_float(u.x & 0xffff0000u); f.z = __uint_as_float(u.y << 16); f.w = __uint_as_float(u.y & 0xffff0000u); return f; }
__device__ __forceinline__ u32x2_t pk4bf(f32x4_t v) { u32x2_t o; o.x = pk2bf(v.x, v.y); o.y = pk2bf(v.z, v.w); return o; }
#define LNC(j) (8 * lane + 512 * ((j) >> 1) + 4 * ((j) & 1))
constexpr int NJ4 = D_MODEL / 256;
__device__ __forceinline__ void ld8bf(const bf16_t* q, u32x2_t& a, u32x2_t& b) { const u32x4_t v = *(const u32x4_t*)q; a.x = v.x; a.y = v.y; b.x = v.z; b.y = v.w; }
__device__ __forceinline__ void st8bf(bf16_t* q, u32x2_t a, u32x2_t b) { *(u32x4_t*)q = (u32x4_t){a.x, a.y, b.x, b.y}; }

__device__ __forceinline__ void cvt_item(const float* W, int K, int N, bf16_t* WT, int k0, int n0, int dst_row0, LAS float* scr, int lane) {
    float tv[32];
#pragma unroll
    for (int i = 0; i < 32; ++i) tv[i] = W[(size_t)(k0 + 2 * i + (lane >> 5)) * N + n0 + (lane & 31)];
#pragma unroll
    for (int i = 0; i < 32; ++i) scr[(2 * i + (lane >> 5)) * 33 + (lane & 31)] = tv[i];
    LDS_WAIT_();
    const int c = lane & 7;
#pragma unroll
    for (int j = 0; j < 4; ++j) { const int n = (lane >> 3) + 8 * j; const LAS float* s = scr + (8 * c) * 33 + n;
        u32x4_t o; o.x = pk2bf(s[0 * 33], s[1 * 33]); o.y = pk2bf(s[2 * 33], s[3 * 33]); o.z = pk2bf(s[4 * 33], s[5 * 33]); o.w = pk2bf(s[6 * 33], s[7 * 33]);
        *(u32x4_t*)(WT + (size_t)(dst_row0 + n) * K + k0 + 8 * c) = o; }
    LDS_WAIT_();
}
constexpr int CVT_I_IN = (D_MODEL / 64) * (IN_W / 256), CVT_I_OUT = (MIX_W / 64) * (D_MODEL / 256), CVT_I_GU1 = (D_MODEL / 64) * (EXP_FF / 256), CVT_I_D1 = (EXP_FF / 64) * (D_MODEL / 256);
constexpr int CVT_NIT = CVT_I_IN + CVT_I_OUT + N_EXP * (2 * CVT_I_GU1 + CVT_I_D1);
struct CvtItem { const float* W; bf16_t* WT; int K, N, k0, n0, kind; };
__device__ __forceinline__ CvtItem cvt_decode(const P& p, int l, int it) {
    CvtItem c; bf16_t* wb = p.WB[l & 1]; int r = it;
    if (r < CVT_I_IN) { const int nb = IN_W / 256; c.W = p.w_in + (size_t)l * D_MODEL * IN_W; c.WT = WB_WIN(wb); c.K = D_MODEL; c.N = IN_W; c.k0 = 64 * (r % (D_MODEL / 64)); c.n0 = 256 * (r / (D_MODEL / 64)); c.kind = 1; (void)nb; return c; } r -= CVT_I_IN;
    if (r < CVT_I_OUT) { const int nb = D_MODEL / 256; c.W = p.w_out + (size_t)l * MIX_W * D_MODEL; c.WT = WB_WOUT(wb); c.K = MIX_W; c.N = D_MODEL; c.k0 = 64 * (r % (MIX_W / 64)); c.n0 = 256 * (r / (MIX_W / 64)); c.kind = 0; (void)nb; return c; } r -= CVT_I_OUT;
    const int per_e = 2 * CVT_I_GU1 + CVT_I_D1, e = r / per_e; r -= e * per_e;
    if (r < 2 * CVT_I_GU1) { const int half = r / CVT_I_GU1; r -= half * CVT_I_GU1; const int nb = EXP_FF / 256;
        c.W = (half ? p.exp_w_up : p.exp_w_gate) + ((size_t)l * N_EXP + e) * D_MODEL * EXP_FF; c.WT = WB_WGU(wb) + (size_t)e * 2 * EXP_FF * D_MODEL; c.K = D_MODEL; c.N = EXP_FF; c.k0 = 64 * (r % (D_MODEL / 64)); c.n0 = 256 * (r / (D_MODEL / 64)); c.kind = 2 + half; (void)nb; return c; }
    r -= 2 * CVT_I_GU1;
    { const int nb = D_MODEL / 256; c.W = p.exp_w_down + ((size_t)l * N_EXP + e) * EXP_FF * D_MODEL; c.WT = WB_WD(wb) + (size_t)e * D_MODEL * EXP_FF; c.K = EXP_FF; c.N = D_MODEL; c.k0 = 64 * (r % (EXP_FF / 64)); c.n0 = 256 * (r / (EXP_FF / 64)); c.kind = 0; (void)nb; }
    return c;
}
__device__ __forceinline__ int cvt_drow(int kind, int n) {
    if (kind == 1) { if (n < 512) return n; const int sc = n % 256; return (n - sc) + 128 * ((sc % 64) / 32) + 32 * (sc / 64) + (sc % 32); }
    if (kind >= 2) return gu_row(kind - 2, n);
    return n;
}
__device__ __forceinline__ void cvt_load(const CvtItem& c, f32x4_t (&v)[8], int wave, int lane) {
#pragma unroll
    for (int i = 0; i < 8; ++i) v[i] = *(const f32x4_t*)(c.W + (size_t)(c.k0 + wave * 8 + i) * c.N + c.n0 + 4 * lane);
}
template <int MODE = 0> __device__ __forceinline__ void ph_cvt_range(const P& p, int l, unsigned char* lds, int it0, int it1, int start, int stride, int tid) {
    LAS float* scr = (LAS float*)(LAS unsigned char*)lds;
    const int wave = tid >> 6, lane = tid & 63;
    if (it0 + start >= it1) return;
    CvtItem c = cvt_decode(p, l, it0 + start); f32x4_t v[8]; cvt_load(c, v, wave, lane);
    for (int it = it0 + start; it < it1; it += stride) {
#pragma unroll
        for (int i = 0; i < 8; ++i) { const int k = wave * 8 + i;
            scr[(4 * lane + 0) * 65 + k] = v[i].x; scr[(4 * lane + 1) * 65 + k] = v[i].y; scr[(4 * lane + 2) * 65 + k] = v[i].z; scr[(4 * lane + 3) * 65 + k] = v[i].w; }
        const CvtItem cur = c;
        if (it + stride < it1) { c = cvt_decode(p, l, it + stride); cvt_load(c, v, wave, lane); }
        __syncthreads();
        const int ch = lane & 7;
#pragma unroll
        for (int j = 0; j < 4; ++j) { const int n = wave * 32 + j * 8 + (lane >> 3); const LAS float* s = scr + n * 65 + 8 * ch;
            u32x4_t o; o.x = pk2bf(s[0], s[1]); o.y = pk2bf(s[2], s[3]); o.z = pk2bf(s[4], s[5]); o.w = pk2bf(s[6], s[7]);
            *(u32x4_t*)(cur.WT + (size_t)cvt_drow(cur.kind, cur.n0 + n) * cur.K + cur.k0 + 8 * ch) = o; }
        __syncthreads();
    }
}
__device__ __forceinline__ void ph_cvt(const P& p, int l, unsigned char* lds, int vcu, int G, int tid) { ph_cvt_range<0>(p, l, lds, 0, CVT_NIT, vcu, G, tid); }

__device__ __forceinline__ void ph_ada(const P& p, unsigned char* lds, int vcu, int G, int wave, int lane) {
    LAS float* red = (LAS float*)(LAS unsigned char*)lds;
    LAS float* sl = red + 8 * 3 * 64;
    for (int i = wave * 64 + lane; i < 3 * D_MODEL; i += NTHR) { const float x = i < 2 * D_MODEL ? p.c[i] : p.c_ctx[i - 2 * D_MODEL]; sl[i] = siluf_(x); }
    __syncthreads();
    constexpr int UPL = 6 * D_MODEL / 32, NU = DEPTH * UPL;
    const int cl = lane & 31, kh = lane >> 5;
    for (int u = vcu; u < NU; u += G) {
        const int l = u / UPL, col = (u % UPL) * 32 + cl;
        const float* W = p.ada_w + (size_t)l * D_MODEL * 6 * D_MODEL + col;
        float a0 = 0.f, a1 = 0.f, a2 = 0.f;
        const int kb = wave * (D_MODEL / 8) + kh * (D_MODEL / 16);
#pragma unroll 16
        for (int k = 0; k < D_MODEL / 16; ++k) { const float wv = W[(size_t)(kb + k) * 6 * D_MODEL];
            a0 += sl[kb + k] * wv; a1 += sl[D_MODEL + kb + k] * wv; a2 += sl[2 * D_MODEL + kb + k] * wv; }
        a0 += __shfl_xor(a0, 32); a1 += __shfl_xor(a1, 32); a2 += __shfl_xor(a2, 32);
        if (kh == 0) { red[(wave * 3 + 0) * 32 + cl] = a0; red[(wave * 3 + 1) * 32 + cl] = a1; red[(wave * 3 + 2) * 32 + cl] = a2; }
        __syncthreads();
        if (wave < 3 && lane < 32) { float s = 0.f;
#pragma unroll
            for (int w = 0; w < 8; ++w) s += red[(w * 3 + wave) * 32 + lane];
            p.MOD[((size_t)l * 3 + wave) * 6 * D_MODEL + col] = s + p.ada_b[l * 6 * D_MODEL + col]; }
        __syncthreads();
    }
}

__device__ __forceinline__ void ph_mod0(const P& p, int gw, int NGW, int lane) {
    f32x4_t sc[NJ4], sh[NJ4], va[NJ4], vn[NJ4]; int cur_who = -1;
#define MOD0_LOAD(V, ROW) do { const int rr_ = (ROW); const float* src_ = rr_ < NLAT ? p.x + (size_t)rr_ * D_MODEL : p.ctx + (size_t)(rr_ - NLAT) * D_MODEL; \
        _Pragma("unroll") for (int j = 0; j < NJ4; ++j) V[j] = *(const f32x4_t*)(src_ + LNC(j)); } while (0)
    if (gw < NROW) MOD0_LOAD(vn, gw);
    for (int r = gw; r < NROW; r += NGW) {
        const int who = row_who(r);
#pragma unroll
        for (int j = 0; j < NJ4; ++j) va[j] = vn[j];
        if (r + NGW < NROW) MOD0_LOAD(vn, r + NGW);
        if (who != cur_who) { cur_who = who;
#pragma unroll
            for (int j = 0; j < NJ4; ++j) { sh[j] = *(const f32x4_t*)(modp(p, 0, who, 0) + LNC(j)); sc[j] = *(const f32x4_t*)(modp(p, 0, who, 1) + LNC(j)); } }
#pragma unroll
        for (int j = 0; j < NJ4; j += 2) { const int c = LNC(j);
            st8bf((bf16_t*)p.XR + (size_t)r * D_MODEL + c, pk4bf(va[j]), pk4bf(va[j + 1]));
            st8bf(p.H + (size_t)r * D_MODEL + c, pk4bf(va[j] * (1.f + sc[j]) + sh[j]), pk4bf(va[j + 1] * (1.f + sc[j + 1]) + sh[j + 1])); }
    }
#undef MOD0_LOAD
}
__device__ __forceinline__ void route_tail(float lgt, const float* router_b, int lane, int& e1, int& e2, float& gw1, float& gw2);
__device__ __forceinline__ void route_wave(const float (&lg)[N_EXP], const float* router_b, int lane, int& e1, int& e2, float& gw1, float& gw2) {
    static_assert(N_EXP == 16, "lane layout");
    const bool b5 = (lane >> 5) & 1, b4 = (lane >> 4) & 1, b3 = (lane >> 3) & 1, b2 = (lane >> 2) & 1;
    float r8[8], r4[4], r2[2];
#pragma unroll
    for (int i = 0; i < 8; ++i) { const float a = b5 ? lg[i + 8] : lg[i], b = b5 ? lg[i] : lg[i + 8]; r8[i] = a + __shfl_xor(b, 32); }
#pragma unroll
    for (int i = 0; i < 4; ++i) { const float a = b4 ? r8[i + 4] : r8[i], b = b4 ? r8[i] : r8[i + 4]; r4[i] = a + __shfl_xor(b, 16); }
#pragma unroll
    for (int i = 0; i < 2; ++i) { const float a = b3 ? r4[i + 2] : r4[i], b = b3 ? r4[i] : r4[i + 2]; r2[i] = a + __shfl_xor(b, 8); }
    float lgt = (b2 ? r2[1] : r2[0]) + __shfl_xor(b2 ? r2[0] : r2[1], 4);
    lgt += __shfl_xor(lgt, 2); lgt += __shfl_xor(lgt, 1);
    route_tail(lgt, router_b, lane, e1, e2, gw1, gw2);
}
__device__ __forceinline__ void route_tail(float lgt, const float* router_b, int lane, int& e1, int& e2, float& gw1, float& gw2) {
    const int e = lane >> 2;
    float mx = lgt; mx = fmaxf(mx, dpp_mov<DPP_HMIR>(mx)); mx = fmaxf(mx, dpp_mov<DPP_MIR>(mx)); mx = swap16_max(mx); mx = swap32_max(mx);
    const float pe = expf(lgt - mx);
    float sm = pe; sm += dpp_mov<DPP_HMIR>(sm); sm += dpp_mov<DPP_MIR>(sm); sm = swap16_sum(sm); sm = swap32_sum(sm);
    const float prob = pe * (1.f / sm), sel = prob + router_b[e];
    const int rb = lane & 48;
    float sj[4], pj[4];
#pragma unroll
    for (int j = 0; j < 4; ++j) { sj[j] = __shfl(sel, rb + 4 * j); pj[j] = __shfl(prob, rb + 4 * j); }
    float s1 = -1e30f, p1 = 0.f; int i1 = 0;
#pragma unroll
    for (int j = 0; j < 4; ++j) if (sj[j] > s1) { s1 = sj[j]; i1 = j; p1 = pj[j]; }
    float s2 = -1e30f, p2 = 0.f; int i2 = 0;
#pragma unroll
    for (int j = 0; j < 4; ++j) if (j != i1 && sj[j] > s2) { s2 = sj[j]; i2 = j; p2 = pj[j]; }
    const float sc = s1 + s2;
    float bs = -1e30f; int bg = 0;
#pragma unroll
    for (int g = 0; g < 4; ++g) { const float sg = __shfl(sc, 16 * g); if (sg > bs) { bs = sg; bg = g; } }
    const int src = 16 * bg;
    const int ri1 = __shfl(i1, src), ri2 = __shfl(i2, src); const float rp1 = __shfl(p1, src), rp2 = __shfl(p2, src);
    e1 = bg * 4 + ri1; e2 = bg * 4 + ri2; const float ws = rp1 + rp2; gw1 = rp1 / ws; gw2 = rp2 / ws;
}
constexpr int LNR_MAXR = 16;
static_assert(NROW < 65536, "row index is packed in 16 bits");
__device__ __forceinline__ void ph_lnroute(const P& p, int l, unsigned char* lds, int gw, int NGW, int tid, int lane, const int nrow) {
    typedef short bf16x8_t __attribute__((ext_vector_type(8)));
    constexpr int AST = D_MODEL * 2 + 16;
    LAS unsigned char* AH = (LAS unsigned char*)lds; LAS unsigned char* AL = AH + 8 * AST;
    LAS float* PART = (LAS float*)(AL + 8 * AST);
    LAS int* LC = (LAS int*)(PART + 8 * 16 * 16);
    LAS int* REC = LC + 2 * N_EXP;
    const int wave = __builtin_amdgcn_readfirstlane(tid >> 6); int nrec = 0;
    if (tid < 2 * N_EXP) LC[tid] = 0;
    f32x4_t lng[NJ4], lnb[NJ4], mg1[NJ4], msc[NJ4], msh[NJ4]; int cur_who = -1;
#pragma unroll
    for (int j = 0; j < NJ4; ++j) { const int c = LNC(j); lng[j] = *(const f32x4_t*)(p.ln1_g + l * D_MODEL + c); lnb[j] = *(const f32x4_t*)(p.ln1_b + l * D_MODEL + c); }
    u32x2_t xa[NJ4], ya[NJ4], xn[NJ4], yn[NJ4];
    if (gw < nrow) {
#pragma unroll
        for (int j = 0; j < NJ4; j += 2) { const int c = LNC(j); ld8bf((const bf16_t*)p.XR + (size_t)gw * D_MODEL + c, xn[j], xn[j + 1]); ld8bf((const bf16_t*)p.YO + (size_t)gw * D_MODEL + c, yn[j], yn[j + 1]); } }
    bf16x8_t Bhi[4], Blo[4];
    { const int e = lane & 15, kq = lane >> 4;
#pragma unroll
      for (int s = 0; s < 4; ++s) { unsigned hh[4], ll[4];
#pragma unroll
          for (int j2 = 0; j2 < 4; ++j2) { const int k = 128 * wave + 32 * s + 8 * kq + 2 * j2; const float w0 = p.router_w[k * N_EXP + e], w1 = p.router_w[(k + 1) * N_EXP + e];
              hh[j2] = pk2bf(w0, w1); ll[j2] = pk2bf(w0 - __uint_as_float(hh[j2] << 16), w1 - __uint_as_float(hh[j2] & 0xffff0000u)); }
          Bhi[s] = __builtin_bit_cast(bf16x8_t, (u32x4_t){hh[0], hh[1], hh[2], hh[3]}); Blo[s] = __builtin_bit_cast(bf16x8_t, (u32x4_t){ll[0], ll[1], ll[2], ll[3]}); } }
    __syncthreads();
    for (int r = gw; r < nrow; r += NGW) {
        const int who = row_who(r);
#pragma unroll
        for (int j = 0; j < NJ4; ++j) { xa[j] = xn[j]; ya[j] = yn[j]; }
        if (r + NGW < nrow) {
#pragma unroll
            for (int j = 0; j < NJ4; j += 2) { const int c = LNC(j); ld8bf((const bf16_t*)p.XR + (size_t)(r + NGW) * D_MODEL + c, xn[j], xn[j + 1]); ld8bf((const bf16_t*)p.YO + (size_t)(r + NGW) * D_MODEL + c, yn[j], yn[j + 1]); } }
        if (who != cur_who) { cur_who = who;
#pragma unroll
            for (int j = 0; j < NJ4; ++j) { const int c = LNC(j); mg1[j] = *(const f32x4_t*)(modp(p, l, who, 2) + c); msh[j] = *(const f32x4_t*)(modp(p, l, who, 3) + c); msc[j] = *(const f32x4_t*)(modp(p, l, who, 4) + c); } }
        f32x4_t t[NJ4]; float s = 0.f;
#pragma unroll
        for (int j = 0; j < NJ4; ++j) { t[j] = unpk4bf(xa[j]) * DN_ALPHA + mg1[j] * unpk4bf(ya[j]); s += (t[j].x + t[j].y) + (t[j].z + t[j].w); }
        const float mean = wave_sum(s) * (1.f / D_MODEL); float s2 = 0.f;
#pragma unroll
        for (int j = 0; j < NJ4; ++j) { t[j] = t[j] - mean; s2 += (t[j].x * t[j].x + t[j].y * t[j].y) + (t[j].z * t[j].z + t[j].w * t[j].w); }
        const float rstd = 1.0f / sqrtf(wave_sum(s2) * (1.f / D_MODEL) + 1e-6f);
#pragma unroll
        for (int j = 0; j < NJ4; j += 2) { const int c = LNC(j); u32x2_t xo[2], hi[2], lo[2];
#pragma unroll
            for (int q = 0; q < 2; ++q) { const f32x4_t x1 = t[j + q] * rstd * lng[j + q] + lnb[j + q]; xo[q] = pk4bf(x1);
                const f32x4_t h2 = x1 * (1.f + msc[j + q]) + msh[j + q]; hi[q] = pk4bf(h2); lo[q] = pk4bf(h2 - unpk4bf(hi[q])); }
            st8bf((bf16_t*)p.XRo + (size_t)r * D_MODEL + c, xo[0], xo[1]); st8bf(p.Ho + (size_t)r * D_MODEL + c, hi[0], hi[1]);
            *(LAS u32x4_t*)(AH + wave * AST + c * 2) = (u32x4_t){hi[0].x, hi[0].y, hi[1].x, hi[1].y}; *(LAS u32x4_t*)(AL + wave * AST + c * 2) = (u32x4_t){lo[0].x, lo[0].y, lo[1].x, lo[1].y}; }
        __syncthreads();
        {
            f32x4_t acc = (f32x4_t){0.f, 0.f, 0.f, 0.f};
            const int arow = lane & 7, kq = lane >> 4;
#pragma unroll
            for (int s4 = 0; s4 < 4; ++s4) { const int off = arow * AST + (128 * wave + 32 * s4 + 8 * kq) * 2;
                const bf16x8_t ah = *(const LAS bf16x8_t*)(AH + off), al = *(const LAS bf16x8_t*)(AL + off);
                acc = __builtin_amdgcn_mfma_f32_16x16x32_bf16(ah, Bhi[s4], acc, 0, 0, 0);
                acc = __builtin_amdgcn_mfma_f32_16x16x32_bf16(ah, Blo[s4], acc, 0, 0, 0);
                acc = __builtin_amdgcn_mfma_f32_16x16x32_bf16(al, Bhi[s4], acc, 0, 0, 0); }
            if (lane < 32) {
#pragma unroll
                for (int i = 0; i < 4; ++i) PART[(wave * 16 + 4 * (lane >> 4) + i) * 16 + (lane & 15)] = acc[i]; }
        }
        __syncthreads();
        float lgt = 0.f;
#pragma unroll
        for (int w = 0; w < 8; ++w) lgt += PART[(w * 16 + wave) * 16 + (lane >> 2)];
        int e1, e2; float gw1, gw2; route_tail(lgt, p.router_b, lane, e1, e2, gw1, gw2);
        if (lane == 0) { p.TGo[r * 2 + 0] = gw1; p.TGo[r * 2 + 1] = gw2;
            const int k1 = __hip_atomic_fetch_add((LAS int*)&LC[e1], 1, __ATOMIC_RELAXED, __HIP_MEMORY_SCOPE_WORKGROUP), k2 = __hip_atomic_fetch_add((LAS int*)&LC[e2], 1, __ATOMIC_RELAXED, __HIP_MEMORY_SCOPE_WORKGROUP);
            REC[(wave * LNR_MAXR + nrec) * 2 + 0] = (r << 16) | (e1 << 12) | k1; REC[(wave * LNR_MAXR + nrec) * 2 + 1] = (r << 16) | (e2 << 12) | k2; }
        ++nrec;
    }
    __syncthreads();
    if (tid < N_EXP) { const int c = LC[tid]; LC[N_EXP + tid] = c ? atomicAdd(p.cnto + CNT_IDX(l, tid), c) : 0; }
    __syncthreads();
    if (lane < 2) for (int i = 0; i < nrec; ++i) { const int rec = REC[(wave * LNR_MAXR + i) * 2 + lane]; const int r = (unsigned)rec >> 16, e = (rec >> 12) & 15, k = rec & 4095;
        p.SLOTTOKo[(size_t)e * NROW + LC[N_EXP + e] + k] = r * 2 + lane; }
    __syncthreads();
}

__device__ __forceinline__ void ph_lnfinal(const P& p, int l, int gw, int NGW, int lane, const int nrow) {
    f32x4_t lng[NJ4], lnb[NJ4], mg2[NJ4], nsc[NJ4], nsh[NJ4]; int cur_who = -1;
#pragma unroll
    for (int j = 0; j < NJ4; ++j) { const int c = LNC(j); lng[j] = *(const f32x4_t*)(p.ln2_g + l * D_MODEL + c); lnb[j] = *(const f32x4_t*)(p.ln2_b + l * D_MODEL + c); }
    u32x2_t xa[NJ4], xn[NJ4], xm[NJ4]; u32x2_t fa0[NJ4], fa1[NJ4], fn0[NJ4], fn1[NJ4], fm0[NJ4], fm1[NJ4];
#define LNF_LOAD(X, F0, F1, ROW) do { const int rr_ = (ROW); _Pragma("unroll") for (int j = 0; j < NJ4; j += 2) { const int c = LNC(j); ld8bf((const bf16_t*)p.XR + (size_t)rr_ * D_MODEL + c, X[j], X[j + 1]); \
            ld8bf(p.FO + (size_t)(rr_ * 2) * D_MODEL + c, F0[j], F0[j + 1]); ld8bf(p.FO + (size_t)(rr_ * 2 + 1) * D_MODEL + c, F1[j], F1[j + 1]); } } while (0)
    if (gw < nrow) LNF_LOAD(xn, fn0, fn1, gw);
    if (gw + NGW < nrow) LNF_LOAD(xm, fm0, fm1, gw + NGW);
    for (int r = gw; r < nrow; r += NGW) {
        const int who = row_who(r);
#pragma unroll
        for (int j = 0; j < NJ4; ++j) { xa[j] = xn[j]; fa0[j] = fn0[j]; fa1[j] = fn1[j]; xn[j] = xm[j]; fn0[j] = fm0[j]; fn1[j] = fm1[j]; }
        if (r + 2 * NGW < nrow) LNF_LOAD(xm, fm0, fm1, r + 2 * NGW);
        if (who != cur_who) { cur_who = who;
#pragma unroll
            for (int j = 0; j < NJ4; ++j) { const int c = LNC(j); mg2[j] = *(const f32x4_t*)(modp(p, l, who, 5) + c);
                if (l + 1 < DEPTH) { nsh[j] = *(const f32x4_t*)(modp(p, l + 1, who, 0) + c); nsc[j] = *(const f32x4_t*)(modp(p, l + 1, who, 1) + c); } } }
        f32x4_t t[NJ4]; float s = 0.f;
#pragma unroll
        for (int j = 0; j < NJ4; ++j) { const u32x2_t u0 = fa0[j], u1 = fa1[j];
            f32x4_t f; f.x = __uint_as_float(u0.x << 16) + __uint_as_float(u1.x << 16); f.y = __uint_as_float(u0.x & 0xffff0000u) + __uint_as_float(u1.x & 0xffff0000u);
            f.z = __uint_as_float(u0.y << 16) + __uint_as_float(u1.y << 16); f.w = __uint_as_float(u0.y & 0xffff0000u) + __uint_as_float(u1.y & 0xffff0000u);
            t[j] = unpk4bf(xa[j]) * DN_ALPHA + mg2[j] * f; s += (t[j].x + t[j].y) + (t[j].z + t[j].w); }
        const float mean = wave_sum(s) * (1.f / D_MODEL); float s2 = 0.f;
#pragma unroll
        for (int j = 0; j < NJ4; ++j) { t[j] = t[j] - mean; s2 += (t[j].x * t[j].x + t[j].y * t[j].y) + (t[j].z * t[j].z + t[j].w * t[j].w); }
        const float rstd = 1.0f / sqrtf(wave_sum(s2) * (1.f / D_MODEL) + 1e-6f);
#pragma unroll
        for (int j = 0; j < NJ4; j += 2) { const int c = LNC(j);
            const f32x4_t xa2 = t[j] * rstd * lng[j] + lnb[j], xb2 = t[j + 1] * rstd * lng[j + 1] + lnb[j + 1];
            if (l + 1 < DEPTH) { st8bf((bf16_t*)p.XRo + (size_t)r * D_MODEL + c, pk4bf(xa2), pk4bf(xb2));
                st8bf(p.Ho + (size_t)r * D_MODEL + c, pk4bf(xa2 * (1.f + nsc[j]) + nsh[j]), pk4bf(xb2 * (1.f + nsc[j + 1]) + nsh[j + 1])); }
            else if (r < NLAT) { *(f32x4_t*)(p.out + (size_t)r * D_MODEL + c) = xa2; *(f32x4_t*)(p.out + (size_t)r * D_MODEL + c + 4) = xb2; } }
    }
#undef LNF_LOAD
}
constexpr int LCH = 64, CCH = 32;
constexpr int NLCH = SEQ / LCH, NCCH = CTX_LEN / CCH, NSEQC = NCCH + NLCH;
constexpr int LRU_UNITS = BATCH * (NLCH + NCCH);
struct LruChunk { int b, row0, ntok, seg0, seglen, sf, sr; };
__device__ __forceinline__ LruChunk lru_chunk(int u) {
    LruChunk k;
    if (u < BATCH * NLCH) { k.b = u / NLCH; const int c = u % NLCH; k.seg0 = k.b * SEQ; k.seglen = SEQ; k.row0 = k.seg0 + c * LCH; k.ntok = LCH; k.sf = NCCH + c; k.sr = NCCH + (NLCH - 1 - c); }
    else { const int q = u - BATCH * NLCH; k.b = q / NCCH; const int c = q % NCCH; k.seg0 = NLAT + k.b * CTX_LEN; k.seglen = CTX_LEN; k.row0 = k.seg0 + c * CCH; k.ntok = CCH; k.sf = c; k.sr = NCCH - 1 - c; }
    return k;
}
__device__ __forceinline__ float* agg_ptr(float* AGG, int b, int dir, int s) { return AGG + (((size_t)b * 2 + dir) * NSEQC + s) * 2 * LRU_W; }

__device__ __forceinline__ void lru_stage_rows(const float* AX, LAS float* Rw, unsigned rw_lds, int row0, int ntok, int seg0, int seglen, int wave, int lane) {
    const int nr = ntok + 3; asm volatile("" : "+v"(lane));
    for (int rr = wave; rr < nr; rr += 8) { const int r = row0 - 1 + rr;
        if (r >= seg0 && r < seg0 + seglen) attn_body::glds16(AX + (size_t)r * LRU_W + 4 * lane, (unsigned)__builtin_amdgcn_readfirstlane(rw_lds + (unsigned)rr * (LRU_W * 4)));
        else *(LAS f32x4_t*)(Rw + rr * LRU_W + 4 * lane) = (f32x4_t){0.f, 0.f, 0.f, 0.f}; }
}
__device__ __forceinline__ void ph_lru1(const P& p, int l, float* AGG, unsigned char* lds, int vcu, int G, int tid) {
    typedef short bf16x8_t __attribute__((ext_vector_type(8)));
    typedef float f32x16_t __attribute__((ext_vector_type(16)));
    constexpr int UST = LRU_W + 8;
    LAS bf16_t* Ub = (LAS bf16_t*)(LAS unsigned char*)lds;
    const int wave = __builtin_amdgcn_readfirstlane(tid >> 6), lane = tid & 63, col = lane & 31, hi = lane >> 5;
    const int n = wave >> 1, dir = wave & 1;
    LAS float* Rw = (LAS float*)((LAS unsigned char*)lds + LCH * UST * 2);
    const unsigned rw_lds = (unsigned)(uintptr_t)lds + (unsigned)(LCH * UST * 2);
    if (vcu < LRU_UNITS) { const LruChunk k0 = lru_chunk(vcu); lru_stage_rows(p.AX, Rw, rw_lds, k0.row0, k0.ntok, k0.seg0, k0.seglen, wave, lane); }
    bf16x8_t Bf[2][2][4];
    {
#pragma unroll
        for (int g = 0; g < 2; ++g) { const float* Wg = (g ? p.rg_wx : p.rg_wa) + ((size_t)(l * 2 + dir) * 4 + n) * LRU_BLK * LRU_BLK;
#pragma unroll
            for (int dh = 0; dh < 2; ++dh)
#pragma unroll
                for (int ks = 0; ks < 4; ++ks) { unsigned w4[4];
#pragma unroll
                    for (int j2 = 0; j2 < 4; ++j2) { const int c0 = 16 * ks + 8 * hi + 2 * j2; w4[j2] = pk2bf(Wg[c0 * LRU_BLK + 32 * dh + col], Wg[(c0 + 1) * LRU_BLK + 32 * dh + col]); }
                    Bf[g][dh][ks] = __builtin_bit_cast(bf16x8_t, (u32x4_t){w4[0], w4[1], w4[2], w4[3]}); } }
    }
    float ba[2], bx[2], nsp8[2];
#pragma unroll
    for (int dh = 0; dh < 2; ++dh) { const int ch = n * LRU_BLK + 32 * dh + col; ba[dh] = p.rg_ba[(l * 2 + dir) * LRU_W + ch]; bx[dh] = p.rg_bx[(l * 2 + dir) * LRU_W + ch];
        nsp8[dh] = -8.0f * __logf(1.f + __expf(-p.rg_lam[(l * 2 + dir) * LRU_W + ch])); }
    const int cch = tid & 255, cpar = tid >> 8;
    const float cw0 = p.conv_w[(l * 4 + 0) * LRU_W + cch], cw1 = p.conv_w[(l * 4 + 1) * LRU_W + cch], cw2 = p.conv_w[(l * 4 + 2) * LRU_W + cch], cw3 = p.conv_w[(l * 4 + 3) * LRU_W + cch], cb = p.conv_b[l * LRU_W + cch];
    for (int u = vcu; u < LRU_UNITS; u += G) {
        const LruChunk k = lru_chunk(u);
        asm volatile("s_waitcnt vmcnt(0)" ::: "memory");
        __syncthreads();
        for (int tt = cpar; tt < k.ntok; tt += 2) { const LAS float* ax = Rw + (tt + 1) * LRU_W + cch;
            Ub[tt * UST + cch] = f2bf(cb + cw0 * ax[-LRU_W] + cw1 * ax[0] + cw2 * ax[LRU_W] + cw3 * ax[2 * LRU_W]); }
        __syncthreads();
        if (u + G < LRU_UNITS) { const LruChunk kn = lru_chunk(u + G); lru_stage_rows(p.AX, Rw, rw_lds, kn.row0, kn.ntok, kn.seg0, kn.seglen, wave, lane); }
        float ap[2] = {1.f, 1.f}, hh[2] = {0.f, 0.f};
        const int nmt = k.ntok / 32;
        for (int im = 0; im < nmt; ++im) { const int mt = dir ? nmt - 1 - im : im;
            f32x16_t acc[2][2];
#pragma unroll
            for (int g = 0; g < 2; ++g)
#pragma unroll
                for (int dh = 0; dh < 2; ++dh) acc[g][dh] = (f32x16_t){0.f, 0.f, 0.f, 0.f, 0.f, 0.f, 0.f, 0.f, 0.f, 0.f, 0.f, 0.f, 0.f, 0.f, 0.f, 0.f};
#pragma unroll
            for (int ks = 0; ks < 4; ++ks) { const bf16x8_t af = *(const LAS bf16x8_t*)(Ub + (mt * 32 + col) * UST + n * LRU_BLK + 16 * ks + 8 * hi);
#pragma unroll
                for (int g = 0; g < 2; ++g)
#pragma unroll
                    for (int dh = 0; dh < 2; ++dh) acc[g][dh] = __builtin_amdgcn_mfma_f32_32x32x16_bf16(af, Bf[g][dh][ks], acc[g][dh], 0, 0, 0); }
#pragma unroll
            for (int dh = 0; dh < 2; ++dh) { const int ch = n * LRU_BLK + 32 * dh + col;
                float GA_[4], GB_[4];
#pragma unroll
                for (int g4 = 0; g4 < 4; ++g4) { float av[4], bv[4];
#pragma unroll
                    for (int i = 0; i < 4; ++i) { const int reg = 4 * g4 + i, tok = mt * 32 + 8 * g4 + 4 * hi + i;
                        const float uc = bf2f(Ub[tok * UST + ch]);
                        const float rg = __builtin_amdgcn_rcpf(1.f + __expf(-(acc[0][dh][reg] + ba[dh]))), ig = __builtin_amdgcn_rcpf(1.f + __expf(-(acc[1][dh][reg] + bx[dh])));
                        const float log_a = nsp8[dh] * rg; const float a = __expf(log_a); const float mult = sqrtf(fmaxf(1.f - __expf(2.f * log_a), 0.f));
                        const float b = mult * ig * uc; av[i] = a; bv[i] = b;
                        const size_t gi = ((size_t)(k.row0 + tok) * 2 + dir) * LRU_W + ch; p.LA[gi] = a; p.LB[gi] = b; }
                    float A_, B_;
                    if (dir == 0) { A_ = av[0]; B_ = bv[0];
#pragma unroll
                        for (int i = 1; i < 4; ++i) { B_ = av[i] * B_ + bv[i]; A_ *= av[i]; } }
                    else { A_ = av[3]; B_ = bv[3];
#pragma unroll
                        for (int i = 2; i >= 0; --i) { B_ = av[i] * B_ + bv[i]; A_ *= av[i]; } }
                    GA_[g4] = A_; GB_[g4] = B_; }
#pragma unroll
                for (int s = 0; s < 8; ++s) { const int q = dir ? 7 - s : s; const int g4 = q >> 1, qh = q & 1;
                    const float oa = __shfl_xor(GA_[g4], 32), ob = __shfl_xor(GB_[g4], 32);
                    const float A_ = (qh == hi) ? GA_[g4] : oa, B_ = (qh == hi) ? GB_[g4] : ob;
                    hh[dh] = A_ * hh[dh] + B_; ap[dh] *= A_; } }
        }
        if (hi == 0) { float* ag = agg_ptr(AGG, k.b, dir, dir ? k.sr : k.sf);
#pragma unroll
            for (int dh = 0; dh < 2; ++dh) { const int ch = n * LRU_BLK + 32 * dh + col; ag[ch] = ap[dh]; ag[LRU_W + ch] = hh[dh]; } }
        __syncthreads();
    }
}
__device__ __forceinline__ void ph_lru2(const P& p, const float* AGG, unsigned char* lds, int vcu, int G, int tid, const int nunits) {
    LAS float* HF = (LAS float*)(LAS unsigned char*)lds;
    const int dir = tid >> 8, ch = tid & 255;
    for (int u = vcu; u < nunits; u += G) {
        const LruChunk k = lru_chunk(u);
        const int me = dir ? k.sr : k.sf;
        const float* ag = AGG + (((size_t)k.b * 2 + dir) * NSEQC) * 2 * LRU_W + ch;
        f32x4_t gq[4][2];
#pragma unroll
        for (int i = 0; i < 4; ++i) { const int it = tid + i * NTHR, tt = it >> 5, c8 = (it & 31) * 8;
            if (tt < k.ntok) { const float* gp = p.GA + (size_t)(k.row0 + tt) * LRU_W + c8; gq[i][0] = *(const f32x4_t*)gp; gq[i][1] = *(const f32x4_t*)(gp + 4); }
            else { gq[i][0] = (f32x4_t){0.f, 0.f, 0.f, 0.f}; gq[i][1] = (f32x4_t){0.f, 0.f, 0.f, 0.f}; } }
        float an[8], bn[8];
#pragma unroll
        for (int q = 0; q < 8; ++q) { const int tt = dir ? k.ntok - 1 - q : q; const size_t gi = ((size_t)(k.row0 + tt) * 2 + dir) * LRU_W + ch; an[q] = p.LA[gi]; bn[q] = p.LB[gi]; }
        float h = 0.f;
        for (int s = 0; s < me; s += 16) { float av[16], hv[16];
#pragma unroll
            for (int q = 0; q < 16; ++q) { const bool ok = s + q < me; const int si = ok ? s + q : me - 1; av[q] = ag[(size_t)si * 2 * LRU_W]; hv[q] = ag[(size_t)si * 2 * LRU_W + LRU_W]; av[q] = ok ? av[q] : 1.f; hv[q] = ok ? hv[q] : 0.f; }
#pragma unroll
            for (int q = 0; q < 16; ++q) h = av[q] * h + hv[q]; }
        for (int i0 = 0; i0 < k.ntok; i0 += 8) { float av[8], bv[8];
#pragma unroll
            for (int q = 0; q < 8; ++q) { av[q] = an[q]; bv[q] = bn[q]; }
            if (i0 + 8 < k.ntok) {
#pragma unroll
                for (int q = 0; q < 8; ++q) { const int tt = dir ? k.ntok - 1 - (i0 + 8 + q) : i0 + 8 + q; const size_t gi = ((size_t)(k.row0 + tt) * 2 + dir) * LRU_W + ch; an[q] = p.LA[gi]; bn[q] = p.LB[gi]; } }
#pragma unroll
            for (int q = 0; q < 8; ++q) { const int tt = dir ? k.ntok - 1 - (i0 + q) : i0 + q; h = av[q] * h + bv[q]; HF[(dir * LCH + tt) * LRU_W + ch] = h; } }
        __syncthreads();
#pragma unroll
        for (int i = 0; i < 4; ++i) { const int it = tid + i * NTHR, tt = it >> 5, c8 = (it & 31) * 8;
            if (tt < k.ntok) { const LAS float* hf = HF + tt * LRU_W + c8; const LAS float* hb = HF + (LCH + tt) * LRU_W + c8;
                const f32x4_t f0 = *(const LAS f32x4_t*)hf, f1 = *(const LAS f32x4_t*)(hf + 4), b0 = *(const LAS f32x4_t*)hb, b1 = *(const LAS f32x4_t*)(hb + 4);
                const f32x4_t y0 = gq[i][0] * (f0 + b0), y1 = gq[i][1] * (f1 + b1);
                u32x4_t w; w.x = pk2bf(y0.x, y0.y); w.y = pk2bf(y0.z, y0.w); w.z = pk2bf(y1.x, y1.y); w.w = pk2bf(y1.z, y1.w);
                *(u32x4_t*)(p.Y + (size_t)(k.row0 + tt) * MIX_W + c8) = w; } }
        __syncthreads();
    }
}
__device__ __forceinline__ void ph_diffcomb(const P& p, int l, int gw, int NGW, int lane) {
    static_assert(DIFF_H == 4, "lane mapping assumes 4 diff heads (8 branch outputs of 64)");
    const float lam = diff_lam(p, l), lam_init = 0.8f - 0.6f * expf(-0.3f * (float)l);
    const int hb = lane >> 3, sub = lane & 7, head = hb >> 1;
    float g[8];
#pragma unroll
    for (int j = 0; j < 8; ++j) g[j] = p.diff_subln_g[l * 64 + sub * 8 + j] * (1.f - lam_init);
    for (int r = gw; r < NROW; r += NGW) {
        const u32x4_t v = *(const u32x4_t*)(p.OD + (size_t)r * ODP + hb * 64 + sub * 8);
        float o[8]; o[0] = __uint_as_float(v.x << 16); o[1] = __uint_as_float(v.x & 0xffff0000u); o[2] = __uint_as_float(v.y << 16); o[3] = __uint_as_float(v.y & 0xffff0000u);
        o[4] = __uint_as_float(v.z << 16); o[5] = __uint_as_float(v.z & 0xffff0000u); o[6] = __uint_as_float(v.w << 16); o[7] = __uint_as_float(v.w & 0xffff0000u);
        float ss = 0.f;
#pragma unroll
        for (int j = 0; j < 8; ++j) { const float o2 = __shfl_down(o[j], 8); o[j] = o[j] - lam * o2; ss += o[j] * o[j]; }
        ss += __shfl_xor(ss, 1); ss += __shfl_xor(ss, 2); ss += __shfl_xor(ss, 4);
        const float rs = 1.0f / sqrtf(ss * (1.f / 64.f) + 1e-6f);
        if ((hb & 1) == 0) { u32x4_t w; w.x = pk2bf(o[0] * rs * g[0], o[1] * rs * g[1]); w.y = pk2bf(o[2] * rs * g[2], o[3] * rs * g[3]); w.z = pk2bf(o[4] * rs * g[4], o[5] * rs * g[5]); w.w = pk2bf(o[6] * rs * g[6], o[7] * rs * g[7]);
            *(u32x4_t*)(p.Y + (size_t)r * MIX_W + LRU_W + GQA_H * 64 + head * 64 + sub * 8) = w; }
    }
}
#define FOR_GID(n) for (long gid = (long)blockIdx.x * NTHR + tid_; gid < (long)(n); gid += (long)gridDim.x * NTHR)
#define GRID_SYNC() do { XcdBarrier b2_ = bar; asm volatile("" : "+s"(b2_.bar), "+s"(b2_.x)); xcd_barrier(b2_); } while (0)
#define CTL_NB_WORD 16384
#define PHASE_P() int tid_ = threadIdx.x; asm volatile("" : "+v"(tid_)); const P& q = p

struct AttnWork { const attn_body::bf16* Qu; const attn_body::bf16* Kh; const attn_body::bf16* Vh; attn_body::bf16* Ou; int nt; };
__device__ __forceinline__ AttnWork attn_decode(const P& p, int b, int vh, int row0, int nt) {
    AttnWork w;
    const int kh = vh < GQA_H ? vh / (GQA_H / GQA_KV) : GQA_KV + (vh - GQA_H);
    const int vv = vh < GQA_H ? vh / (GQA_H / GQA_KV) : GQA_KV + (vh - GQA_H) / 2;
    w.Qu = (const attn_body::bf16*)(p.ZQ + (size_t)row0 * QP + vh * 64);
    w.Kh = (const attn_body::bf16*)(p.ZK + (size_t)b * SKEY * KP + kh * 64);
    w.Vh = (const attn_body::bf16*)(p.ZV + (size_t)b * SKEY * VP + vv * 64);
    if (vh < GQA_H) { w.Ou = (attn_body::bf16*)(p.Y + (size_t)row0 * MIX_W + LRU_W + vh * 64); }
    else { w.Ou = (attn_body::bf16*)(p.OD + (size_t)row0 * ODP + (vh - GQA_H) * 64); }
    w.nt = nt; return w;
}
__device__ __forceinline__ void diffcomb_wave(const P& p, int l, float lam, int row_first, int h, int lane) {
    asm volatile("s_waitcnt vmcnt(0)" ::: "memory");
    const float lam_init = 0.8f - 0.6f * expf(-0.3f * (float)l);
    const int rs = lane >> 5, dp = lane & 31;
    const float g0 = p.diff_subln_g[l * 64 + 2 * dp] * (1.f - lam_init), g1 = p.diff_subln_g[l * 64 + 2 * dp + 1] * (1.f - lam_init);
    unsigned u1[16], u2[16];
#pragma unroll
    for (int it = 0; it < 16; ++it) { const size_t r = (size_t)(row_first + 2 * it + rs);
        u1[it] = __hip_atomic_load((const unsigned*)(p.OD + r * ODP + (2 * h) * 64 + 2 * dp), __ATOMIC_RELAXED, __HIP_MEMORY_SCOPE_AGENT);
        u2[it] = __hip_atomic_load((const unsigned*)(p.OD + r * ODP + (2 * h + 1) * 64 + 2 * dp), __ATOMIC_RELAXED, __HIP_MEMORY_SCOPE_AGENT); }
#pragma unroll
    for (int it = 0; it < 16; ++it) { const size_t r = (size_t)(row_first + 2 * it + rs);
        const float a0 = __uint_as_float(u1[it] << 16) - lam * __uint_as_float(u2[it] << 16), a1 = __uint_as_float(u1[it] & 0xffff0000u) - lam * __uint_as_float(u2[it] & 0xffff0000u);
        const float ss = half32_sum(a0 * a0 + a1 * a1);
        const float rsq = 1.0f / sqrtf(ss * (1.f / 64.f) + 1e-6f);
        *(unsigned*)(p.Y + r * MIX_W + LRU_W + GQA_H * 64 + h * 64 + 2 * dp) = pk2bf(a0 * rsq * g0, a1 * rsq * g1); }
}
__device__ __forceinline__ void attn_one(const P& p, int l, float lam, char* lds, int b, int vh, int row0, int nt, int wid, int lane, const attn_body::bf16* knext = nullptr, const bool kpre = false) {
    const AttnWork w = attn_decode(p, b, vh, row0, nt);
    if (vh < GQA_H) attn_body::attn_unit<8, QP, KP, VP, MIX_W, false, true>(w.Qu, w.Kh, w.Vh, w.Ou, w.nt, lds, knext, kpre);
    else {
        const int* nb = (const int*)p.ctl + CTL_NB_WORD + 64 * l + b * 16 + (vh - GQA_H);
        const float q2 = __int_as_float(__builtin_amdgcn_readfirstlane(nb[0])), k2 = __int_as_float(__builtin_amdgcn_readfirstlane(nb[8]));
        if (sqrtf(q2 * k2) * 1.05f < 64.f) attn_body::attn_unit<8, QP, KP, VP, MIX_W, true, true>(w.Qu, w.Kh, w.Vh, w.Ou, w.nt, lds, knext, kpre);
        else attn_body::attn_unit<8, QP, KP, VP, MIX_W, true, false>(w.Qu, w.Kh, w.Vh, w.Ou, w.nt, lds, knext, kpre);
        if ((vh - GQA_H) & 1) diffcomb_wave(p, l, lam, row0 + wid * 32, (vh - GQA_H) >> 1, lane); }
}
__device__ __forceinline__ void attn_phase_all(const P& p, int l, char* lds, int vcu, int G, int tid, const bool need_ctx) {
    constexpr int NQB = SEQ / 256, NLU = BATCH * NVH * NQB;
    static_assert(NLU % 256 == 0 && NVH == 16 && CTX_LEN == 256, "unit deal");
    const int wid = __builtin_amdgcn_readfirstlane(tid >> 6), lane = tid & 63;
    const float lam = diff_lam(p, l);
    bool kpre = false;
    for (int u = vcu; u < NLU; u += G) { const int i = u / 256, v = u % 256, x = v / 32, j = v % 32; const int b = x / 4, g = x % 4; const int vh = (i == 0) ? 2 * g : (i == 1) ? GQA_H + 2 * g : (i == 2) ? GQA_H + 2 * g + 1 : 2 * g + 1;
        const attn_body::bf16* knext = nullptr;
        if (u + G < NLU) { const int u2 = u + G, i2 = u2 / 256, v2 = u2 % 256, x2 = v2 / 32; const int b2 = x2 / 4, g2 = x2 % 4; const int vh2 = (i2 == 0) ? 2 * g2 : (i2 == 1) ? GQA_H + 2 * g2 : (i2 == 2) ? GQA_H + 2 * g2 + 1 : 2 * g2 + 1;
            knext = attn_decode(p, b2, vh2, b2 * SEQ, SKEY / 64).Kh; }
        attn_one(p, l, lam, lds, b, vh, b * SEQ + j * 256, SKEY / 64, wid, lane, knext, kpre); kpre = knext != nullptr; }
    if (need_ctx) for (int k = 0; k < BATCH * NVH / 2; ++k) if ((k * 16 + 8) % G == vcu) {
#pragma unroll 1
        for (int c = 2 * k; c < 2 * k + 2; ++c) { const int b = c / NVH, vh = c % NVH; attn_one(p, l, lam, lds, b, vh, NLAT + b * CTX_LEN, CTX_LEN / 64, wid, lane); } }
}

__global__ void __launch_bounds__(NTHR, 2) k_mega(P p) {
    extern __shared__ __attribute__((aligned(16))) unsigned char lds[];
    if (threadIdx.x < 4) ((volatile LAS unsigned*)(lds + LDS_MISC))[threadIdx.x] = 0u;
    __syncthreads();
    XcdBarrier bar = xcd_barrier_post(p.ctl, (volatile LAS unsigned*)(lds + LDS_MISC));
    const int G = gridDim.x; const int vcu = (G % 8 == 0) ? ((int)blockIdx.x % 8) * (G / 8) + (int)blockIdx.x / 8 : (int)blockIdx.x;
    const int wave_ = __builtin_amdgcn_readfirstlane((int)threadIdx.x >> 6);
    { PHASE_P(); ph_ada(q, lds, vcu, G, wave_, tid_ & 63); }
    GRID_SYNC();
    { PHASE_P(); ph_mod0(q, vcu * 8 + wave_, G * 8, tid_ & 63); }
    for (int l = 0; l < DEPTH; ++l) {
        const bool need_ctx = l + 1 < DEPTH; const int nrow = need_ctx ? NROW : NLAT;
        { PHASE_P(); ph_cvt(q, l, lds, vcu, G, tid_); }
        GRID_SYNC();
        {
            pg8::DenseOrder S; S.init(p.H, WB_WIN(p.WB[l & 1]), NROW, IN_W, D_MODEL, G, (int)blockIdx.x);
            pg8::EpiInProj E{p.AX, p.GA, p.ZQ, p.ZK, p.ZV, p.q_norm_g + l * 64, p.k_norm_g + l * 64, (int*)p.ctl + CTL_NB_WORD + 64 * l};
            pg8::gemm_phase<pg8::EpiInProj, pg8::DenseOrder, true, true>((LAS unsigned char*)lds, D_MODEL, S, E); }
        GRID_SYNC();
        { PHASE_P(); ph_lru1(q, l, q.HS, lds, vcu, G, tid_); }
        GRID_SYNC();
        { PHASE_P(); ph_lru2(q, q.HS, lds, vcu, G, tid_, need_ctx ? LRU_UNITS : BATCH * NLCH); __syncthreads(); }
        { PHASE_P(); attn_phase_all(q, l, (char*)lds, vcu, G, tid_, need_ctx); }
        GRID_SYNC();
        {
            pg8::DenseOrder S; S.init(p.Y, WB_WOUT(p.WB[l & 1]), nrow, D_MODEL, MIX_W, G, (int)blockIdx.x);
            pg8::EpiBf16Plain E{(bf16_t*)p.YO, D_MODEL};
            pg8::gemm_phase<pg8::EpiBf16Plain, pg8::DenseOrder, true, true>((LAS unsigned char*)lds, MIX_W, S, E); }
        GRID_SYNC();
        { PHASE_P(); ph_lnroute(q, l, lds, vcu * 8 + wave_, G * 8, tid_, tid_ & 63, nrow); }
        GRID_SYNC();
        {
            pg8::MoeOrder S; S.init(p.H, WB_WGU(p.WB[l & 1]), p.cnt + CNT_IDX(l, 0), p.SLOTTOK, 2 * EXP_FF, D_MODEL, true, G, (int)blockIdx.x);
            pg8::EpiSwiGLU E{p.HM};
            pg8::gemm_phase<pg8::EpiSwiGLU, pg8::MoeOrder, true, true>((LAS unsigned char*)lds, D_MODEL, S, E); }
        GRID_SYNC();
        {
            pg8::MoeOrder S; S.init(p.HM, WB_WD(p.WB[l & 1]), p.cnt + CNT_IDX(l, 0), p.SLOTTOK, D_MODEL, EXP_FF, false, G, (int)blockIdx.x);
            pg8::EpiMoeDown E{p.FO, p.TG, p.SLOTTOK, S.pl};
            pg8::gemm_phase<pg8::EpiMoeDown, pg8::MoeOrder, true, true>((LAS unsigned char*)lds, EXP_FF, S, E); }
        GRID_SYNC();
        { PHASE_P(); ph_lnfinal(q, l, vcu * 8 + wave_, G * 8, tid_ & 63, nrow); }
    }
}
extern "C" void kernel_launch(void* const* d_in, const int* in_sizes, int n_in, void* d_out, int out_size, void* d_ws, size_t ws_size, hipStream_t stream) {
    (void)in_sizes; (void)n_in; (void)out_size;
    WsMap m = ws_map();
    if (ws_size < m.total) { fprintf(stderr, "ws too small: %zu < %zu\n", ws_size, m.total); return; }
    static int grid = 0;
    if (!grid) { int dev = 0, cus = 0; (void)hipGetDevice(&dev); (void)hipDeviceGetAttribute(&cus, hipDeviceAttributeMultiprocessorCount, dev);
        if (hipFuncSetAttribute((const void*)k_mega, hipFuncAttributeMaxDynamicSharedMemorySize, LDS_BYTES) != hipSuccess) { fprintf(stderr, "hipFuncSetAttribute failed\n"); grid = -1; return; }
        int per_cu = 0; (void)hipOccupancyMaxActiveBlocksPerMultiprocessor(&per_cu, (const void*)k_mega, NTHR, LDS_BYTES); (void)hipGetLastError();
        if (per_cu < 1) fprintf(stderr, "note: occupancy query says %d\n", per_cu);
        grid = cus; }
    if (grid < 0) return;
    P p; memset(&p, 0, sizeof(p)); fill_inputs(p, d_in, d_out); fill_ws(p, (unsigned char*)d_ws);
    (void)hipMemsetAsync(p.ctl, 0, 1 << 17, stream);
    k_mega<<<dim3(grid), dim3(NTHR), LDS_BYTES, stream>>>(p);
}
```

```cpp
#include <hip/hip_runtime.h>
#include <cstdio>
#include <stdint.h>
#include <math.h>
#include <string.h>

#ifdef CPU_TEST
#define HD inline
#define UNROLL
#else
#define HD __host__ __device__ __forceinline__
#define UNROLL _Pragma("unroll")
#endif
#if defined(__HIP_DEVICE_COMPILE__)
#define LAUNDER_V(x) asm volatile("" : "+v"(x))
#else
#define LAUNDER_V(x) do {} while (0)
#endif

#ifndef D_MODEL
#define D_MODEL 1024
#define BATCH 2
#define SEQ 8192
#define DEPTH 4
#define GRID_W 64
#define CTX_LEN 256
#define LRU_W 256
#define GQA_H 8
#define GQA_KV 2
#define DIFF_H 4
#define EXP_FF 512
#endif
#define LRU_BLK (LRU_W / 4)
#define N_EXP 16
#define CNT_STRIDE 32
#define CNT_IDX(l, e) ((((l) * N_EXP) + (e)) * CNT_STRIDE)
#define OFF_AX 0
#define OFF_AG (LRU_W)
#define OFF_GQ (2 * LRU_W)
#define OFF_GK (OFF_GQ + GQA_H * 64)
#define OFF_GV (OFF_GK + GQA_KV * 64)
#define OFF_DQ (OFF_GV + GQA_KV * 64)
#define OFF_DK (OFF_DQ + DIFF_H * 64)
#define OFF_DV (OFF_DK + DIFF_H * 64)
#define IN_W (OFF_DV + DIFF_H * 64)
#define MIX_W (LRU_W + GQA_H * 64 + DIFF_H * 64)
#define NLAT (BATCH * SEQ)
#define NCTX (BATCH * CTX_LEN)
#define NROW (NLAT + NCTX)
#define SKEY (CTX_LEN + SEQ)
#define NVH (GQA_H + 2 * DIFF_H)
#define NKH (GQA_KV + 2 * DIFF_H)
#define NVV (GQA_KV + DIFF_H)
#define QP (NVH * 64)
#define KP (NKH * 64)
#define VP (NVV * 64)
#define ODP MIX_W
#define GUB (EXP_FF < 128 ? EXP_FF : 128)
#define MOE_TM 256
#define MOE_ROWS (2 * NROW + N_EXP * MOE_TM)
#define DN_ALPHA 1.681792830507429f
#define LOG2E 1.4426950408889634f
#define QS_G (0.125f * LOG2E)
#define QS_D (0.17677669529663687f * LOG2E)

#ifdef EXACT_TEST
typedef float bf16_t;
HD float bf2f(bf16_t h) { return h; }
HD bf16_t f2bf(float f) { return f; }
#else
typedef unsigned short bf16_t;
HD float bf2f(bf16_t h) { unsigned u = ((unsigned)h) << 16; float f; memcpy(&f, &u, 4); return f; }
HD bf16_t f2bf(float f) { unsigned u; memcpy(&u, &f, 4); return (bf16_t)((u + 0x7fffu + ((u >> 16) & 1u)) >> 16); }
#endif

struct P {
    const float *x, *c, *ctx, *c_ctx, *ada_w, *ada_b, *w_in, *conv_w, *conv_b, *rg_wa, *rg_ba, *rg_wx, *rg_bx, *rg_lam,
        *q_norm_g, *k_norm_g, *diff_lambda, *diff_subln_g, *w_out, *ln1_g, *ln1_b, *ln2_g, *ln2_b, *router_w, *router_b,
        *exp_w_gate, *exp_w_up, *exp_w_down;
    float* out;
    unsigned* ctl;
    int* cnt;
    float* MOD;
    bf16_t* WB[2];
    float* XR;
    bf16_t* H;
    float* Z;
    float *LA, *LB, *HS;
    float* YO;
    bf16_t* FO;
    bf16_t *ZQ, *ZK, *ZV;
    float *AX, *GA;
    bf16_t* Y;
    bf16_t* OD;
    float* TG;
    int* SLOTTOK;
    bf16_t* HM;
    float* XRo; bf16_t* Ho; float* TGo; int* SLOTTOKo; int* cnto;
    int pad_[2];
};
#define WB_WIN(wb) (wb)
#define WB_WOUT(wb) ((wb) + (size_t)IN_W * D_MODEL)
#define WB_WGU(wb) (WB_WOUT(wb) + (size_t)D_MODEL * MIX_W)
#define WB_WD(wb) (WB_WGU(wb) + (size_t)N_EXP * 2 * EXP_FF * D_MODEL)
#define WB_ELEMS ((size_t)IN_W * D_MODEL + (size_t)D_MODEL * MIX_W + (size_t)N_EXP * 3 * EXP_FF * D_MODEL)

HD float sigmoidf_(float x) { return 1.f / (1.f + expf(-x)); }
HD float siluf_(float x) { return x / (1.f + expf(-x)); }
HD float gelu_tanhf_(float x) { return 0.5f * x * (1.f + tanhf(0.7978845608028654f * (x + 0.044715f * x * x * x))); }
HD float softplusf_(float x) { return x > 20.f ? x : log1pf(expf(x)); }

HD int row_who(int r) { return r < NLAT ? r / SEQ : BATCH; }
HD int row_kidx(int r) { if (r < NLAT) { int b = r / SEQ, t = r % SEQ; return b * SKEY + CTX_LEN + t; } int q = r - NLAT; int b = q / CTX_LEN, j = q % CTX_LEN; return b * SKEY + j; }
HD int gu_row(int half, int j) { return (j / GUB) * 2 * GUB + half * GUB + (j % GUB); }

HD long n_cvt() { return (long)WB_ELEMS; }
HD void st_cvt(const P& p, int l, long gid) {
    bf16_t* wb = p.WB[l & 1];
    size_t i = (size_t)gid;
    const size_t n_in = (size_t)IN_W * D_MODEL, n_out = (size_t)D_MODEL * MIX_W, n_gu = (size_t)N_EXP * 2 * EXP_FF * D_MODEL;
    if (i < n_in) { int n = (int)(i / D_MODEL), k = (int)(i % D_MODEL); wb[i] = f2bf(p.w_in[((size_t)l * D_MODEL + k) * IN_W + n]); return; }
    i -= n_in;
    if (i < n_out) { int n = (int)(i / MIX_W), k = (int)(i % MIX_W); WB_WOUT(wb)[i] = f2bf(p.w_out[((size_t)l * MIX_W + k) * D_MODEL + n]); return; }
    i -= n_out;
    if (i < n_gu) {
        int e = (int)(i / ((size_t)2 * EXP_FF * D_MODEL)); size_t q = i % ((size_t)2 * EXP_FF * D_MODEL); int r = (int)(q / D_MODEL), k = (int)(q % D_MODEL);
        int t = r / (2 * GUB), w = r % (2 * GUB), half = w / GUB, cc = w % GUB, j = t * GUB + cc;
        const float* src = half ? p.exp_w_up : p.exp_w_gate;
        WB_WGU(wb)[i] = f2bf(src[(((size_t)l * N_EXP + e) * D_MODEL + k) * EXP_FF + j]); return; }
    i -= n_gu;
    { int e = (int)(i / ((size_t)D_MODEL * EXP_FF)); size_t q = i % ((size_t)D_MODEL * EXP_FF); int n = (int)(q / EXP_FF), k = (int)(q % EXP_FF);
      WB_WD(wb)[i] = f2bf(p.exp_w_down[(((size_t)l * N_EXP + e) * EXP_FF + k) * D_MODEL + n]); }
}

HD long n_ada() { return (long)DEPTH * 6 * D_MODEL; }
HD void st_ada(const P& p, long gid) {
    int l = (int)(gid / (6 * D_MODEL)), col = (int)(gid % (6 * D_MODEL));
    float acc[BATCH + 1]; UNROLL for (int w = 0; w <= BATCH; ++w) acc[w] = 0.f;
    const float* W = p.ada_w + (size_t)l * D_MODEL * 6 * D_MODEL + col;
    for (int k = 0; k < D_MODEL; ++k) { float wv = W[(size_t)k * 6 * D_MODEL];
        for (int b = 0; b < BATCH; ++b) acc[b] += siluf_(p.c[b * D_MODEL + k]) * wv;
        acc[BATCH] += siluf_(p.c_ctx[k]) * wv; }
    float bias = p.ada_b[l * 6 * D_MODEL + col];
    UNROLL for (int w = 0; w <= BATCH; ++w) p.MOD[((size_t)l * 3 + w) * 6 * D_MODEL + col] = acc[w] + bias;
}
HD const float* modp(const P& p, int l, int who, int chunk) { return p.MOD + ((size_t)l * 3 + who) * 6 * D_MODEL + chunk * D_MODEL; }

HD long n_mod0() { return (long)NROW * D_MODEL; }
HD void st_mod0(const P& p, long gid) {
    int r = (int)(gid / D_MODEL), cc = (int)(gid % D_MODEL); int who = row_who(r);
    float v = r < NLAT ? p.x[(size_t)r * D_MODEL + cc] : p.ctx[(size_t)(r - NLAT) * D_MODEL + cc];
    p.XR[gid] = v;
    p.H[gid] = f2bf(v * (1.f + modp(p, 0, who, 1)[cc]) + modp(p, 0, who, 0)[cc]);
}

HD void dot4x4(const bf16_t* const a[4], const bf16_t* const b[4], int K, float acc[4][4]) {
    UNROLL for (int i = 0; i < 4; ++i) UNROLL for (int j = 0; j < 4; ++j) acc[i][j] = 0.f;
    for (int k = 0; k < K; k += 4) {
        float av[4][4], bv[4][4];
        UNROLL for (int i = 0; i < 4; ++i) UNROLL for (int q = 0; q < 4; ++q) { av[i][q] = bf2f(a[i][k + q]); bv[i][q] = bf2f(b[i][k + q]); }
        UNROLL for (int i = 0; i < 4; ++i) UNROLL for (int j = 0; j < 4; ++j) UNROLL for (int q = 0; q < 4; ++q) acc[i][j] += av[i][q] * bv[j][q];
    }
}
HD long n_gemm_in() { return (long)(NROW / 4) * (IN_W / 4); }
HD void st_gemm_in(const P& p, int l, long gid) {
    int m0 = (int)(gid / (IN_W / 4)) * 4, n0 = (int)(gid % (IN_W / 4)) * 4;
    const bf16_t* wb = WB_WIN(p.WB[l & 1]); const bf16_t *a[4], *b[4];
    UNROLL for (int i = 0; i < 4; ++i) { a[i] = p.H + (size_t)(m0 + i) * D_MODEL; b[i] = wb + (size_t)(n0 + i) * D_MODEL; }
    float acc[4][4]; dot4x4(a, b, D_MODEL, acc);
    UNROLL for (int i = 0; i < 4; ++i) UNROLL for (int j = 0; j < 4; ++j) p.Z[(size_t)(m0 + i) * IN_W + n0 + j] = acc[i][j];
}
HD long n_gemm_out() { return (long)(NROW / 4) * (D_MODEL / 4); }
HD void st_gemm_out(const P& p, int l, long gid) {
    int m0 = (int)(gid / (D_MODEL / 4)) * 4, n0 = (int)(gid % (D_MODEL / 4)) * 4;
    const bf16_t* wb = WB_WOUT(p.WB[l & 1]); const bf16_t *a[4], *b[4];
    UNROLL for (int i = 0; i < 4; ++i) { a[i] = p.Y + (size_t)(m0 + i) * MIX_W; b[i] = wb + (size_t)(n0 + i) * MIX_W; }
    float acc[4][4]; dot4x4(a, b, MIX_W, acc);
    UNROLL for (int i = 0; i < 4; ++i) UNROLL for (int j = 0; j < 4; ++j) p.YO[(size_t)(m0 + i) * D_MODEL + n0 + j] = acc[i][j];
}

HD void rope_cs(int t, int i, int nfreq, float& cs, float& sn) {
    int rowp = t / GRID_W, colp = t % GRID_W;
    float pos = (float)(i < nfreq ? rowp : colp); int j = i % nfreq;
    float inv = exp2f(-(float)j / (float)nfreq * 13.287712379549449f);
    float ang = pos * inv;
#if defined(__HIP_DEVICE_COMPILE__)
    cs = __cosf(ang); sn = __sinf(ang);
#else
    cs = cosf(ang); sn = sinf(ang);
#endif
}
HD long n_post() { return (long)NROW * (IN_W / 64); }
HD void st_post(const P& p, int l, long gid) {
    int r = (int)(gid / (IN_W / 64)), job = (int)(gid % (IN_W / 64)); int c0 = job * 64;
    const float* z = p.Z + (size_t)r * IN_W + c0;
    bool lat = r < NLAT; int t = lat ? r % SEQ : 0; int kidx = row_kidx(r);
    float v[64]; UNROLL for (int d = 0; d < 64; ++d) v[d] = z[d];
    unsigned zz_ = 0; LAUNDER_V(zz_); const bf16_t zz = (bf16_t)zz_;
    if (c0 < OFF_AG) { UNROLL for (int d = 0; d < 64; ++d) p.AX[(size_t)r * LRU_W + c0 + d] = v[d]; return; }
    if (c0 < OFF_GQ) { UNROLL for (int d = 0; d < 64; ++d) p.GA[(size_t)r * LRU_W + (c0 - OFF_AG) + d] = gelu_tanhf_(v[d]); return; }
    if (c0 < OFF_GV) {
        bool isq = c0 < OFF_GK; int h = isq ? (c0 - OFF_GQ) / 64 : (c0 - OFF_GK) / 64;
        const float* g = (isq ? p.q_norm_g : p.k_norm_g) + l * 64;
        float ss = 0.f; UNROLL for (int d = 0; d < 64; ++d) ss += v[d] * v[d];
        float rs = 1.0f / sqrtf(ss / 64.f + 1e-6f);
        UNROLL for (int d = 0; d < 64; ++d) v[d] = v[d] * rs * g[d];
        if (lat) UNROLL for (int i = 0; i < 32; ++i) { float cs, sn; rope_cs(t, i, 16, cs, sn); float x0 = v[2 * i], x1 = v[2 * i + 1]; v[2 * i] = x0 * cs - x1 * sn; v[2 * i + 1] = x0 * sn + x1 * cs; }
        if (isq) { UNROLL for (int d = 0; d < 64; ++d) p.ZQ[(size_t)r * QP + h * 64 + d] = f2bf(v[d] * QS_G); }
        else { UNROLL for (int d = 0; d < 64; ++d) p.ZK[(size_t)kidx * KP + h * 64 + d] = f2bf(v[d]); }
        return; }
    if (c0 < OFF_DQ) { int h = (c0 - OFF_GV) / 64; UNROLL for (int d = 0; d < 64; ++d) p.ZV[(size_t)kidx * VP + h * 64 + d] = f2bf(v[d]); return; }
    if (c0 < OFF_DV) {
        bool isq = c0 < OFF_DK; int h = isq ? (c0 - OFF_DQ) / 64 : (c0 - OFF_DK) / 64;
        UNROLL for (int m = 0; m < 2; ++m) {
            float* w = v + m * 32;
            if (lat) UNROLL for (int i = 0; i < 16; ++i) { float cs, sn; rope_cs(t, i, 8, cs, sn); float x0 = w[2 * i], x1 = w[2 * i + 1]; w[2 * i] = x0 * cs - x1 * sn; w[2 * i + 1] = x0 * sn + x1 * cs; }
            if (isq) { bf16_t* o = p.ZQ + (size_t)r * QP + (GQA_H + 2 * h + m) * 64; UNROLL for (int d = 0; d < 32; ++d) { o[d] = f2bf(w[d] * QS_D); o[32 + d] = zz; } }
            else { bf16_t* o = p.ZK + (size_t)kidx * KP + (GQA_KV + 2 * h + m) * 64; UNROLL for (int d = 0; d < 32; ++d) { o[d] = f2bf(w[d]); o[32 + d] = zz; } }
        }
        return; }
    { int h = (c0 - OFF_DV) / 64; UNROLL for (int d = 0; d < 64; ++d) p.ZV[(size_t)kidx * VP + (GQA_KV + h) * 64 + d] = f2bf(v[d]); }
}

HD float conv_u(const P& p, int l, int r, int ch) {
    int base, pos, len;
    if (r < NLAT) { base = (r / SEQ) * SEQ; pos = r % SEQ; len = SEQ; } else { int q = r - NLAT; base = NLAT + (q / CTX_LEN) * CTX_LEN; pos = q % CTX_LEN; len = CTX_LEN; }
    float y = p.conv_b[l * LRU_W + ch];
    UNROLL for (int k = 0; k < 4; ++k) { int pp = pos + k - 1; if (pp >= 0 && pp < len) y += p.AX[(size_t)(base + pp) * LRU_W + ch] * p.conv_w[(l * 4 + k) * LRU_W + ch]; }
    return y;
}
HD long n_lru_ab() { return (long)NROW * 2 * LRU_W; }
HD void st_lru_ab(const P& p, int l, long gid) {
    int r = (int)(gid / (2 * LRU_W)), dir = (int)((gid / LRU_W) % 2), ch = (int)(gid % LRU_W);
    int n = ch / LRU_BLK, d = ch % LRU_BLK;
    const float* wa = p.rg_wa + ((size_t)(l * 2 + dir) * 4 + n) * LRU_BLK * LRU_BLK;
    const float* wx = p.rg_wx + ((size_t)(l * 2 + dir) * 4 + n) * LRU_BLK * LRU_BLK;
    float sa = 0.f, sx = 0.f, uc = 0.f;
    for (int c = 0; c < LRU_BLK; ++c) { float u = conv_u(p, l, r, n * LRU_BLK + c); if (c == d) uc = u; sa += u * wa[c * LRU_BLK + d]; sx += u * wx[c * LRU_BLK + d]; }
    float rg = sigmoidf_(sa + p.rg_ba[(l * 2 + dir) * LRU_W + ch]), ig = sigmoidf_(sx + p.rg_bx[(l * 2 + dir) * LRU_W + ch]);
    float log_a = -8.0f * rg * softplusf_(-p.rg_lam[(l * 2 + dir) * LRU_W + ch]);
    float a = expf(log_a), mult = sqrtf(-expm1f(2.f * log_a));
    p.LA[gid] = a; p.LB[gid] = mult * (ig * uc);
}
HD long n_lru_scan() { return (long)BATCH * 2 * LRU_W; }
HD void st_lru_scan(const P& p, long gid) {
    int b = (int)(gid / (2 * LRU_W)), dir = (int)((gid / LRU_W) % 2), ch = (int)(gid % LRU_W);
    float h = 0.f;
    for (int s = 0; s < SKEY; ++s) {
        int r;
        if (dir == 0) r = s < CTX_LEN ? NLAT + b * CTX_LEN + s : b * SEQ + (s - CTX_LEN);
        else r = s < CTX_LEN ? NLAT + b * CTX_LEN + (CTX_LEN - 1 - s) : b * SEQ + (SEQ - 1 - (s - CTX_LEN));
        size_t i = ((size_t)r * 2 + dir) * LRU_W + ch;
        h = p.LA[i] * h + p.LB[i]; p.HS[i] = h;
    }
}

HD long n_att() { return (long)NROW * NVH; }
HD void st_att(const P& p, long gid) {
    int vh = (int)(gid / NROW), r = (int)(gid % NROW);
    int b = r < NLAT ? r / SEQ : (r - NLAT) / CTX_LEN; int nk = r < NLAT ? SKEY : CTX_LEN;
    int kh = vh < GQA_H ? vh / (GQA_H / GQA_KV) : GQA_KV + (vh - GQA_H);
    int vv = vh < GQA_H ? vh / (GQA_H / GQA_KV) : GQA_KV + (vh - GQA_H) / 2;
    float q[64], o[64]; UNROLL for (int d = 0; d < 64; ++d) { q[d] = bf2f(p.ZQ[(size_t)r * QP + vh * 64 + d]); o[d] = 0.f; }
    float m = -1e30f, lsum = 0.f;
    const bf16_t* K = p.ZK + (size_t)b * SKEY * KP + kh * 64; const bf16_t* V = p.ZV + (size_t)b * SKEY * VP + vv * 64;
    for (int j = 0; j < nk; ++j) {
        float s = 0.f; UNROLL for (int d = 0; d < 64; ++d) s += q[d] * bf2f(K[(size_t)j * KP + d]);
        if (s > m) { float f = exp2f(m - s); lsum *= f; UNROLL for (int d = 0; d < 64; ++d) o[d] *= f; m = s; }
        float pr = exp2f(s - m); lsum += pr;
        UNROLL for (int d = 0; d < 64; ++d) o[d] += pr * bf2f(V[(size_t)j * VP + d]);
    }
    float inv = 1.f / lsum;
    if (vh < GQA_H) { UNROLL for (int d = 0; d < 64; ++d) p.Y[(size_t)r * MIX_W + LRU_W + vh * 64 + d] = f2bf(o[d] * inv); }
    else { UNROLL for (int d = 0; d < 64; ++d) p.OD[(size_t)r * ODP + (vh - GQA_H) * 64 + d] = f2bf(o[d] * inv); }
}

HD float diff_lam(const P& p, int l) {
    const float* dl = p.diff_lambda + l * 4 * 32; float s0 = 0.f, s1 = 0.f;
    UNROLL for (int i = 0; i < 32; ++i) { s0 += dl[i] * dl[32 + i]; s1 += dl[64 + i] * dl[96 + i]; }
    float lam_init = 0.8f - 0.6f * expf(-0.3f * (float)l);
    return expf(s0) - expf(s1) + lam_init;
}
HD long n_yasm() { return (long)NROW * (LRU_W / 64 + DIFF_H); }
HD void st_yasm(const P& p, int l, long gid) {
    const int NJ = LRU_W / 64 + DIFF_H; int r = (int)(gid / NJ), job = (int)(gid % NJ);
    if (job < LRU_W / 64) {
        UNROLL for (int d = 0; d < 64; ++d) { int ch = job * 64 + d;
            float h = p.HS[((size_t)r * 2 + 0) * LRU_W + ch] + p.HS[((size_t)r * 2 + 1) * LRU_W + ch];
            p.Y[(size_t)r * MIX_W + ch] = f2bf(p.GA[(size_t)r * LRU_W + ch] * h); }
        return; }
    int h = job - LRU_W / 64; float lam = diff_lam(p, l); float lam_init = 0.8f - 0.6f * expf(-0.3f * (float)l);
    float o[64], ss = 0.f;
    UNROLL for (int d = 0; d < 64; ++d) { o[d] = bf2f(p.OD[(size_t)r * ODP + (2 * h) * 64 + d]) - lam * bf2f(p.OD[(size_t)r * ODP + (2 * h + 1) * 64 + d]); ss += o[d] * o[d]; }
    float rs = 1.0f / sqrtf(ss / 64.f + 1e-6f);
    UNROLL for (int d = 0; d < 64; ++d) p.Y[(size_t)r * MIX_W + LRU_W + GQA_H * 64 + h * 64 + d] = f2bf(o[d] * rs * p.diff_subln_g[l * 64 + d] * (1.f - lam_init));
}

#ifdef CPU_TEST
HD int atomic_inc(int* p_) { int v; _Pragma("omp atomic capture") { v = *p_; *p_ += 1; } return v; }
#else
__device__ __forceinline__ int atomic_inc(int* p_) { return atomicAdd(p_, 1); }
#endif
HD void route_select(const float (&lg)[N_EXP], const float* router_b, int& e1, int& e2, float& gw1, float& gw2) {
    float mx = lg[0]; UNROLL for (int e = 1; e < N_EXP; ++e) mx = fmaxf(mx, lg[e]);
    float pr[N_EXP], sum = 0.f; UNROLL for (int e = 0; e < N_EXP; ++e) { pr[e] = expf(lg[e] - mx); sum += pr[e]; }
    float inv = 1.f / sum;
    UNROLL for (int e = 0; e < N_EXP; ++e) pr[e] *= inv;
    float bs = -1e30f; e1 = 0; e2 = 1; float bp1 = 0.f, bp2 = 0.f;
    UNROLL for (int g = 0; g < 4; ++g) {
        float s1 = -1e30f, p1 = 0.f; int i1 = 0;
        UNROLL for (int i = 0; i < 4; ++i) { float sv = pr[g * 4 + i] + router_b[g * 4 + i]; if (sv > s1) { s1 = sv; i1 = i; p1 = pr[g * 4 + i]; } }
        float s2 = -1e30f, p2 = 0.f; int i2 = 0;
        UNROLL for (int i = 0; i < 4; ++i) { float sv = pr[g * 4 + i] + router_b[g * 4 + i]; if (i != i1 && sv > s2) { s2 = sv; i2 = i; p2 = pr[g * 4 + i]; } }
        float sc = s1 + s2;
        if (sc > bs) { bs = sc; e1 = g * 4 + i1; e2 = g * 4 + i2; bp1 = p1; bp2 = p2; } }
    float ws = bp1 + bp2; gw1 = bp1 / ws; gw2 = bp2 / ws;
}
HD long n_lnroute() { return (long)NROW; }
HD void st_lnroute(const P& p, int l, long gid) {
    int r = (int)gid, who = row_who(r);
    float* xr = p.XR + (size_t)r * D_MODEL; const float* yo = p.YO + (size_t)r * D_MODEL;
    const float *g1 = modp(p, l, who, 2), *sh2 = modp(p, l, who, 3), *sc2 = modp(p, l, who, 4);
    float mu = 0.f; for (int c = 0; c < D_MODEL; ++c) mu += DN_ALPHA * xr[c] + g1[c] * yo[c];
    mu /= D_MODEL; float var = 0.f;
    for (int c = 0; c < D_MODEL; ++c) { float t = DN_ALPHA * xr[c] + g1[c] * yo[c] - mu; var += t * t; }
    float rstd = 1.0f / sqrtf(var / D_MODEL + 1e-6f);
    float lg[N_EXP]; UNROLL for (int e = 0; e < N_EXP; ++e) lg[e] = 0.f;
    for (int c = 0; c < D_MODEL; ++c) {
        float t = DN_ALPHA * xr[c] + g1[c] * yo[c];
        float x1 = (t - mu) * rstd * p.ln1_g[l * D_MODEL + c] + p.ln1_b[l * D_MODEL + c];
        xr[c] = x1; float h2 = x1 * (1.f + sc2[c]) + sh2[c]; p.H[(size_t)r * D_MODEL + c] = f2bf(h2);
        UNROLL for (int e = 0; e < N_EXP; ++e) lg[e] += h2 * p.router_w[c * N_EXP + e]; }
    int e1, e2; float gw1, gw2; route_select(lg, p.router_b, e1, e2, gw1, gw2);
    p.TG[r * 2 + 0] = gw1; p.TG[r * 2 + 1] = gw2;
    int s1 = atomic_inc(p.cnt + CNT_IDX(l, e1)); p.SLOTTOK[(size_t)e1 * NROW + s1] = r * 2 + 0;
    int s2 = atomic_inc(p.cnt + CNT_IDX(l, e2)); p.SLOTTOK[(size_t)e2 * NROW + s2] = r * 2 + 1;
}

HD bool moe_row(const P& p, int l, int i, int& e, int& tok2) {
    int off = 0;
    UNROLL for (int q = 0; q < N_EXP; ++q) { int c = p.cnt[CNT_IDX(l, q)]; int pc = (c + MOE_TM - 1) / MOE_TM * MOE_TM;
        if (i < off + pc) { e = q; int s = i - off; if (s >= c) return false; tok2 = p.SLOTTOK[(size_t)q * NROW + s]; return true; }
        off += pc; }
    return false;
}
HD long n_moe_up() { return (long)MOE_ROWS * (EXP_FF / 4); }
HD void st_moe_up(const P& p, int l, long gid) {
    int i = (int)(gid / (EXP_FF / 4)), j0 = (int)(gid % (EXP_FF / 4)) * 4; int e, tok2;
    if (!moe_row(p, l, i, e, tok2)) return;
    const bf16_t* a = p.H + (size_t)(tok2 >> 1) * D_MODEL; const bf16_t* W = WB_WGU(p.WB[l & 1]) + (size_t)e * 2 * EXP_FF * D_MODEL;
    for (int j = j0; j < j0 + 4; ++j) {
        const bf16_t* wg = W + (size_t)gu_row(0, j) * D_MODEL; const bf16_t* wu = W + (size_t)gu_row(1, j) * D_MODEL;
        float g = 0.f, u = 0.f; for (int k = 0; k < D_MODEL; ++k) { float av = bf2f(a[k]); g += av * bf2f(wg[k]); u += av * bf2f(wu[k]); }
        p.HM[(size_t)i * EXP_FF + j] = f2bf(siluf_(g) * u); }
}
HD long n_moe_down() { return (long)MOE_ROWS * (D_MODEL / 4); }
HD void st_moe_down(const P& p, int l, long gid) {
    int i = (int)(gid / (D_MODEL / 4)), n0 = (int)(gid % (D_MODEL / 4)) * 4; int e, tok2;
    if (!moe_row(p, l, i, e, tok2)) return;
    const bf16_t* a = p.HM + (size_t)i * EXP_FF; const bf16_t* W = WB_WD(p.WB[l & 1]) + (size_t)e * D_MODEL * EXP_FF;
    float gate = p.TG[tok2];
    for (int n = n0; n < n0 + 4; ++n) { const bf16_t* w = W + (size_t)n * EXP_FF; float acc = 0.f; for (int k = 0; k < EXP_FF; ++k) acc += bf2f(a[k]) * bf2f(w[k]);
        p.FO[(size_t)tok2 * D_MODEL + n] = f2bf(acc * gate); }
}

HD long n_lnfinal() { return (long)NROW; }
HD void st_lnfinal(const P& p, int l, long gid) {
    int r = (int)gid, who = row_who(r);
    float* xr = p.XR + (size_t)r * D_MODEL; const bf16_t* f0 = p.FO + (size_t)(r * 2) * D_MODEL; const bf16_t* f1 = f0 + D_MODEL;
    const float* g2 = modp(p, l, who, 5);
    float mu = 0.f; for (int c = 0; c < D_MODEL; ++c) mu += DN_ALPHA * xr[c] + g2[c] * (bf2f(f0[c]) + bf2f(f1[c]));
    mu /= D_MODEL; float var = 0.f;
    for (int c = 0; c < D_MODEL; ++c) { float t = DN_ALPHA * xr[c] + g2[c] * (bf2f(f0[c]) + bf2f(f1[c])) - mu; var += t * t; }
    float rstd = 1.0f / sqrtf(var / D_MODEL + 1e-6f);
    for (int c = 0; c < D_MODEL; ++c) {
        float t = DN_ALPHA * xr[c] + g2[c] * (bf2f(f0[c]) + bf2f(f1[c]));
        float x2 = (t - mu) * rstd * p.ln2_g[l * D_MODEL + c] + p.ln2_b[l * D_MODEL + c];
        xr[c] = x2;
        if (l + 1 < DEPTH) p.H[(size_t)r * D_MODEL + c] = f2bf(x2 * (1.f + modp(p, l + 1, who, 1)[c]) + modp(p, l + 1, who, 0)[c]);
        else if (r < NLAT) p.out[(size_t)r * D_MODEL + c] = x2; }
}
#define NPH_PRE 2
#define NPH_LAYER 11
#define NPH_TOTAL (NPH_PRE + DEPTH * NPH_LAYER)

#define RUN_PHASE(IDX, N, CALL) do { if ((IDX) >= ph_lo && (IDX) < ph_hi) { FOR_GID(N) { CALL; } PHASE_END(); } } while (0)

#define PHASE_PROGRAM(p, ph_lo, ph_hi) do { \
    RUN_PHASE(0, n_ada(), st_ada(p, gid)); \
    RUN_PHASE(1, n_mod0(), st_mod0(p, gid)); \
    for (int l = 0; l < DEPTH; ++l) { const int pb = NPH_PRE + l * NPH_LAYER; \
        RUN_PHASE(pb + 0, n_cvt(), st_cvt(p, l, gid)); \
        RUN_PHASE(pb + 1, n_gemm_in(), st_gemm_in(p, l, gid)); \
        RUN_PHASE(pb + 2, n_post(), st_post(p, l, gid)); \
        RUN_PHASE(pb + 3, n_lru_ab(), st_lru_ab(p, l, gid)); \
        RUN_PHASE(pb + 4, n_lru_scan() + n_att(), { if (gid < n_lru_scan()) st_lru_scan(p, gid); else st_att(p, gid - n_lru_scan()); }); \
        RUN_PHASE(pb + 5, n_yasm(), st_yasm(p, l, gid)); \
        RUN_PHASE(pb + 6, n_gemm_out(), st_gemm_out(p, l, gid)); \
        RUN_PHASE(pb + 7, n_lnroute(), st_lnroute(p, l, gid)); \
        RUN_PHASE(pb + 8, n_moe_up(), st_moe_up(p, l, gid)); \
        RUN_PHASE(pb + 9, n_moe_down(), st_moe_down(p, l, gid)); \
        RUN_PHASE(pb + 10, n_lnfinal(), st_lnfinal(p, l, gid)); \
    } } while (0)

struct WsMap { size_t ctl, mod, wb0, wb1, xr, h, u, zq, zk, zv, ax, ga, y, od, tg, slottok, hm, total; };
static inline size_t al256(size_t v) { return (v + 255) & ~(size_t)255; }
static inline WsMap ws_map() {
    WsMap m; size_t o = 0;
    m.ctl = o; o += al256(1 << 20);
    m.mod = o; o += al256((size_t)DEPTH * 3 * 6 * D_MODEL * 4);
    m.wb0 = o; o += al256(WB_ELEMS * sizeof(bf16_t));
    m.wb1 = o; o += al256(WB_ELEMS * sizeof(bf16_t));
    m.xr = o; o += al256((size_t)NROW * D_MODEL * 4);
    m.h = o; o += al256((size_t)NROW * D_MODEL * sizeof(bf16_t));
    size_t usz = (size_t)NROW * IN_W * 4; size_t u2 = (size_t)NROW * 2 * LRU_W * 4 * 3; if (u2 > usz) usz = u2; size_t u3 = (size_t)NROW * D_MODEL * 4 + (size_t)NROW * 2 * D_MODEL * sizeof(bf16_t); if (u3 > usz) usz = u3;
    m.u = o; o += al256(usz);
    m.zq = o; o += al256((size_t)NROW * QP * sizeof(bf16_t));
    m.zk = o; o += al256((size_t)BATCH * SKEY * KP * sizeof(bf16_t));
    m.zv = o; o += al256((size_t)BATCH * SKEY * VP * sizeof(bf16_t));
    m.ax = o; o += al256((size_t)NROW * LRU_W * 4);
    m.ga = o; o += al256((size_t)NROW * LRU_W * 4);
    m.y = o; o += al256((size_t)NROW * MIX_W * sizeof(bf16_t));
    m.od = o; o += al256((size_t)NROW * ODP * sizeof(bf16_t));
    m.tg = o; o += al256((size_t)NROW * 2 * 4);
    m.slottok = o; o += al256((size_t)N_EXP * NROW * 4);
    m.hm = o; o += al256((size_t)MOE_ROWS * EXP_FF * sizeof(bf16_t));
    m.total = o; return m;
}
#define CTL_CNT_WORD 8192
static inline void fill_ws(P& p, unsigned char* ws) {
    WsMap m = ws_map();
    p.ctl = (unsigned*)(ws + m.ctl); p.cnt = (int*)(p.ctl + CTL_CNT_WORD);
    p.MOD = (float*)(ws + m.mod); p.WB[0] = (bf16_t*)(ws + m.wb0); p.WB[1] = (bf16_t*)(ws + m.wb1);
    p.XR = (float*)(ws + m.xr); p.H = (bf16_t*)(ws + m.h);
    p.Z = (float*)(ws + m.u);
    p.LA = (float*)(ws + m.u); p.LB = p.LA + (size_t)NROW * 2 * LRU_W; p.HS = p.LB + (size_t)NROW * 2 * LRU_W;
    p.YO = (float*)(ws + m.u); p.FO = (bf16_t*)(ws + m.u + (size_t)NROW * D_MODEL * 4);
    p.ZQ = (bf16_t*)(ws + m.zq); p.ZK = (bf16_t*)(ws + m.zk); p.ZV = (bf16_t*)(ws + m.zv);
    p.AX = (float*)(ws + m.ax); p.GA = (float*)(ws + m.ga); p.Y = (bf16_t*)(ws + m.y); p.OD = (bf16_t*)(ws + m.od);
    p.TG = (float*)(ws + m.tg); p.SLOTTOK = (int*)(ws + m.slottok); p.HM = (bf16_t*)(ws + m.hm); p.XRo = p.XR; p.Ho = p.H; p.TGo = p.TG; p.SLOTTOKo = p.SLOTTOK; p.cnto = p.cnt; p.pad_[0] = 0; p.pad_[1] = 0;
}
static inline void fill_inputs(P& p, void* const* d_in, void* d_out) {
    const float** f = (const float**)d_in;
    p.x = f[0]; p.c = f[1]; p.ctx = f[2]; p.c_ctx = f[3]; p.ada_w = f[4]; p.ada_b = f[5]; p.w_in = f[6]; p.conv_w = f[7]; p.conv_b = f[8];
    p.rg_wa = f[9]; p.rg_ba = f[10]; p.rg_wx = f[11]; p.rg_bx = f[12]; p.rg_lam = f[13]; p.q_norm_g = f[14]; p.k_norm_g = f[15];
    p.diff_lambda = f[16]; p.diff_subln_g = f[17]; p.w_out = f[18]; p.ln1_g = f[19]; p.ln1_b = f[20]; p.ln2_g = f[21]; p.ln2_b = f[22];
    p.router_w = f[23]; p.router_b = f[24]; p.exp_w_gate = f[25]; p.exp_w_up = f[26]; p.exp_w_down = f[27]; p.out = (float*)d_out;
}
constexpr int NTHR = 512;
constexpr int LDS_RING = 131072;
constexpr int LDS_BYTES = 147456;
constexpr int LDS_MISC = LDS_RING;
constexpr int LDS_EPI = LDS_RING + 256;
template <int CTRL> __device__ __forceinline__ float dpp_mov(float v) { return __builtin_bit_cast(float, __builtin_amdgcn_update_dpp(0, __builtin_bit_cast(int, v), CTRL, 0xf, 0xf, true)); }
#define DPP_XOR1 0xB1
#define DPP_XOR2 0x4E
#define DPP_HMIR 0x141
#define DPP_MIR  0x140
__device__ __forceinline__ float swap16_sum(float v) { auto rr = __builtin_amdgcn_permlane16_swap(__float_as_uint(v), __float_as_uint(v), false, false); return __uint_as_float(rr[0]) + __uint_as_float(rr[1]); }
__device__ __forceinline__ float swap32_sum(float v) { auto rr = __builtin_amdgcn_permlane32_swap(__float_as_uint(v), __float_as_uint(v), false, false); return __uint_as_float(rr[0]) + __uint_as_float(rr[1]); }
__device__ __forceinline__ float swap16_max(float v) { auto rr = __builtin_amdgcn_permlane16_swap(__float_as_uint(v), __float_as_uint(v), false, false); return fmaxf(__uint_as_float(rr[0]), __uint_as_float(rr[1])); }
__device__ __forceinline__ float swap32_max(float v) { auto rr = __builtin_amdgcn_permlane32_swap(__float_as_uint(v), __float_as_uint(v), false, false); return fmaxf(__uint_as_float(rr[0]), __uint_as_float(rr[1])); }
__device__ __forceinline__ float row16_sum(float v) { v += dpp_mov<DPP_XOR1>(v); v += dpp_mov<DPP_XOR2>(v); v += dpp_mov<DPP_HMIR>(v); v += dpp_mov<DPP_MIR>(v); return v; }
__device__ __forceinline__ float half32_sum(float v) { return swap16_sum(row16_sum(v)); }
__device__ __forceinline__ float wave_sum(float v) { return swap32_sum(swap16_sum(row16_sum(v))); }
__device__ __forceinline__ float xor32_get(float v, bool upper) { auto rr = __builtin_amdgcn_permlane32_swap(__float_as_uint(v), __float_as_uint(v), false, false); return __uint_as_float(upper ? rr[0] : rr[1]); }
#define XB_TMO      128
#define XB_XCNT(j)  (256  + 64 * (j))
#define XB_XSUB(j)  (1280 + 64 * (j))
#define XB_XGEN(j)  (2304 + 64 * (j))
#define XB_TOP      3328
#define XB_TOPGEN   3392
#define XCD_BAR_WORDS 3456
#define XB_SPIN_CAP (1u << 21)
#define LAS __attribute__((address_space(3)))

__device__ __forceinline__ unsigned xb_ld(unsigned* p)              { return __hip_atomic_load(p, __ATOMIC_RELAXED, __HIP_MEMORY_SCOPE_AGENT); }
__device__ __forceinline__ unsigned xb_add(unsigned* p, unsigned v) { return __hip_atomic_fetch_add(p, v, __ATOMIC_RELAXED, __HIP_MEMORY_SCOPE_AGENT); }
__device__ __forceinline__ unsigned xb_xcc_id() { return (unsigned)__builtin_amdgcn_s_getreg((3 << 11) | 20) & 0xFu; }
#define XB_SPIN(cond, bar) do { unsigned _sp = 0; while (cond) { __builtin_amdgcn_s_sleep(1); \
    if ((++_sp & 255u) == 0u) { if (xb_ld(&(bar)[XB_TMO])) break; if (_sp > XB_SPIN_CAP) { atomicAdd(&(bar)[XB_TMO], 1u); break; } } } } while (0)

struct XcdBarrier {
    unsigned* bar; unsigned x;
    volatile LAS unsigned* st;
};

__device__ __forceinline__ XcdBarrier xcd_barrier_post(unsigned* bar, volatile LAS unsigned* st) {
    XcdBarrier b; b.bar = bar; b.x = xb_xcc_id(); b.st = st;
    if (threadIdx.x == 0) (void)xb_add(&bar[XB_XCNT(b.x)], 1u);
    return b;
}
__device__ __forceinline__ void xcd_barrier_complete(unsigned* bar, unsigned x, unsigned& nloc, unsigned& nx) {
    const unsigned G = gridDim.x * gridDim.y * gridDim.z;
    unsigned sum, cnt, mine, sp = 0u;
    for (;;) {
        sum = 0u; cnt = 0u; mine = 0u;
#pragma unroll
        for (unsigned j = 0; j < 16; ++j) { const unsigned c = xb_ld(&bar[XB_XCNT(j)]); sum += c; cnt += (c > 0u) ? 1u : 0u; mine = (j == x) ? c : mine; }
        if (sum == G) break;
        __builtin_amdgcn_s_sleep(1);
        if ((++sp & 255u) == 0u) { if (xb_ld(&bar[XB_TMO])) break; if (sp > XB_SPIN_CAP) { atomicAdd(&bar[XB_TMO], 1u); break; } }
    }
    nloc = mine > 0u ? mine : 1u; nx = cnt > 0u ? cnt : 1u;
}

__device__ __forceinline__ void xcd_barrier(const XcdBarrier& b) {
    asm volatile("s_waitcnt vmcnt(0)" ::: "memory");
    __syncthreads();
    if (threadIdx.x == 0) {
        unsigned* bar = b.bar;
        __builtin_amdgcn_s_waitcnt(0);
        unsigned nloc = b.st[0], nx = b.st[1];
        if (nloc == 0u) { xcd_barrier_complete(bar, b.x, nloc, nx); b.st[0] = nloc; b.st[1] = nx; }
        const unsigned old = xb_add(&bar[XB_XSUB(b.x)], 1u);
        const unsigned gen = old / nloc;
        if (old + 1u == (gen + 1u) * nloc) {
            __builtin_amdgcn_fence(__ATOMIC_RELEASE, "agent");
            asm volatile("s_waitcnt vmcnt(0)" ::: "memory");
            const unsigned og = xb_add(&bar[XB_TOP], 1u);
            const unsigned tg = og / nx;
            __builtin_amdgcn_fence(__ATOMIC_ACQUIRE, "agent");
            if (og + 1u != (tg + 1u) * nx) XB_SPIN(xb_ld(&bar[XB_TOP]) < (tg + 1u) * nx, bar);
            xb_add(&bar[XB_XGEN(b.x)], 1u);
            asm volatile("s_waitcnt vmcnt(0)" ::: "memory");
        } else {
            __builtin_amdgcn_fence(__ATOMIC_ACQUIRE, "agent");
            XB_SPIN(xb_ld(&bar[XB_XGEN(b.x)]) == gen, bar);
            asm volatile("s_waitcnt vmcnt(0)" ::: "memory");
        }
    }
    __syncthreads();
}

#include <hip/hip_bf16.h>
#include <cmath>
namespace attn_body {
using bf16=__hip_bfloat16;
using bf16x8=__attribute__((ext_vector_type(8)))short;
using s16x4=__attribute__((ext_vector_type(4)))short;
using f32x16=__attribute__((ext_vector_type(16)))float;
using u32x4=__attribute__((ext_vector_type(4)))unsigned;
constexpr int D=64;
constexpr int NW=8,QBLK=32,QB=QBLK*NW,KVBLK=64;
constexpr int ATTN_UNIT_ROWS=QB;
__device__ __forceinline__ int crow(int r,int hi){return (r&3)+8*(r>>2)+4*hi;}
#define SBAR() __builtin_amdgcn_sched_barrier(0)
__device__ __forceinline__ void cmask(f32x16&p0,f32x16&p1,int jb,int qrel,int hi){
  const float NEG=-INFINITY; int kb=64*jb+4*hi;
  #pragma unroll
  for(int r=0;r<16;++r){int kv=kb+(r&3)+8*(r>>2); if(kv>qrel)p0[r]=NEG; if(kv+32>qrel)p1[r]=NEG;}
}

constexpr int NSLOT=3, SLOTB=8192;
constexpr int LDS_K=0, LDS_V=NSLOT*SLOTB, LDS_WS=2*NSLOT*SLOTB, LDS_OST=LDS_WS+NW*64*4, LDS_BYTES=LDS_OST+NW*4096;
constexpr float C2=0.125f*1.4426950408889634f;
__device__ __forceinline__ void glds16(const void*gsrc,unsigned lds_dst){unsigned keep;
  asm volatile("s_mov_b32 %0, m0\n\ts_mov_b32 m0, %2\n\ts_nop 0\n\tglobal_load_lds_dwordx4 %1, off\n\ts_mov_b32 m0, %0":"=&s"(keep):"v"(gsrc),"s"(lds_dst):"memory");}
__device__ __forceinline__ float max3f(float a,float b,float c){float r;asm("v_max3_f32 %0, %1, %2, %3":"=v"(r):"v"(a),"v"(b),"v"(c));return r;}
__device__ __forceinline__ float max2f(float a,float b){float r;asm("v_max_f32_e32 %0, %1, %2":"=v"(r):"v"(a),"v"(b));return r;}
__device__ __forceinline__ float fadd_s(float a,float b){float r;asm("v_add_f32_e32 %0, %1, %2":"=v"(r):"v"(a),"v"(b));return r;}
__device__ __forceinline__ float fsub_s(float a,float b){float r;asm("v_sub_f32_e32 %0, %1, %2":"=v"(r):"v"(a),"v"(b));return r;}
typedef float f32x2_t __attribute__((ext_vector_type(2))); typedef __bf16 bf16x2_t __attribute__((ext_vector_type(2)));
__device__ __forceinline__ unsigned cvtpk_s(float lo,float hi){f32x2_t v={lo,hi};bf16x2_t b=__builtin_convertvector(v,bf16x2_t);return __builtin_bit_cast(unsigned,b);}
#define WAIT_BAR(N) asm volatile("s_waitcnt vmcnt(" #N ") lgkmcnt(0)\n\ts_barrier":::"memory")

template<int ND> __device__ __forceinline__ void qkt(f32x16&p0,f32x16&p1,const char*Kslot,const bf16x8*qr,const f32x16&negm,int r32,int hi){
  const char*kb=Kslot+hi*1024+r32*16;
  #pragma unroll
  for(int d0=0;d0<ND;++d0){
    const bf16x8 b0=*reinterpret_cast<const bf16x8*>(kb+d0*2048);
    const bf16x8 b1=*reinterpret_cast<const bf16x8*>(kb+d0*2048+512);
    if(d0==0){p0=__builtin_amdgcn_mfma_f32_32x32x16_bf16(b0,qr[0],negm,0,0,0);p1=__builtin_amdgcn_mfma_f32_32x32x16_bf16(b1,qr[0],negm,0,0,0);}
    else{p0=__builtin_amdgcn_mfma_f32_32x32x16_bf16(b0,qr[d0],p0,0,0,0);p1=__builtin_amdgcn_mfma_f32_32x32x16_bf16(b1,qr[d0],p1,0,0,0);}}
}
typedef __attribute__((address_space(3))) const char* lds_cptr;
typedef short v4i16_t __attribute__((ext_vector_type(4)));
__device__ __forceinline__ void kload8(bf16x8*kf,lds_cptr kp){
  kf[0]=*(const __attribute__((address_space(3))) bf16x8*)(kp);      kf[1]=*(const __attribute__((address_space(3))) bf16x8*)(kp+512);
  kf[2]=*(const __attribute__((address_space(3))) bf16x8*)(kp+2048); kf[3]=*(const __attribute__((address_space(3))) bf16x8*)(kp+2560);
  kf[4]=*(const __attribute__((address_space(3))) bf16x8*)(kp+4096); kf[5]=*(const __attribute__((address_space(3))) bf16x8*)(kp+4608);
  kf[6]=*(const __attribute__((address_space(3))) bf16x8*)(kp+6144); kf[7]=*(const __attribute__((address_space(3))) bf16x8*)(kp+6656);
}
__device__ __forceinline__ void kload2(bf16x8*kf,lds_cptr kp,int j){ kf[2*j]=*(const __attribute__((address_space(3))) bf16x8*)(kp+j*2048); kf[2*j+1]=*(const __attribute__((address_space(3))) bf16x8*)(kp+j*2048+512); }
__device__ __forceinline__ s16x4 vtr(lds_cptr p){ return __builtin_bit_cast(s16x4,__builtin_amdgcn_ds_read_tr16_b64_v4i16((__attribute__((address_space(3))) v4i16_t*)p)); }
__device__ __forceinline__ float rowmax(const f32x16&p0,const f32x16&p1){
  float a=max3f(p0[0],p0[1],p1[0]),b=max3f(p0[2],p0[3],p1[1]);a=max3f(a,p1[2],p1[3]);
  #pragma unroll
  for(int r=4;r<16;r+=4){a=max3f(a,p0[r],p0[r+1]);b=max3f(b,p0[r+2],p0[r+3]);a=max3f(a,p1[r],p1[r+1]);b=max3f(b,p1[r+2],p1[r+3]);}
  const float m=max2f(a,b);
  auto rr=__builtin_amdgcn_permlane32_swap(__float_as_uint(m),__float_as_uint(m),false,false);
  return max2f(__uint_as_float(rr[0]),__uint_as_float(rr[1]));
}
__device__ __forceinline__ void pv(f32x16*o,int vb,bf16x8 pa0,bf16x8 pa1,bf16x8 pa2,bf16x8 pa3){
  #pragma unroll
  for(int d0=0;d0<2;++d0){s16x4 lo[4],hi[4];
    #pragma unroll
    for(int ks=0;ks<4;++ks){
      asm volatile("ds_read_b64_tr_b16 %0,%1 offset:%c2":"=&v"(lo[ks]):"v"(vb),"i"(d0*4096+ks*1024):"memory");
      asm volatile("ds_read_b64_tr_b16 %0,%1 offset:%c2":"=&v"(hi[ks]):"v"(vb),"i"(d0*4096+ks*1024+512):"memory");}
    asm volatile("s_waitcnt lgkmcnt(0)":::"memory");SBAR();
    #define PK(k) (bf16x8){lo[k][0],lo[k][1],lo[k][2],lo[k][3],hi[k][0],hi[k][1],hi[k][2],hi[k][3]}
    o[d0]=__builtin_amdgcn_mfma_f32_32x32x16_bf16(pa0,PK(0),o[d0],0,0,0);
    o[d0]=__builtin_amdgcn_mfma_f32_32x32x16_bf16(pa1,PK(1),o[d0],0,0,0);
    o[d0]=__builtin_amdgcn_mfma_f32_32x32x16_bf16(pa2,PK(2),o[d0],0,0,0);
    o[d0]=__builtin_amdgcn_mfma_f32_32x32x16_bf16(pa3,PK(3),o[d0],0,0,0);
    #undef PK
  }
}

#ifndef ATTN_STORE16
#define ATTN_STORE16(p,v) (*(u32x4*)(p)=(v))
#endif
template<int THRL,int QPITCH,int KPITCH,int VPITCH,int OPITCH,bool HALFK,bool NOMAX> __device__ __forceinline__ void attn_unit(const bf16*Qu,const bf16*__restrict__ Kh,const bf16*__restrict__ Vh,bf16*Ou,const int NT,char*shm,const bf16*Knext=nullptr,const bool kpre=false){
  int tid_l=threadIdx.x; asm volatile("":"+v"(tid_l)); const int tid=tid_l,lane=tid&63,r32=lane&31,hi=lane>>5; const int wid=__builtin_amdgcn_readfirstlane(tid>>6);
  const bf16*Qw=Qu+(long)(wid*QBLK)*QPITCH;
  const unsigned lds0=(unsigned)(uintptr_t)shm;
  float*wsf=(float*)(shm+LDS_WS)+wid*64;
  const bf16*ksrc=Kh+(long)lane*KPITCH+wid*8;
  const bf16*vsrc=Vh+(long)(16*(wid&3)+(lane>>2))*VPITCH+(wid>>2)*32+(lane&3)*8;
  const unsigned kdst=lds0+LDS_K+wid*1024, vdst=lds0+LDS_V+wid*1024;
  #define DMA_K(t,slot) glds16(ksrc+(long)(t)*KVBLK*KPITCH,(unsigned)__builtin_amdgcn_readfirstlane(kdst+(slot)))
  #define DMA_V(t,slot) glds16(vsrc+(long)(t)*KVBLK*VPITCH,(unsigned)__builtin_amdgcn_readfirstlane(vdst+(slot)))
  const int vb0=(int)(lds0+LDS_V)+((lane>>4)&1)*32+(lane&3)*8+(4*hi+((lane&15)>>2))*64;
  const char*Kbase=shm+LDS_K; bf16x8 kf[8];
  const lds_cptr shm3=(lds_cptr)shm; const lds_cptr kp0=shm3+LDS_K+hi*1024+r32*16; const lds_cptr vp0=shm3+LDS_V+((lane>>4)&1)*32+(lane&3)*8+(4*hi+((lane&15)>>2))*64;
  if(!kpre){DMA_K(0,0);DMA_V(0,0);DMA_K(1,SLOTB);}
  bf16x8 qr[4];
  #pragma unroll
  for(int d0=0;d0<4;++d0)qr[d0]=*reinterpret_cast<const bf16x8*>(&Qw[(long)r32*QPITCH+d0*16+hi*8]);
  float mhat=0.f,l_reg=0.f;f32x16 o[2];o[0]=f32x16{};o[1]=f32x16{};f32x16 negm=f32x16{};asm volatile("":"+v"(negm));
  #define CMASK(P0,P1,t) do{}while(0)
  bool resc=false;
  #define START(P0,P1) do{ resc=false; \
    if constexpr(!NOMAX){ const float rm=rowmax(P0,P1); const float dl=rm; mhat=fadd_s(mhat,dl); \
      _Pragma("unroll") for(int r=0;r<16;++r){P0[r]=fsub_s(P0[r],dl);P1[r]=fsub_s(P1[r],dl);} \
      _Pragma("unroll") for(int r=0;r<16;++r)negm[r]=-mhat; asm volatile("":"+v"(negm)); } \
    _Pragma("unroll") for(int r=0;r<16;++r)P0[r]=__builtin_amdgcn_exp2f(P0[r]); }while(0)
  #define RESC() do{ if(resc){ asm volatile("s_waitcnt lgkmcnt(0)":::"memory"); \
      _Pragma("unroll") for(int d_=0;d_<2;++d_) _Pragma("unroll") for(int r=0;r<16;++r)o[d_][r]*=wsf[crow(r,hi)]; } }while(0)
  f32x16 pA0,pA1,pB0,pB1;
  int sl_prev=0,sl_cur=0,sl_next=SLOTB;
  #define ROT() do{sl_prev=sl_cur;sl_cur=sl_next;sl_next=(sl_next==(NSLOT-1)*SLOTB)?0:sl_next+SLOTB;}while(0)
  if(!kpre){ DMA_K(2,2*SLOTB);
    WAIT_BAR(3); }
  else{ DMA_V(0,0); WAIT_BAR(1); }
  qkt<(HALFK?2:4)>(pA0,pA1,Kbase,qr,negm,r32,hi);asm volatile("s_nop 15\n\ts_nop 7":"+v"(pA0),"+v"(pA1));CMASK(pA0,pA1,0);
  START(pA0,pA1);
  _Pragma("unroll") for(int r=0;r<16;++r)pA1[r]=__builtin_amdgcn_exp2f(pA1[r]);
  WAIT_BAR(0);
  DMA_K(3,0);DMA_V(1,SLOTB);
  ROT();
  if constexpr(HALFK){kload2(kf,kp0+sl_cur,0);kload2(kf,kp0+sl_cur,1);}else kload8(kf,kp0+sl_cur);
  WAIT_BAR(2);
  s16x4 vlo[8],vhi[8]; u32x4 pw0,pw1,pw2,pw3;
  #define PKW(P,B) cvtpk_s(P[B],P[B+1])
  #define PAF(k) __builtin_bit_cast(bf16x8,pw##k)
  #define VFR(i) (bf16x8){vlo[i][0],vlo[i][1],vlo[i][2],vlo[i][3],vhi[i][0],vhi[i][1],vhi[i][2],vhi[i][3]}
  #define PIN(x) asm volatile("":"+v"(x))
  #define MX3(a,b,c) __builtin_fmaxf(__builtin_fmaxf((a),(b)),(c))
  #define GAPA(MF,A0,A1,A2,A3,W0,W1,PW) do{ MF; sacc+=A0; sacc+=A1; sacc+=A2; sacc+=A3; PIN(sacc); W0; W1; PIN(PW); SBAR(); }while(0)
  #define EX(v) __builtin_amdgcn_exp2f(v)
  #define GAPB(MF,X,B) do{ MF; X[B]=EX(X[B]); X[B+1]=EX(X[B+1]); X[B+2]=EX(X[B+2]); X[B+3]=EX(X[B+3]); PIN(X); SBAR(); }while(0)
  #define VRD(i) do{ vlo[i]=vtr(vp_+(((i)>>2)*4096+((i)&3)*1024)); vhi[i]=vtr(vp_+(((i)>>2)*4096+((i)&3)*1024+512)); }while(0)
  #define KRD(G,j) do{ if(G){ kload2(kf,kp0+sl_next,j); SBAR(); } }while(0)
  #define STEP(C0,C1,P0,P1,t,GK,GV,GL) do{ SBAR(); \
    const lds_cptr vp_=vp0+sl_prev; \
    VRD(0); SBAR(); float sacc=(P0[0]+P0[1]); \
    GAPA(C0=__builtin_amdgcn_mfma_f32_32x32x16_bf16(kf[0],qr[0],negm,0,0,0), P0[2],P0[3],P0[4],P0[5],     pw0[0]=PKW(P0,0), pw0[1]=PKW(P0,2), pw0); \
    VRD(4); SBAR(); GAPA(C1=__builtin_amdgcn_mfma_f32_32x32x16_bf16(kf[1],qr[0],negm,0,0,0), P0[6],P0[7],P0[8],P0[9],     pw0[2]=PKW(P0,4), pw0[3]=PKW(P0,6), pw0); \
    VRD(1); SBAR(); GAPA(C0=__builtin_amdgcn_mfma_f32_32x32x16_bf16(kf[2],qr[1],C0,0,0,0),   P0[10],P0[11],P0[12],P0[13], pw1[0]=PKW(P0,8), pw1[1]=PKW(P0,10), pw1); \
    VRD(5); SBAR(); GAPA(C1=__builtin_amdgcn_mfma_f32_32x32x16_bf16(kf[3],qr[1],C1,0,0,0),   P0[14],P0[15],P1[0],P1[1],   pw1[2]=PKW(P0,12),pw1[3]=PKW(P0,14), pw1); \
    VRD(2); SBAR(); GAPA(if constexpr(!HALFK)C0=__builtin_amdgcn_mfma_f32_32x32x16_bf16(kf[4],qr[2],C0,0,0,0),   P1[2],P1[3],P1[4],P1[5],     pw2[0]=PKW(P1,0), pw2[1]=PKW(P1,2), pw2); \
    VRD(6); SBAR(); GAPA(if constexpr(!HALFK)C1=__builtin_amdgcn_mfma_f32_32x32x16_bf16(kf[5],qr[2],C1,0,0,0),   P1[6],P1[7],P1[8],P1[9],     pw2[2]=PKW(P1,4), pw2[3]=PKW(P1,6), pw2); \
    VRD(3); SBAR(); GAPA(if constexpr(!HALFK)C0=__builtin_amdgcn_mfma_f32_32x32x16_bf16(kf[6],qr[3],C0,0,0,0),   P1[10],P1[11],P1[12],P1[13], pw3[0]=PKW(P1,8), pw3[1]=PKW(P1,10), pw3); \
    VRD(7); SBAR(); GAPA(if constexpr(!HALFK)C1=__builtin_amdgcn_mfma_f32_32x32x16_bf16(kf[7],qr[3],C1,0,0,0),   P1[14],P1[15],0.f,0.f,       pw3[2]=PKW(P1,12),pw3[3]=PKW(P1,14), pw3); \
    l_reg+=sacc; \
    if(GK){DMA_K((t)+3,sl_cur);} if(GV){DMA_V((t)+1,sl_next);} \
    CMASK(C0,C1,t); \
    if constexpr(!NOMAX){ float a=MX3(C0[0],C0[1],C1[0]),b=MX3(C0[2],C0[3],C1[1]); a=MX3(a,C1[2],C1[3]); \
      _Pragma("unroll") for(int r=4;r<16;r+=4){a=MX3(a,C0[r],C0[r+1]);b=MX3(b,C0[r+2],C0[r+3]);a=MX3(a,C1[r],C1[r+1]);b=MX3(b,C1[r+2],C1[r+3]);} \
      float rm=__builtin_fmaxf(a,b); { auto rr=__builtin_amdgcn_permlane32_swap(__float_as_uint(rm),__float_as_uint(rm),false,false); rm=__builtin_fmaxf(__uint_as_float(rr[0]),__uint_as_float(rr[1])); } \
      resc=false; \
      if(__builtin_expect(__any(rm>(float)THRL),0)){ const float dl=__builtin_fmaxf(rm,0.f); mhat+=dl; \
        _Pragma("unroll") for(int r=0;r<16;++r){C0[r]-=dl;C1[r]-=dl;} \
        _Pragma("unroll") for(int r=0;r<16;++r)negm[r]=-mhat; asm volatile("":"+v"(negm)); \
        const float f=__builtin_amdgcn_exp2f(-dl); l_reg*=f; if(hi==0)wsf[r32]=f; resc=true; } } \
    SBAR(); \
    GAPB(o[0]=__builtin_amdgcn_mfma_f32_32x32x16_bf16(PAF(0),VFR(0),o[0],0,0,0), C0,0); \
    GAPB(o[1]=__builtin_amdgcn_mfma_f32_32x32x16_bf16(PAF(0),VFR(4),o[1],0,0,0), C0,4); \
    KRD(GL,0); GAPB(o[0]=__builtin_amdgcn_mfma_f32_32x32x16_bf16(PAF(1),VFR(1),o[0],0,0,0), C0,8); \
    KRD(GL,1); GAPB(o[1]=__builtin_amdgcn_mfma_f32_32x32x16_bf16(PAF(1),VFR(5),o[1],0,0,0), C0,12); \
    KRD(GL&&!HALFK,2); GAPB(o[0]=__builtin_amdgcn_mfma_f32_32x32x16_bf16(PAF(2),VFR(2),o[0],0,0,0), C1,0); \
    KRD(GL&&!HALFK,3); GAPB(o[1]=__builtin_amdgcn_mfma_f32_32x32x16_bf16(PAF(2),VFR(6),o[1],0,0,0), C1,4); \
    GAPB(o[0]=__builtin_amdgcn_mfma_f32_32x32x16_bf16(PAF(3),VFR(3),o[0],0,0,0), C1,8); \
    GAPB(o[1]=__builtin_amdgcn_mfma_f32_32x32x16_bf16(PAF(3),VFR(7),o[1],0,0,0), C1,12); \
    }while(0)
  int t=1;
  #undef CMASK
  #define CMASK(P0,P1,t) do{}while(0)
  for(;t+5<NT;t+=2){
    STEP(pB0,pB1,pA0,pA1,t,true,true,true);     WAIT_BAR(2); RESC(); ROT();
    STEP(pA0,pA1,pB0,pB1,t+1,true,true,true);   WAIT_BAR(2); RESC(); ROT();
  }
  #undef CMASK
  #define CMASK(P0,P1,t) do{}while(0)
  #define ENDW(tt) do{ if((tt)+3<NT){WAIT_BAR(2);} else if((tt)+2<NT){WAIT_BAR(1);} else {WAIT_BAR(0);} }while(0)
  for(;t+1<NT;t+=2){
    STEP(pB0,pB1,pA0,pA1,t,(t+3<NT),(t+1<NT),(t+1<NT));       ENDW(t);   RESC(); ROT();
    STEP(pA0,pA1,pB0,pB1,t+1,(t+4<NT),(t+2<NT),(t+2<NT));     ENDW(t+1); RESC(); ROT();
  }
  STEP(pB0,pB1,pA0,pA1,NT-1,false,false,false); RESC();
  if(Knext){ const bf16*kn=Knext+(long)lane*KPITCH+wid*8;
    glds16(kn,(unsigned)__builtin_amdgcn_readfirstlane(kdst)); glds16(kn+(long)KVBLK*KPITCH,(unsigned)__builtin_amdgcn_readfirstlane(kdst+SLOTB)); glds16(kn+(long)2*KVBLK*KPITCH,(unsigned)__builtin_amdgcn_readfirstlane(kdst+2*SLOTB)); }
  { float sacc=pB0[0]+pB0[1]; _Pragma("unroll") for(int r=2;r<16;++r)sacc+=pB0[r]; _Pragma("unroll") for(int r=0;r<16;++r)sacc+=pB1[r]; l_reg+=sacc;
    pw0=(u32x4){PKW(pB0,0),PKW(pB0,2),PKW(pB0,4),PKW(pB0,6)};pw1=(u32x4){PKW(pB0,8),PKW(pB0,10),PKW(pB0,12),PKW(pB0,14)};pw2=(u32x4){PKW(pB1,0),PKW(pB1,2),PKW(pB1,4),PKW(pB1,6)};pw3=(u32x4){PKW(pB1,8),PKW(pB1,10),PKW(pB1,12),PKW(pB1,14)};
    SBAR(); pv(o,vb0+sl_cur,PAF(0),PAF(1),PAF(2),PAF(3)); }
  #undef PKW
  #undef PAF
  #undef VFR
  #undef PIN
  #undef MX3
  #undef GAPA
  #undef GAPB
  #undef EX
  #undef VRD
  #undef KRD
  #undef STEP
  #undef ENDW
  {auto rr=__builtin_amdgcn_permlane32_swap(__float_as_uint(l_reg),__float_as_uint(l_reg),false,false);l_reg=__uint_as_float(rr[0])+__uint_as_float(rr[1]);}
  if(hi==0)wsf[32+r32]=l_reg;asm volatile("s_waitcnt lgkmcnt(0)":::"memory");
  float rli[16];
  #pragma unroll
  for(int r=0;r<16;++r)rli[r]=__builtin_amdgcn_rcpf(wsf[32+crow(r,hi)]);
  bf16*Ow=Ou+(long)(wid*QBLK)*OPITCH;
  { bf16*stg=(bf16*)(shm+LDS_OST)+wid*2048;
    #pragma unroll
    for(int r=0;r<16;++r){const int orow=crow(r,hi);
      #pragma unroll
      for(int d0=0;d0<2;++d0)stg[orow*64+d0*32+r32]=__float2bfloat16(o[d0][r]*rli[r]);}
    asm volatile("s_waitcnt lgkmcnt(0)":::"memory");
    #pragma unroll
    for(int i=0;i<4;++i){const int row=i*8+(lane>>3),ch=lane&7; const u32x4 v=*(const u32x4*)(stg+row*64+ch*8); ATTN_STORE16(Ow+(long)row*OPITCH+ch*8,v);} }
  asm volatile("s_waitcnt lgkmcnt(0)\n\ts_barrier":::"memory");
  #undef DMA_K
  #undef DMA_V
  #undef CMASK
  #undef START
  #undef RESC
  #undef ROT
}
constexpr int ATTN_LDS_BYTES=LDS_BYTES;
#undef SBAR
#undef WAIT_BAR
}
namespace pg8 {
#define PG8_LAS __attribute__((address_space(3)))
typedef unsigned short bf16_t;
typedef short bf16x8 __attribute__((ext_vector_type(8)));
typedef float f32x4 __attribute__((ext_vector_type(4)));
typedef unsigned u32x4 __attribute__((ext_vector_type(4)));
constexpr int BM = 256, BK = 64, HALF = 128, HTB = HALF * BK * 2  , STAGE_BYTES = 8 * HTB, NXCD = 8, WGM = 8;

__host__ __device__ __forceinline__ int lds_byte(int r, int c) { const int st = (r >> 4) * 2 + (c >> 5), rr = r & 15, cc = c & 31, ob = rr * 64 + cc * 2; return st * 1024 + (ob ^ (((ob >> 9) & 1) << 5)); }
__host__ __device__ __forceinline__ void stage_rc(int b, int& R, int& C) { const int st = b / 1024, sb = b % 1024, swz = sb ^ (((sb >> 9) & 1) << 5); R = (st >> 1) * 16 + swz / 64; C = (st & 1) * 32 + (swz % 64) / 2; }
__host__ __device__ __forceinline__ int perm32(int rho) { const int n = rho >> 4, i = rho & 15; return 8 * (i >> 2) + 4 * n + (i & 3); }

struct Unit { int pm, pn, aux; };
__device__ __forceinline__ unsigned cvt_pk_bf16(float lo, float hi) { unsigned r; asm volatile("v_cvt_pk_bf16_f32 %0, %1, %2" : "=v"(r) : "v"(lo), "v"(hi)); return r; }
typedef float f32x2 __attribute__((ext_vector_type(2)));
template <class Epi, class Sched, bool ALIGN_EPI = false, bool SP2 = false>
__device__ __forceinline__ void gemm_phase(PG8_LAS unsigned char* lds, const int K, const Sched& S, const Epi& E) {
    int tid_l = threadIdx.x; asm volatile("" : "+v"(tid_l));
    const int tid = tid_l, wid = __builtin_amdgcn_readfirstlane(tid >> 6), lane = tid & 63, wr = wid >> 2, wc = wid & 3, fr = lane & 15, fq = lane >> 4;
    const int nt = K / BK;
    unsigned voffB[2]; int stR[2], stC[2];
#pragma unroll
    for (int i = 0; i < 2; ++i) { int R, C; stage_rc(tid * 16 + i * 8192, R, C); const int Rb = Epi::PERM ? ((R & ~31) + perm32(R & 31)) : R;
        stR[i] = R; stC[i] = C; voffB[i] = (unsigned)(Rb * K + C) * 2u; }
    const size_t kstep = (size_t)(BK * 2);
    const size_t hstep = (size_t)HALF * K * 2;
    const unsigned ldsw = (unsigned)wid * 1024u;
    const int aoff = lds_byte(wr * 64 + fr, fq * 8), boff = lds_byte(wc * 32 + fr, fq * 8);
#define PG8_SA(b, h) (((b) * 2 + (h)) * HTB)
#define PG8_SB(b, h) ((4 + (b) * 2 + (h)) * HTB)
#define PG8_STAGE(bufoff, gbase, voff) do { _Pragma("unroll") for (int _i = 0; _i < 2; ++_i) \
        __builtin_amdgcn_global_load_lds((const unsigned*)((const char*)(gbase) + (voff)[_i]), (PG8_LAS unsigned*)(lds + (bufoff) + ldsw + _i * 8192), 16, 0, 0); } while (0)
#define PG8_LDA(dst, b, h) do { _Pragma("unroll") for (int m = 0; m < 4; ++m) _Pragma("unroll") for (int k = 0; k < 2; ++k) dst[m][k] = *(const PG8_LAS bf16x8*)(lds + PG8_SA(b, h) + aoff + m * 2048 + k * 1024); } while (0)
#define PG8_LDB(dst, b, h) do { _Pragma("unroll") for (int n = 0; n < 2; ++n) _Pragma("unroll") for (int k = 0; k < 2; ++k) dst[n][k] = *(const PG8_LAS bf16x8*)(lds + PG8_SB(b, h) + boff + n * 2048 + k * 1024); } while (0)
#define PG8_MMA(ai, bj, At, Bt) do { __builtin_amdgcn_s_setprio(1); _Pragma("unroll") for (int m = 0; m < 4; ++m) _Pragma("unroll") for (int n = 0; n < 2; ++n) _Pragma("unroll") for (int k = 0; k < 2; ++k) \
        acc[ai][bj][m][n] = __builtin_amdgcn_mfma_f32_16x16x32_bf16(Bt[n][k], At[m][k], acc[ai][bj][m][n], 0, 0, 0); __builtin_amdgcn_s_setprio(0); } while (0)
#define PG8_WAIT_V(n) asm volatile("s_waitcnt vmcnt(" #n ")" ::: "memory")
#define PG8_WAIT_L(n) asm volatile("s_waitcnt lgkmcnt(" #n ")" ::: "memory")
#define PG8_BAR __builtin_amdgcn_s_barrier()
#define PG8_SCHED __builtin_amdgcn_sched_barrier(0)
    Unit cur, nxt; int ui = 0;
    if (!S.next(0, cur)) return;
    f32x4 acc[2][2][4][2];
#pragma unroll
    for (int a = 0; a < 2; ++a)
#pragma unroll
        for (int b = 0; b < 2; ++b)
#pragma unroll
            for (int m = 0; m < 4; ++m)
#pragma unroll
                for (int n = 0; n < 2; ++n) acc[a][b][m][n] = (f32x4){0.f, 0.f, 0.f, 0.f};
    bf16x8 At[4][2], B0[2][2], B1[2][2];
    const char* cA = S.a_ptr(cur); const char* cB = S.b_ptr(cur);
    unsigned cv0[2], cv1[2]; S.a_offs(cur, stR, stC, cv0, cv1);
    S.a_ready(cur);
    if constexpr (SP2) {
        PG8_STAGE(PG8_SB(0, 0), cB, voffB); PG8_STAGE(PG8_SB(0, 1), cB + hstep, voffB); PG8_STAGE(PG8_SA(0, 0), cA, cv0); PG8_STAGE(PG8_SA(0, 1), cA, cv1);
        if (wr == 1) PG8_BAR;
        PG8_WAIT_V(2); PG8_BAR;
        PG8_STAGE(PG8_SB(1, 0), cB + kstep, voffB); PG8_STAGE(PG8_SA(1, 0), cA + kstep, cv0); PG8_STAGE(PG8_SB(1, 1), cB + hstep + kstep, voffB);
        PG8_WAIT_V(6); PG8_BAR;
    } else {
        PG8_STAGE(PG8_SB(0, 0), cB, voffB); PG8_STAGE(PG8_SA(0, 0), cA, cv0); PG8_STAGE(PG8_SB(0, 1), cB + hstep, voffB); PG8_STAGE(PG8_SA(0, 1), cA, cv1);
        if (wr == 1) PG8_BAR;
        PG8_WAIT_V(4); PG8_BAR;
        PG8_STAGE(PG8_SB(1, 0), cB + kstep, voffB); PG8_STAGE(PG8_SA(1, 0), cA + kstep, cv0); PG8_STAGE(PG8_SB(1, 1), cB + hstep + kstep, voffB);
        PG8_WAIT_V(6); PG8_BAR;
    }
    for (;;) {
        const bool has_next = S.next(ui + 1, nxt);
        const char* nA = has_next ? S.a_ptr(nxt) : cA; const char* nB = has_next ? S.b_ptr(nxt) : cB;
        for (int t = 0; t < nt; t += 2) {
            const bool last = (t == nt - 2);
            const char* a1 = cA + (size_t)(t + 1) * kstep;
            const char* a2 = last ? nA : cA + (size_t)(t + 2) * kstep; const char* b2 = last ? nB : cB + (size_t)(t + 2) * kstep;
            const char* a3 = a2 + kstep; const char* b3 = b2 + kstep;
            unsigned c0_[2], c1[2], x0[2], x1[2];
            { int rr[2] = {stR[0], stR[1]}; asm volatile("" : "+v"(rr[0]), "+v"(rr[1])); Unit cu = cur, xu = (last && has_next) ? nxt : cur; asm volatile("" : "+s"(cu.aux), "+s"(xu.aux));
              S.a_offs(cu, rr, stC, c0_, c1); S.a_offs(xu, rr, stC, x0, x1); }
            if (last && has_next) S.a_ready(nxt);
            if constexpr (SP2) {
            PG8_LDB(B0, 0, 0); PG8_LDB(B1, 0, 1); PG8_SCHED; PG8_LDA(At, 0, 0); PG8_STAGE(PG8_SA(1, 1), a1, c1);
            PG8_WAIT_V(8); PG8_WAIT_L(0); PG8_BAR; PG8_MMA(0, 0, At, B0); PG8_MMA(0, 1, At, B1); PG8_BAR; PG8_SCHED;
            PG8_LDA(At, 0, 1); PG8_STAGE(PG8_SB(0, 0), b2, voffB); PG8_STAGE(PG8_SB(0, 1), b2 + hstep, voffB); PG8_STAGE(PG8_SA(0, 0), a2, x0);
            PG8_WAIT_V(8); PG8_WAIT_L(0); PG8_BAR; PG8_MMA(1, 0, At, B0); PG8_MMA(1, 1, At, B1); PG8_BAR; PG8_SCHED;
            PG8_LDB(B0, 1, 0); PG8_LDB(B1, 1, 1); PG8_SCHED; PG8_LDA(At, 1, 0); PG8_STAGE(PG8_SA(0, 1), a2, x1);
            PG8_WAIT_V(8); PG8_WAIT_L(0); PG8_BAR; PG8_MMA(0, 0, At, B0); PG8_MMA(0, 1, At, B1); PG8_BAR; PG8_SCHED;
            PG8_LDA(At, 1, 1); PG8_STAGE(PG8_SB(1, 0), b3, voffB); PG8_STAGE(PG8_SB(1, 1), b3 + hstep, voffB); PG8_STAGE(PG8_SA(1, 0), a3, x0);
            PG8_WAIT_V(8); PG8_WAIT_L(0); PG8_BAR; PG8_MMA(1, 0, At, B0); PG8_MMA(1, 1, At, B1); PG8_BAR; PG8_SCHED;
            } else {
            PG8_LDB(B0, 0, 0); PG8_SCHED; PG8_LDA(At, 0, 0); PG8_STAGE(PG8_SA(1, 1), a1, c1);
            PG8_WAIT_L(8); PG8_BAR; PG8_WAIT_L(0); PG8_MMA(0, 0, At, B0); PG8_BAR; PG8_SCHED;
            PG8_LDB(B1, 0, 1); PG8_STAGE(PG8_SB(0, 0), b2, voffB);
            PG8_BAR; PG8_WAIT_L(0); PG8_MMA(0, 1, At, B1); PG8_BAR;
            PG8_LDA(At, 0, 1); PG8_STAGE(PG8_SA(0, 0), a2, x0);
            PG8_BAR; PG8_WAIT_L(0); PG8_MMA(1, 0, At, B0); PG8_BAR; PG8_SCHED;
            PG8_STAGE(PG8_SB(0, 1), b2 + hstep, voffB);
            PG8_WAIT_V(6); PG8_BAR; PG8_MMA(1, 1, At, B1); PG8_BAR;
            PG8_LDB(B0, 1, 0); PG8_SCHED; PG8_LDA(At, 1, 0); PG8_STAGE(PG8_SA(0, 1), a2, x1);
            PG8_WAIT_L(8); PG8_BAR; PG8_WAIT_L(0); PG8_MMA(0, 0, At, B0); PG8_BAR; PG8_SCHED;
            PG8_LDB(B1, 1, 1); PG8_STAGE(PG8_SB(1, 0), b3, voffB);
            PG8_BAR; PG8_WAIT_L(0); PG8_MMA(0, 1, At, B1); PG8_BAR;
            PG8_LDA(At, 1, 1); PG8_STAGE(PG8_SA(1, 0), a3, x0);
            PG8_BAR; PG8_WAIT_L(0); PG8_MMA(1, 0, At, B0); PG8_BAR; PG8_SCHED;
            PG8_STAGE(PG8_SB(1, 1), b3 + hstep, voffB);
            PG8_WAIT_V(6); PG8_BAR; PG8_MMA(1, 1, At, B1); PG8_BAR;
            }
        }
        if constexpr (ALIGN_EPI) { if (wr == 0) PG8_BAR; }
        if constexpr (!Epi::AFTER_DRAIN) { E(acc, cur, wr, wc, fr, fq); S.done(cur); }
        if (!has_next) break;
#pragma unroll
        for (int a = 0; a < 2; ++a)
#pragma unroll
            for (int b = 0; b < 2; ++b)
#pragma unroll
                for (int m = 0; m < 4; ++m)
#pragma unroll
                    for (int n = 0; n < 2; ++n) acc[a][b][m][n] = (f32x4){0.f, 0.f, 0.f, 0.f};
        cur = nxt; cA = nA; cB = nB; ++ui;
        if constexpr (ALIGN_EPI) { if (wr == 1) PG8_BAR; }
    }
    PG8_WAIT_V(0);
    if constexpr (!ALIGN_EPI) { if (wr == 0) PG8_BAR; }
    PG8_BAR;
    if constexpr (Epi::AFTER_DRAIN) { E.fused(acc, cur, wr, wc, fr, fq, lds, wid, lane); S.done(cur); }
#undef PG8_SA
#undef PG8_SB
#undef PG8_STAGE
#undef PG8_LDA
#undef PG8_LDB
#undef PG8_MMA
#undef PG8_WAIT_V
#undef PG8_WAIT_L
#undef PG8_BAR
#undef PG8_SCHED
}
}
namespace pg8 {
struct DenseOrder {
    const char* A; const char* Bt; int K; int nM, nN, nwg, G, c;
    __device__ __forceinline__ void init(const void* A_, const void* Bt_, int M, int N, int K_, int G_, int c_) { A = (const char*)A_; Bt = (const char*)Bt_; K = K_; nM = M / BM; nN = N / BM; nwg = nM * nN; G = G_; c = c_; }
    __device__ __forceinline__ bool next(int i, Unit& u) const {
        const long L = (long)i * G + c; if (L >= nwg) return false;
        int wgid = (int)L; { const int q = nwg / NXCD, r = nwg % NXCD, xcd = wgid % NXCD, off = wgid / NXCD; wgid = (xcd < r ? xcd * (q + 1) : r * (q + 1) + (xcd - r) * q) + off; }
        const int nig = WGM * nN, gid = wgid / nig, fm = gid * WGM, gsz = (nM - fm) < WGM ? (nM - fm) : WGM;
        u.pm = fm + ((wgid % nig) % gsz); u.pn = (wgid % nig) / gsz; u.aux = i; return true;
    }
    __device__ __forceinline__ const char* a_ptr(const Unit& u) const { return A + (size_t)u.pm * BM * K * 2; }
    __device__ __forceinline__ const char* b_ptr(const Unit& u) const { return Bt + (size_t)u.pn * BM * K * 2; }
    __device__ __forceinline__ void a_offs(const Unit&, const int (&R)[2], const int (&C)[2], unsigned (&v0)[2], unsigned (&v1)[2]) const {
#pragma unroll
        for (int i = 0; i < 2; ++i) { v0[i] = (unsigned)(R[i] * K + C[i]) * 2u; v1[i] = v0[i] + (unsigned)(HALF * K * 2); } }
    __device__ __forceinline__ void a_ready(const Unit&) const {}
    __device__ __forceinline__ void done(const Unit&) const {}
};
struct EpiF32 {
    static constexpr bool PERM = false, AFTER_DRAIN = false;
    float* C; int ldc;
    __device__ __forceinline__ void operator()(const f32x4 (&acc)[2][2][4][2], const Unit& u, int wr, int wc, int fr, int fq) const {
        const int row0 = u.pm * BM + wr * 64 + fr, col0 = u.pn * BM + wc * 32 + 4 * fq;
#pragma unroll
        for (int ai = 0; ai < 2; ++ai)
#pragma unroll
            for (int m = 0; m < 4; ++m) { float* rowp = C + (size_t)(row0 + ai * HALF + m * 16) * ldc + col0;
#pragma unroll
                for (int bj = 0; bj < 2; ++bj)
#pragma unroll
                    for (int n = 0; n < 2; ++n) *(f32x4*)(rowp + bj * HALF + n * 16) = acc[ai][bj][m][n]; }
    }
};
struct EpiBf16Plain {
    static constexpr bool PERM = true, AFTER_DRAIN = false;
    bf16_t* O; int ldc;
    __device__ __forceinline__ void operator()(const f32x4 (&acc)[2][2][4][2], const Unit& u, int wr, int wc, int fr, int fq) const {
        const int row0 = u.pm * BM + wr * 64 + fr, col0 = u.pn * BM + wc * 32 + 8 * fq;
#pragma unroll
        for (int ai = 0; ai < 2; ++ai)
#pragma unroll
            for (int m = 0; m < 4; ++m) { bf16_t* rowp = O + (size_t)(row0 + ai * HALF + m * 16) * ldc + col0;
#pragma unroll
                for (int bj = 0; bj < 2; ++bj) { const f32x4 v0 = acc[ai][bj][m][0], v1 = acc[ai][bj][m][1];
                    u32x4 w; w.x = cvt_pk_bf16(v0[0], v0[1]); w.y = cvt_pk_bf16(v0[2], v0[3]); w.z = cvt_pk_bf16(v1[0], v1[1]); w.w = cvt_pk_bf16(v1[2], v1[3]);
                    *(u32x4*)(rowp + bj * HALF) = w; } }
    }
};
}
namespace pg8 {
constexpr int MOE_MAXU = 3;
typedef int i32x16 __attribute__((ext_vector_type(16)));
typedef unsigned u32x16 __attribute__((ext_vector_type(16)));
struct MoePlan {
    i32x16 toff, cnt; int TT;
    __device__ __forceinline__ void init(const int* cntp) { int acc = 0;
        int ln = threadIdx.x & 15; asm volatile("" : "+v"(ln));
        const int mine = cntp[ln * CNT_STRIDE];
#pragma unroll
        for (int q = 0; q < N_EXP; ++q) { const int cq = __builtin_amdgcn_readlane(mine, q); cnt[q] = cq; toff[q] = acc; acc += (cq + BM - 1) / BM; }
        TT = acc; }
    __device__ __forceinline__ void decode(int pm, int& e, int& lt, int& ce) const { int ee = 0, base = 0, cc = cnt[0];
#pragma unroll
        for (int q = 1; q < N_EXP; ++q) { const bool ge = pm >= toff[q]; ee = ge ? q : ee; base = ge ? toff[q] : base; cc = ge ? cnt[q] : cc; }
        e = ee; lt = pm - base; ce = cc; }
};
struct MoeOrder {
    const char* A; const char* W; const int* slottok; int K; size_t wexp; int nN, TT, nwg, G, c; bool gather;
    MoePlan pl;
    u32x16 goff;
    __device__ __forceinline__ bool next(int i, Unit& u) const {
        const long L = (long)i * G + c; if (L >= nwg) return false;
        int wgid = (int)L; { const int q = nwg / NXCD, r = nwg % NXCD, xcd = wgid % NXCD, off = wgid / NXCD; wgid = (xcd < r ? xcd * (q + 1) : r * (q + 1) + (xcd - r) * q) + off; }
        const int nig = WGM * nN, gid = wgid / nig, fm = gid * WGM, gsz = (TT - fm) < WGM ? (TT - fm) : WGM;
        u.pm = fm + ((wgid % nig) % gsz); u.pn = (wgid % nig) / gsz; u.aux = i; return true;
    }
    __device__ __forceinline__ void init(const void* A_, const void* W_, const int* cntp, const int* slottok_, int N, int K_, bool gather_, int G_, int c_) {
        A = (const char*)A_; W = (const char*)W_; slottok = slottok_; K = K_; wexp = (size_t)N * K_ * 2; nN = N / BM; G = G_; c = c_; gather = gather_;
        pl.init(cntp); TT = pl.TT; nwg = TT * nN;
        if (gather) {
            int tid_l = threadIdx.x; asm volatile("" : "+v"(tid_l));
            int tkv[MOE_MAXU * 4];
#pragma unroll
            for (int ui = 0; ui < MOE_MAXU; ++ui) { Unit u; u.pm = 0; u.pn = 0; u.aux = 0; const bool ok = next(ui, u); int e, lt, ce; pl.decode(ok ? u.pm : 0, e, lt, ce);
#pragma unroll
                for (int i = 0; i < 2; ++i) { int R, C; stage_rc(tid_l * 16 + i * 8192, R, C);
#pragma unroll
                    for (int h = 0; h < 2; ++h) { int slot = lt * BM + h * HALF + R; if (slot >= ce) slot = 0;
                        tkv[ui * 4 + h * 2 + i] = slottok[(size_t)e * NROW + slot]; } } }
            __builtin_amdgcn_sched_barrier(0);
#pragma unroll
            for (int ui = 0; ui < MOE_MAXU; ++ui) { Unit u; u.pm = 0; u.pn = 0; u.aux = 0; const bool ok = next(ui, u);
#pragma unroll
                for (int i = 0; i < 2; ++i) { int R, C; stage_rc(tid_l * 16 + i * 8192, R, C);
#pragma unroll
                    for (int h = 0; h < 2; ++h) { const int tok2 = ok ? tkv[ui * 4 + h * 2 + i] : 0;
                        goff[ui * 4 + h * 2 + i] = (unsigned)((tok2 >> 1) * K + C) * 2u; } } }
        }
    }
    __device__ __forceinline__ const char* a_ptr(const Unit& u) const { return gather ? A : A + (size_t)u.pm * BM * K * 2; }
    __device__ __forceinline__ const char* b_ptr(const Unit& u) const { int e, lt, ce; pl.decode(u.pm, e, lt, ce); return W + (size_t)e * wexp + (size_t)u.pn * BM * K * 2; }
    __device__ __forceinline__ void a_offs(const Unit& u, const int (&R)[2], const int (&C)[2], unsigned (&v0)[2], unsigned (&v1)[2]) const {
        if (gather) {
#pragma unroll
            for (int i = 0; i < 2; ++i) { unsigned a = goff[i], b = goff[2 + i];
#pragma unroll
                for (int q = 1; q < MOE_MAXU; ++q) { const bool is = (u.aux == q); a = is ? goff[q * 4 + i] : a; b = is ? goff[q * 4 + 2 + i] : b; }
                v0[i] = a; v1[i] = b; }
        } else {
#pragma unroll
            for (int i = 0; i < 2; ++i) { v0[i] = (unsigned)(R[i] * K + C[i]) * 2u; v1[i] = v0[i] + (unsigned)(HALF * K * 2); } }
    }
    __device__ __forceinline__ void a_ready(const Unit&) const {}
    __device__ __forceinline__ void done(const Unit&) const {}
};
struct EpiSwiGLU {
    static constexpr bool PERM = true, AFTER_DRAIN = false;
    bf16_t* HMp;
    __device__ __forceinline__ void operator()(const f32x4 (&acc)[2][2][4][2], const Unit& u, int wr, int wc, int fr, int fq) const {
        const int row0 = u.pm * BM + wr * 64 + fr, col0 = u.pn * HALF + wc * 32 + 8 * fq;
#pragma unroll
        for (int ai = 0; ai < 2; ++ai)
#pragma unroll
            for (int m = 0; m < 4; ++m) { bf16_t* rowp = HMp + (size_t)(row0 + ai * HALF + m * 16) * EXP_FF + col0;
                float h[8];
#pragma unroll
                for (int n = 0; n < 2; ++n)
#pragma unroll
                    for (int j = 0; j < 4; ++j) { const float g = acc[ai][0][m][n][j], uu = acc[ai][1][m][n][j]; h[n * 4 + j] = g * __builtin_amdgcn_rcpf(1.f + __expf(-g)) * uu; }
                u32x4 w; w.x = cvt_pk_bf16(h[0], h[1]); w.y = cvt_pk_bf16(h[2], h[3]); w.z = cvt_pk_bf16(h[4], h[5]); w.w = cvt_pk_bf16(h[6], h[7]);
                *(u32x4*)rowp = w; }
    }
};
__device__ __forceinline__ void moe_down_epi_fill(const MoeOrder& S, const float* TGp, const int* slottok, PG8_LAS int* epi) {
    int tid_l = threadIdx.x; asm volatile("" : "+v"(tid_l));
    int tk[2]; bool vl[2];
#pragma unroll
    for (int k = 0; k < 2; ++k) { const int idx = tid_l + k * 512, ui = idx >> 8, row = idx & 255; Unit u; u.pm = 0; u.pn = 0; u.aux = 0;
        const bool ok = ui < MOE_MAXU && S.next(ui, u); int e, lt, ce; S.pl.decode(ok ? u.pm : 0, e, lt, ce);
        const int slot = lt * BM + row; vl[k] = ok && slot < ce; tk[k] = slottok[(size_t)e * NROW + (slot < ce ? slot : 0)]; }
    __builtin_amdgcn_sched_barrier(0);
    float g[2];
#pragma unroll
    for (int k = 0; k < 2; ++k) g[k] = TGp[tk[k]];
    __builtin_amdgcn_sched_barrier(0);
#pragma unroll
    for (int k = 0; k < 2; ++k) { const int idx = tid_l + k * 512; if ((idx >> 8) < MOE_MAXU) { epi[2 * idx] = vl[k] ? tk[k] : -1; epi[2 * idx + 1] = __float_as_int(g[k]); } }
}
struct EpiMoeDown {
    static constexpr bool PERM = true, AFTER_DRAIN = false;
    bf16_t* FOp; const PG8_LAS int* epi;
    __device__ __forceinline__ void operator()(const f32x4 (&acc)[2][2][4][2], const Unit& u, int wr, int wc, int fr, int fq) const {
        const int col0 = u.pn * BM + wc * 32 + 8 * fq;
        const PG8_LAS int* ep = epi + u.aux * 512 + 2 * (wr * 64 + fr);
#pragma unroll
        for (int ai = 0; ai < 2; ++ai)
#pragma unroll
            for (int m = 0; m < 4; ++m) { const int tok2 = ep[2 * (ai * HALF + m * 16)]; const float gate = __int_as_float(ep[2 * (ai * HALF + m * 16) + 1]);
                if (tok2 >= 0) { bf16_t* rowp = FOp + (size_t)tok2 * D_MODEL + col0;
#pragma unroll
                    for (int bj = 0; bj < 2; ++bj) { const f32x4 v0 = acc[ai][bj][m][0] * gate, v1 = acc[ai][bj][m][1] * gate;
                        u32x4 w; w.x = cvt_pk_bf16(v0[0], v0[1]); w.y = cvt_pk_bf16(v0[2], v0[3]); w.z = cvt_pk_bf16(v1[0], v1[1]); w.w = cvt_pk_bf16(v1[2], v1[3]);
                        *(u32x4*)(rowp + bj * HALF) = w; } } }
    }
};
}
namespace pg8 {
static_assert(IN_W == 8 * BM && LRU_W == BM && GQA_H == 8 && GQA_KV == 2 && DIFF_H == 4 && NLAT % BM == 0 && CTX_LEN == BM, "EpiInProj is written for this problem's column partition");
struct EpiInProj {
    static constexpr bool PERM = true, AFTER_DRAIN = false;
    float* AX; float* GA; bf16_t* ZQ; bf16_t* ZK; bf16_t* ZV; const float* qg; const float* kg;
    int* nb;
    __device__ __forceinline__ void operator()(const f32x4 (&acc)[2][2][4][2], const Unit& u, int wr, int wc, int fr, int fq) const {
        const int pn = u.pn, pm = u.pm;
        const bool lat = pm < NLAT / BM;
        const int b = lat ? pm / (SEQ / BM) : pm - NLAT / BM;
        const int rt0 = wr * 64 + fr;
        const int t0 = lat ? (pm % (SEQ / BM)) * BM : 0;
        const size_t kbase = (size_t)b * SKEY + (lat ? CTX_LEN + t0 : 0);
        const size_t row_base = (size_t)pm * BM;
        if (pn < 2) {
            float* dst = pn == 0 ? AX : GA;
#pragma unroll
            for (int ai = 0; ai < 2; ++ai)
#pragma unroll
                for (int m = 0; m < 4; ++m) { float* rowp = dst + (row_base + rt0 + ai * HALF + m * 16) * LRU_W + wc * 32 + 8 * fq;
#pragma unroll
                    for (int bj = 0; bj < 2; ++bj)
#pragma unroll
                        for (int n = 0; n < 2; ++n) { f32x4 v = acc[ai][bj][m][n];
                            if (pn == 1) {
#pragma unroll
                                for (int j = 0; j < 4; ++j) { const float x = v[j]; const float tt = 0.7978845608028654f * (x + 0.044715f * x * x * x); const float e2 = __expf(2.f * tt); v[j] = x - x * __builtin_amdgcn_rcpf(e2 + 1.f); } }
                            *(f32x4*)(rowp + bj * HALF + n * 4) = v; } }
            return;
        }
        const bool isq_g = (pn == 2 || pn == 3), is4 = (pn == 4), isdq = (pn == 5), isdk = (pn == 6), isdv = (pn == 7);
        const bool norm = isq_g || (is4 && wc < 2);
        const bool rope64 = norm && lat, rope32 = (isdq || isdk) && lat;
        const float* gains = isq_g ? qg : kg;
        float g16[2][8];
        if (norm) {
#pragma unroll
            for (int bj = 0; bj < 2; ++bj)
#pragma unroll
                for (int k = 0; k < 8; ++k) g16[bj][k] = gains[32 * bj + 8 * fq + k];
        }
        float inv[4]; bool usecol32 = false;
#pragma unroll
        for (int pp = 0; pp < 4; ++pp) {
            if (rope64) inv[pp] = exp2f(-(float)(4 * fq + pp) * (13.287712379549449f / 16.f));
            else { const int i = 4 * fq + pp; inv[pp] = exp2f(-(float)(i & 7) * (13.287712379549449f / 8.f)); }
        }
        usecol32 = fq >= 2;
        bf16_t* dbase; int dpitch; bool keyrow; float qs = 1.f; bool pad32 = false;
        if (isq_g) { dbase = ZQ + (4 * (pn - 2) + wc) * 64; dpitch = QP; keyrow = false; qs = QS_G; }
        else if (is4) { if (wc < 2) { dbase = ZK + wc * 64; dpitch = KP; } else { dbase = ZV + (wc - 2) * 64; dpitch = VP; } keyrow = true; }
        else if (isdq) { dbase = ZQ + (GQA_H + 2 * wc) * 64; dpitch = QP; keyrow = false; qs = QS_D; pad32 = true; }
        else if (isdk) { dbase = ZK + (GQA_KV + 2 * wc) * 64; dpitch = KP; keyrow = true; pad32 = true; }
        else { dbase = ZV + (GQA_KV + wc) * 64; dpitch = VP; keyrow = true; }
        (void)isdv;
        float nmx[2] = {0.f, 0.f};
#pragma unroll
        for (int ai = 0; ai < 2; ++ai)
#pragma unroll
            for (int m = 0; m < 4; ++m) {
                const int rin = rt0 + ai * HALF + m * 16;
                float v[2][8];
#pragma unroll
                for (int bj = 0; bj < 2; ++bj)
#pragma unroll
                    for (int n = 0; n < 2; ++n)
#pragma unroll
                        for (int j = 0; j < 4; ++j) v[bj][n * 4 + j] = acc[ai][bj][m][n][j];
                if (norm) { float ss = 0.f;
#pragma unroll
                    for (int bj = 0; bj < 2; ++bj)
#pragma unroll
                        for (int k = 0; k < 8; ++k) ss += v[bj][k] * v[bj][k];
                    ss = swap32_sum(swap16_sum(ss));
                    const float rs = __builtin_amdgcn_rsqf(ss * (1.f / 64.f) + 1e-6f);
#pragma unroll
                    for (int bj = 0; bj < 2; ++bj)
#pragma unroll
                        for (int k = 0; k < 8; ++k) v[bj][k] = v[bj][k] * rs * g16[bj][k]; }
                if (rope64 || rope32) { const int t = t0 + rin; const float prow = (float)(t / GRID_W), pcol = (float)(t % GRID_W);
#pragma unroll
                    for (int bj = 0; bj < 2; ++bj) { const float pos = rope64 ? (bj ? pcol : prow) : (usecol32 ? pcol : prow);
#pragma unroll
                        for (int pp = 0; pp < 4; ++pp) { const float ang = pos * inv[pp]; const float cs = __cosf(ang), sn = __sinf(ang);
                            const float x0 = v[bj][2 * pp], x1 = v[bj][2 * pp + 1]; v[bj][2 * pp] = x0 * cs - x1 * sn; v[bj][2 * pp + 1] = x0 * sn + x1 * cs; } } }
                if (pad32) {
#pragma unroll
                    for (int bj = 0; bj < 2; ++bj) { float ss = 0.f;
#pragma unroll
                        for (int k = 0; k < 8; ++k) ss += (v[bj][k] * qs) * (v[bj][k] * qs);
                        ss = swap32_sum(swap16_sum(ss)); nmx[bj] = fmaxf(nmx[bj], ss); } }
                bf16_t* rowp = dbase + (keyrow ? (kbase + rin) : (row_base + rin)) * (size_t)dpitch;
#pragma unroll
                for (int bj = 0; bj < 2; ++bj) { u32x4 w; w.x = cvt_pk_bf16(v[bj][0] * qs, v[bj][1] * qs); w.y = cvt_pk_bf16(v[bj][2] * qs, v[bj][3] * qs); w.z = cvt_pk_bf16(v[bj][4] * qs, v[bj][5] * qs); w.w = cvt_pk_bf16(v[bj][6] * qs, v[bj][7] * qs);
                    if (pad32) { bf16_t* q = rowp + bj * 64 + 8 * fq; *(u32x4*)q = w; unsigned z_ = 0u; asm volatile("" : "+v"(z_)); *(u32x4*)(q + 32) = (u32x4){z_, z_, z_, z_}; }
                    else *(u32x4*)(rowp + 32 * bj + 8 * fq) = w; }
            }
        if (pad32) {
#pragma unroll
            for (int bj = 0; bj < 2; ++bj) { float mxv = nmx[bj]; mxv = fmaxf(mxv, dpp_mov<DPP_XOR1>(mxv)); mxv = fmaxf(mxv, dpp_mov<DPP_XOR2>(mxv)); mxv = fmaxf(mxv, dpp_mov<DPP_HMIR>(mxv)); mxv = fmaxf(mxv, dpp_mov<DPP_MIR>(mxv));
                if (fr == 0 && fq == 0) atomicMax(nb + b * 16 + (isdk ? 8 : 0) + 2 * wc + bj, __float_as_int(mxv)); } }
    }
};
}
typedef float f32x4_t __attribute__((ext_vector_type(4)));
typedef unsigned u32x2_t __attribute__((ext_vector_type(2)));
typedef float f32x2_t_ __attribute__((ext_vector_type(2)));
typedef unsigned u32x4_t __attribute__((ext_vector_type(4)));
__device__ __forceinline__ unsigned pk2bf(float lo, float hi) { unsigned r; asm("v_cvt_pk_bf16_f32 %0, %1, %2" : "=v"(r) : "v"(lo), "v"(hi)); return r; }
#define LDS_WAIT_() asm volatile("s_waitcnt lgkmcnt(0)" ::: "memory")
__device__ __forceinline__ f32x4_t unpk4bf(u32x2_t u) { f32x4_t f; f.x = __uint_as_float(u.x << 16); f.y = __uint_as_float(u.x & 0xffff0000u); f.z = __uint_as_float(u.y << 16); f.w = __uint_as_float(u.y & 0xffff0000u); return f; }
__device__ __forceinline__ u32x2_t pk4bf(f32x4_t v) { u32x2_t o; o.x = pk2bf(v.x, v.y); o.y = pk2bf(v.z, v.w); return o; }
#define LNC(j) (8 * lane + 512 * ((j) >> 1) + 4 * ((j) & 1))
constexpr int NJ4 = D_MODEL / 256;
__device__ __forceinline__ void ld8bf(const bf16_t* q, u32x2_t& a, u32x2_t& b) { const u32x4_t v = *(const u32x4_t*)q; a.x = v.x; a.y = v.y; b.x = v.z; b.y = v.w; }
__device__ __forceinline__ void st8bf(bf16_t* q, u32x2_t a, u32x2_t b) { *(u32x4_t*)q = (u32x4_t){a.x, a.y, b.x, b.y}; }

__device__ __forceinline__ void cvt_item(const float* W, int K, int N, bf16_t* WT, int k0, int n0, int dst_row0, LAS float* scr, int lane) {
    float tv[32];
#pragma unroll
    for (int i = 0; i < 32; ++i) tv[i] = W[(size_t)(k0 + 2 * i + (lane >> 5)) * N + n0 + (lane & 31)];
#pragma unroll
    for (int i = 0; i < 32; ++i) scr[(2 * i + (lane >> 5)) * 33 + (lane & 31)] = tv[i];
    LDS_WAIT_();
    const int c = lane & 7;
#pragma unroll
    for (int j = 0; j < 4; ++j) { const int n = (lane >> 3) + 8 * j; const LAS float* s = scr + (8 * c) * 33 + n;
        u32x4_t o; o.x = pk2bf(s[0 * 33], s[1 * 33]); o.y = pk2bf(s[2 * 33], s[3 * 33]); o.z = pk2bf(s[4 * 33], s[5 * 33]); o.w = pk2bf(s[6 * 33], s[7 * 33]);
        *(u32x4_t*)(WT + (size_t)(dst_row0 + n) * K + k0 + 8 * c) = o; }
    LDS_WAIT_();
}
constexpr int CVT_I_IN = (D_MODEL / 64) * (IN_W / 256), CVT_I_OUT = (MIX_W / 64) * (D_MODEL / 256), CVT_I_GU1 = (D_MODEL / 64) * (EXP_FF / 256), CVT_I_D1 = (EXP_FF / 64) * (D_MODEL / 256);
constexpr int CVT_NIT = CVT_I_IN + CVT_I_OUT + N_EXP * (2 * CVT_I_GU1 + CVT_I_D1);
struct CvtItem { const float* W; bf16_t* WT; int K, N, k0, n0, kind; };
__device__ __forceinline__ CvtItem cvt_decode(const P& p, int l, int it) {
    CvtItem c; bf16_t* wb = p.WB[l & 1]; int r = it;
    if (r < CVT_I_IN) { const int nb = IN_W / 256; c.W = p.w_in + (size_t)l * D_MODEL * IN_W; c.WT = WB_WIN(wb); c.K = D_MODEL; c.N = IN_W; c.k0 = 64 * (r % (D_MODEL / 64)); c.n0 = 256 * (r / (D_MODEL / 64)); c.kind = 1; (void)nb; return c; } r -= CVT_I_IN;
    if (r < CVT_I_OUT) { const int nb = D_MODEL / 256; c.W = p.w_out + (size_t)l * MIX_W * D_MODEL; c.WT = WB_WOUT(wb); c.K = MIX_W; c.N = D_MODEL; c.k0 = 64 * (r % (MIX_W / 64)); c.n0 = 256 * (r / (MIX_W / 64)); c.kind = 0; (void)nb; return c; } r -= CVT_I_OUT;
    const int per_e = 2 * CVT_I_GU1 + CVT_I_D1, e = r / per_e; r -= e * per_e;
    if (r < 2 * CVT_I_GU1) { const int half = r / CVT_I_GU1; r -= half * CVT_I_GU1; const int nb = EXP_FF / 256;
        c.W = (half ? p.exp_w_up : p.exp_w_gate) + ((size_t)l * N_EXP + e) * D_MODEL * EXP_FF; c.WT = WB_WGU(wb) + (size_t)e * 2 * EXP_FF * D_MODEL; c.K = D_MODEL; c.N = EXP_FF; c.k0 = 64 * (r % (D_MODEL / 64)); c.n0 = 256 * (r / (D_MODEL / 64)); c.kind = 2 + half; (void)nb; return c; }
    r -= 2 * CVT_I_GU1;
    { const int nb = D_MODEL / 256; c.W = p.exp_w_down + ((size_t)l * N_EXP + e) * EXP_FF * D_MODEL; c.WT = WB_WD(wb) + (size_t)e * D_MODEL * EXP_FF; c.K = EXP_FF; c.N = D_MODEL; c.k0 = 64 * (r % (EXP_FF / 64)); c.n0 = 256 * (r / (EXP_FF / 64)); c.kind = 0; (void)nb; }
    return c;
}
__device__ __forceinline__ int cvt_drow(int kind, int n) {
    if (kind == 1) { if (n < 512) return n; const int sc = n % 256; return (n - sc) + 128 * ((sc % 64) / 32) + 32 * (sc / 64) + (sc % 32); }
    if (kind >= 2) return gu_row(kind - 2, n);
    return n;
}
__device__ __forceinline__ void cvt_load(const CvtItem& c, f32x4_t (&v)[8], int wave, int lane) {
#pragma unroll
    for (int i = 0; i < 8; ++i) v[i] = *(const f32x4_t*)(c.W + (size_t)(c.k0 + wave * 8 + i) * c.N + c.n0 + 4 * lane);
}
template <int MODE = 0> __device__ __forceinline__ void ph_cvt_range(const P& p, int l, unsigned char* lds, int it0, int it1, int start, int stride, int tid) {
    LAS float* scr = (LAS float*)(LAS unsigned char*)lds;
    const int wave = tid >> 6, lane = tid & 63;
    if (it0 + start >= it1) return;
    CvtItem c = cvt_decode(p, l, it0 + start); f32x4_t v[8]; cvt_load(c, v, wave, lane);
    for (int it = it0 + start; it < it1; it += stride) {
#pragma unroll
        for (int i = 0; i < 8; ++i) { const int k = wave * 8 + i;
            scr[(4 * lane + 0) * 65 + k] = v[i].x; scr[(4 * lane + 1) * 65 + k] = v[i].y; scr[(4 * lane + 2) * 65 + k] = v[i].z; scr[(4 * lane + 3) * 65 + k] = v[i].w; }
        const CvtItem cur = c;
        if (it + stride < it1) { c = cvt_decode(p, l, it + stride); cvt_load(c, v, wave, lane); }
        __syncthreads();
        const int ch = lane & 7;
        bf16_t* const wt0 = cur.WT + (size_t)cvt_drow(cur.kind, cur.n0 + wave * 32 + (lane >> 3)) * cur.K + cur.k0 + 8 * ch;
#pragma unroll
        for (int j = 0; j < 4; ++j) { const int n = wave * 32 + j * 8 + (lane >> 3); const LAS float* s = scr + n * 65 + 8 * ch;
            u32x4_t o; o.x = pk2bf(s[0], s[1]); o.y = pk2bf(s[2], s[3]); o.z = pk2bf(s[4], s[5]); o.w = pk2bf(s[6], s[7]);
            *(u32x4_t*)(wt0 + (size_t)(8 * j) * cur.K) = o; }
        __syncthreads();
    }
}
__device__ __forceinline__ void ph_cvt(const P& p, int l, unsigned char* lds, int vcu, int G, int tid) { ph_cvt_range<0>(p, l, lds, 0, CVT_NIT, vcu, G, tid); }

__device__ __forceinline__ void ph_ada(const P& p, unsigned char* lds, int vcu, int G, int wave, int lane) {
    LAS float* red = (LAS float*)(LAS unsigned char*)lds;
    LAS float* sl = red + 8 * 3 * 64;
    { float xv[3 * D_MODEL / NTHR];
#pragma unroll
      for (int q = 0; q < 3 * D_MODEL / NTHR; ++q) { const int i = wave * 64 + lane + q * NTHR; xv[q] = i < 2 * D_MODEL ? p.c[i] : p.c_ctx[i - 2 * D_MODEL]; }
      __builtin_amdgcn_sched_barrier(0);
#pragma unroll
      for (int q = 0; q < 3 * D_MODEL / NTHR; ++q) sl[wave * 64 + lane + q * NTHR] = siluf_(xv[q]); }
    __syncthreads();
    constexpr int UPL = 6 * D_MODEL / 32, NU = DEPTH * UPL;
    const int cl = lane & 31, kh = lane >> 5;
    for (int u = vcu; u < NU; u += G) {
        const int l = u / UPL, col = (u % UPL) * 32 + cl;
        const float* W = p.ada_w + (size_t)l * D_MODEL * 6 * D_MODEL + col;
        float a0 = 0.f, a1 = 0.f, a2 = 0.f;
        const int kb = wave * (D_MODEL / 8) + kh * (D_MODEL / 16);
#pragma unroll 16
        for (int k = 0; k < D_MODEL / 16; ++k) { const float wv = W[(size_t)(kb + k) * 6 * D_MODEL];
            a0 += sl[kb + k] * wv; a1 += sl[D_MODEL + kb + k] * wv; a2 += sl[2 * D_MODEL + kb + k] * wv; }
        a0 += __shfl_xor(a0, 32); a1 += __shfl_xor(a1, 32); a2 += __shfl_xor(a2, 32);
        if (kh == 0) { red[(wave * 3 + 0) * 32 + cl] = a0; red[(wave * 3 + 1) * 32 + cl] = a1; red[(wave * 3 + 2) * 32 + cl] = a2; }
        __syncthreads();
        if (wave < 3 && lane < 32) { float s = 0.f;
#pragma unroll
            for (int w = 0; w < 8; ++w) s += red[(w * 3 + wave) * 32 + lane];
            p.MOD[((size_t)l * 3 + wave) * 6 * D_MODEL + col] = s + p.ada_b[l * 6 * D_MODEL + col]; }
        __syncthreads();
    }
}

__device__ __forceinline__ void ph_mod0(const P& p, int gw, int NGW, int lane) {
    f32x4_t sc[NJ4], sh[NJ4], va[NJ4], vn[NJ4]; int cur_who = -1;
#define MOD0_LOAD(V, ROW) do { const int rr_ = (ROW); const float* src_ = rr_ < NLAT ? p.x + (size_t)rr_ * D_MODEL : p.ctx + (size_t)(rr_ - NLAT) * D_MODEL; \
        _Pragma("unroll") for (int j = 0; j < NJ4; ++j) V[j] = *(const f32x4_t*)(src_ + LNC(j)); } while (0)
    if (gw < NROW) MOD0_LOAD(vn, gw);
    for (int r = gw; r < NROW; r += NGW) {
        const int who = row_who(r);
#pragma unroll
        for (int j = 0; j < NJ4; ++j) va[j] = vn[j];
        if (r + NGW < NROW) MOD0_LOAD(vn, r + NGW);
        if (who != cur_who) { cur_who = who;
#pragma unroll
            for (int j = 0; j < NJ4; ++j) { sh[j] = *(const f32x4_t*)(modp(p, 0, who, 0) + LNC(j)); sc[j] = *(const f32x4_t*)(modp(p, 0, who, 1) + LNC(j)); } }
#pragma unroll
        for (int j = 0; j < NJ4; j += 2) { const int c = LNC(j);
            st8bf((bf16_t*)p.XR + (size_t)r * D_MODEL + c, pk4bf(va[j]), pk4bf(va[j + 1]));
            st8bf(p.H + (size_t)r * D_MODEL + c, pk4bf(va[j] * (1.f + sc[j]) + sh[j]), pk4bf(va[j + 1] * (1.f + sc[j + 1]) + sh[j + 1])); }
    }
#undef MOD0_LOAD
}
__device__ __forceinline__ void route_tail(float lgt, const float* router_b, int lane, int& e1, int& e2, float& gw1, float& gw2, const float rb_e);
__device__ __forceinline__ void route_wave(const float (&lg)[N_EXP], const float* router_b, int lane, int& e1, int& e2, float& gw1, float& gw2) {
    static_assert(N_EXP == 16, "lane layout");
    const bool b5 = (lane >> 5) & 1, b4 = (lane >> 4) & 1, b3 = (lane >> 3) & 1, b2 = (lane >> 2) & 1;
    float r8[8], r4[4], r2[2];
#pragma unroll
    for (int i = 0; i < 8; ++i) { const float a = b5 ? lg[i + 8] : lg[i], b = b5 ? lg[i] : lg[i + 8]; r8[i] = a + __shfl_xor(b, 32); }
#pragma unroll
    for (int i = 0; i < 4; ++i) { const float a = b4 ? r8[i + 4] : r8[i], b = b4 ? r8[i] : r8[i + 4]; r4[i] = a + __shfl_xor(b, 16); }
#pragma unroll
    for (int i = 0; i < 2; ++i) { const float a = b3 ? r4[i + 2] : r4[i], b = b3 ? r4[i] : r4[i + 2]; r2[i] = a + __shfl_xor(b, 8); }
    float lgt = (b2 ? r2[1] : r2[0]) + __shfl_xor(b2 ? r2[0] : r2[1], 4);
    lgt += __shfl_xor(lgt, 2); lgt += __shfl_xor(lgt, 1);
    route_tail(lgt, router_b, lane, e1, e2, gw1, gw2, router_b[lane >> 2]);
}
__device__ __forceinline__ void route_tail(float lgt, const float* router_b, int lane, int& e1, int& e2, float& gw1, float& gw2, const float rb_e) {
    const int e = lane >> 2;
    float mx = lgt; mx = fmaxf(mx, dpp_mov<DPP_HMIR>(mx)); mx = fmaxf(mx, dpp_mov<DPP_MIR>(mx)); mx = swap16_max(mx); mx = swap32_max(mx);
    const float pe = __expf(lgt - mx);
    float sm = pe; sm += dpp_mov<DPP_HMIR>(sm); sm += dpp_mov<DPP_MIR>(sm); sm = swap16_sum(sm); sm = swap32_sum(sm);
    const float prob = pe * __builtin_amdgcn_rcpf(sm), sel = prob + rb_e;
    const int rb = lane & 48;
    float sj[4], pj[4];
#pragma unroll
    for (int j = 0; j < 4; ++j) { sj[j] = __shfl(sel, rb + 4 * j); pj[j] = __shfl(prob, rb + 4 * j); }
    __builtin_amdgcn_sched_barrier(0);
    float s1 = -1e30f, p1 = 0.f; int i1 = 0;
#pragma unroll
    for (int j = 0; j < 4; ++j) if (sj[j] > s1) { s1 = sj[j]; i1 = j; p1 = pj[j]; }
    float s2 = -1e30f, p2 = 0.f; int i2 = 0;
#pragma unroll
    for (int j = 0; j < 4; ++j) if (j != i1 && sj[j] > s2) { s2 = sj[j]; i2 = j; p2 = pj[j]; }
    const float sc = s1 + s2;
    float bs = -1e30f; int bg = 0;
#pragma unroll
    for (int g = 0; g < 4; ++g) { const float sg = __shfl(sc, 16 * g); if (sg > bs) { bs = sg; bg = g; } }
    const int src = 16 * bg;
    const int ri1 = __shfl(i1, src), ri2 = __shfl(i2, src); const float rp1 = __shfl(p1, src), rp2 = __shfl(p2, src);
    e1 = bg * 4 + ri1; e2 = bg * 4 + ri2; const float wsi = __builtin_amdgcn_rcpf(rp1 + rp2); gw1 = rp1 * wsi; gw2 = rp2 * wsi;
}
constexpr int LNR_MAXR = 16;
static_assert(NROW < 65536, "row index is packed in 16 bits");
__device__ __forceinline__ void ph_lnroute(const P& p, int l, unsigned char* lds, int gw, int NGW, int tid, int lane, const int nrow) {
    typedef short bf16x8_t __attribute__((ext_vector_type(8)));
    constexpr int AST = D_MODEL * 2 + 16;
    LAS unsigned char* AH = (LAS unsigned char*)lds; LAS unsigned char* AL = AH + 8 * AST;
    LAS float* PART = (LAS float*)(AL + 8 * AST);
    LAS int* LC = (LAS int*)(PART + 8 * 16 * 16);
    LAS int* REC = LC + 2 * N_EXP;
    const int wave = __builtin_amdgcn_readfirstlane(tid >> 6); int nrec = 0;
    const float rb_e = p.router_b[lane >> 2];
    if (tid < 2 * N_EXP) LC[tid] = 0;
    f32x4_t lng[NJ4], lnb[NJ4], mg1[NJ4], msc[NJ4], msh[NJ4]; int cur_who = -1;
#pragma unroll
    for (int j = 0; j < NJ4; ++j) { const int c = LNC(j); lng[j] = *(const f32x4_t*)(p.ln1_g + l * D_MODEL + c); lnb[j] = *(const f32x4_t*)(p.ln1_b + l * D_MODEL + c); }
    u32x2_t xa[NJ4], ya[NJ4], xn[NJ4], yn[NJ4];
    if (gw < nrow) {
#pragma unroll
        for (int j = 0; j < NJ4; j += 2) { const int c = LNC(j); ld8bf((const bf16_t*)p.XR + (size_t)gw * D_MODEL + c, xn[j], xn[j + 1]); ld8bf((const bf16_t*)p.YO + (size_t)gw * D_MODEL + c, yn[j], yn[j + 1]); } }
    bf16x8_t Bhi[4], Blo[4];
    { const int e = lane & 15, kq = lane >> 4;
      float rw[4][8];
#pragma unroll
      for (int s = 0; s < 4; ++s)
#pragma unroll
          for (int j = 0; j < 8; ++j) rw[s][j] = p.router_w[(128 * wave + 32 * s + 8 * kq + j) * N_EXP + e];
      __builtin_amdgcn_sched_barrier(0);
#pragma unroll
      for (int s = 0; s < 4; ++s) { unsigned hh[4], ll[4];
#pragma unroll
          for (int j2 = 0; j2 < 4; ++j2) { const float w0 = rw[s][2 * j2], w1 = rw[s][2 * j2 + 1];
              hh[j2] = pk2bf(w0, w1); ll[j2] = pk2bf(w0 - __uint_as_float(hh[j2] << 16), w1 - __uint_as_float(hh[j2] & 0xffff0000u)); }
          Bhi[s] = __builtin_bit_cast(bf16x8_t, (u32x4_t){hh[0], hh[1], hh[2], hh[3]}); Blo[s] = __builtin_bit_cast(bf16x8_t, (u32x4_t){ll[0], ll[1], ll[2], ll[3]}); }
      __builtin_amdgcn_sched_barrier(0); }
    __syncthreads();
    for (int r = gw; r < nrow; r += NGW) {
        const int who = row_who(r);
#pragma unroll
        for (int j = 0; j < NJ4; ++j) { xa[j] = xn[j]; ya[j] = yn[j]; }
        if (r + NGW < nrow) {
#pragma unroll
            for (int j = 0; j < NJ4; j += 2) { const int c = LNC(j); ld8bf((const bf16_t*)p.XR + (size_t)(r + NGW) * D_MODEL + c, xn[j], xn[j + 1]); ld8bf((const bf16_t*)p.YO + (size_t)(r + NGW) * D_MODEL + c, yn[j], yn[j + 1]); } }
        if (who != cur_who) { cur_who = who;
#pragma unroll
            for (int j = 0; j < NJ4; ++j) { const int c = LNC(j); mg1[j] = *(const f32x4_t*)(modp(p, l, who, 2) + c); msh[j] = *(const f32x4_t*)(modp(p, l, who, 3) + c); msc[j] = *(const f32x4_t*)(modp(p, l, who, 4) + c); } }
        f32x4_t t[NJ4]; float s = 0.f;
#pragma unroll
        for (int j = 0; j < NJ4; ++j) { t[j] = unpk4bf(xa[j]) * DN_ALPHA + mg1[j] * unpk4bf(ya[j]); s += (t[j].x + t[j].y) + (t[j].z + t[j].w); }
        const float mean = wave_sum(s) * (1.f / D_MODEL); float s2 = 0.f;
#pragma unroll
        for (int j = 0; j < NJ4; ++j) { t[j] = t[j] - mean; s2 += (t[j].x * t[j].x + t[j].y * t[j].y) + (t[j].z * t[j].z + t[j].w * t[j].w); }
        const float rstd = __builtin_amdgcn_rsqf(wave_sum(s2) * (1.f / D_MODEL) + 1e-6f);
#pragma unroll
        for (int j = 0; j < NJ4; j += 2) { const int c = LNC(j); u32x2_t xo[2], hi[2], lo[2];
#pragma unroll
            for (int q = 0; q < 2; ++q) { const f32x4_t x1 = t[j + q] * rstd * lng[j + q] + lnb[j + q]; xo[q] = pk4bf(x1);
                const f32x4_t h2 = x1 * (1.f + msc[j + q]) + msh[j + q]; hi[q] = pk4bf(h2); lo[q] = pk4bf(h2 - unpk4bf(hi[q])); }
            st8bf((bf16_t*)p.XRo + (size_t)r * D_MODEL + c, xo[0], xo[1]); st8bf(p.Ho + (size_t)r * D_MODEL + c, hi[0], hi[1]);
            *(LAS u32x4_t*)(AH + wave * AST + c * 2) = (u32x4_t){hi[0].x, hi[0].y, hi[1].x, hi[1].y}; *(LAS u32x4_t*)(AL + wave * AST + c * 2) = (u32x4_t){lo[0].x, lo[0].y, lo[1].x, lo[1].y}; }
        __syncthreads();
        {
            f32x4_t acc = (f32x4_t){0.f, 0.f, 0.f, 0.f};
            const int arow = lane & 7, kq = lane >> 4;
#pragma unroll
            for (int s4 = 0; s4 < 4; ++s4) { const int off = arow * AST + (128 * wave + 32 * s4 + 8 * kq) * 2;
                const bf16x8_t ah = *(const LAS bf16x8_t*)(AH + off), al = *(const LAS bf16x8_t*)(AL + off);
                acc = __builtin_amdgcn_mfma_f32_16x16x32_bf16(ah, Bhi[s4], acc, 0, 0, 0);
                acc = __builtin_amdgcn_mfma_f32_16x16x32_bf16(ah, Blo[s4], acc, 0, 0, 0);
                acc = __builtin_amdgcn_mfma_f32_16x16x32_bf16(al, Bhi[s4], acc, 0, 0, 0); }
            if (lane < 32) {
#pragma unroll
                for (int i = 0; i < 4; ++i) PART[(wave * 16 + 4 * (lane >> 4) + i) * 16 + (lane & 15)] = acc[i]; }
        }
        __syncthreads();
        float pl_[8];
#pragma unroll
        for (int w = 0; w < 8; ++w) pl_[w] = PART[(w * 16 + wave) * 16 + (lane >> 2)];
        __builtin_amdgcn_sched_barrier(0);
        const float lgt = ((pl_[0] + pl_[1]) + (pl_[2] + pl_[3])) + ((pl_[4] + pl_[5]) + (pl_[6] + pl_[7]));
        int e1, e2; float gw1, gw2; route_tail(lgt, p.router_b, lane, e1, e2, gw1, gw2, rb_e);
        if (lane == 0) { p.TGo[r * 2 + 0] = gw1; p.TGo[r * 2 + 1] = gw2;
            const int k1 = __hip_atomic_fetch_add((LAS int*)&LC[e1], 1, __ATOMIC_RELAXED, __HIP_MEMORY_SCOPE_WORKGROUP), k2 = __hip_atomic_fetch_add((LAS int*)&LC[e2], 1, __ATOMIC_RELAXED, __HIP_MEMORY_SCOPE_WORKGROUP);
            REC[(wave * LNR_MAXR + nrec) * 2 + 0] = (r << 16) | (e1 << 12) | k1; REC[(wave * LNR_MAXR + nrec) * 2 + 1] = (r << 16) | (e2 << 12) | k2; }
        ++nrec;
    }
    __syncthreads();
    if (tid < N_EXP) { const int c = LC[tid]; LC[N_EXP + tid] = c ? atomicAdd(p.cnto + CNT_IDX(l, tid), c) : 0; }
    __syncthreads();
    if (lane < 2) for (int i = 0; i < nrec; ++i) { const int rec = REC[(wave * LNR_MAXR + i) * 2 + lane]; const int r = (unsigned)rec >> 16, e = (rec >> 12) & 15, k = rec & 4095;
        p.SLOTTOKo[(size_t)e * NROW + LC[N_EXP + e] + k] = r * 2 + lane; }
    __syncthreads();
}

__device__ __forceinline__ void ph_lnfinal(const P& p, int l, int gw, int NGW, int lane, const int nrow) {
    f32x4_t lng[NJ4], lnb[NJ4], mg2[NJ4], nsc[NJ4], nsh[NJ4]; int cur_who = -1;
#pragma unroll
    for (int j = 0; j < NJ4; ++j) { const int c = LNC(j); lng[j] = *(const f32x4_t*)(p.ln2_g + l * D_MODEL + c); lnb[j] = *(const f32x4_t*)(p.ln2_b + l * D_MODEL + c); }
    u32x2_t xa[NJ4], xn[NJ4], xm[NJ4]; u32x2_t fa0[NJ4], fa1[NJ4], fn0[NJ4], fn1[NJ4], fm0[NJ4], fm1[NJ4];
#define LNF_LOAD(X, F0, F1, ROW) do { const int rr_ = (ROW); _Pragma("unroll") for (int j = 0; j < NJ4; j += 2) { const int c = LNC(j); ld8bf((const bf16_t*)p.XR + (size_t)rr_ * D_MODEL + c, X[j], X[j + 1]); \
            ld8bf(p.FO + (size_t)(rr_ * 2) * D_MODEL + c, F0[j], F0[j + 1]); ld8bf(p.FO + (size_t)(rr_ * 2 + 1) * D_MODEL + c, F1[j], F1[j + 1]); } } while (0)
    if (gw < nrow) LNF_LOAD(xn, fn0, fn1, gw);
    if (gw + NGW < nrow) LNF_LOAD(xm, fm0, fm1, gw + NGW);
    for (int r = gw; r < nrow; r += NGW) {
        const int who = row_who(r);
#pragma unroll
        for (int j = 0; j < NJ4; ++j) { xa[j] = xn[j]; fa0[j] = fn0[j]; fa1[j] = fn1[j]; xn[j] = xm[j]; fn0[j] = fm0[j]; fn1[j] = fm1[j]; }
        if (r + 2 * NGW < nrow) LNF_LOAD(xm, fm0, fm1, r + 2 * NGW);
        if (who != cur_who) { cur_who = who;
#pragma unroll
            for (int j = 0; j < NJ4; ++j) { const int c = LNC(j); mg2[j] = *(const f32x4_t*)(modp(p, l, who, 5) + c);
                if (l + 1 < DEPTH) { nsh[j] = *(const f32x4_t*)(modp(p, l + 1, who, 0) + c); nsc[j] = *(const f32x4_t*)(modp(p, l + 1, who, 1) + c); } } }
        f32x4_t t[NJ4]; float s = 0.f;
#pragma unroll
        for (int j = 0; j < NJ4; ++j) { const u32x2_t u0 = fa0[j], u1 = fa1[j];
            f32x4_t f; f.x = __uint_as_float(u0.x << 16) + __uint_as_float(u1.x << 16); f.y = __uint_as_float(u0.x & 0xffff0000u) + __uint_as_float(u1.x & 0xffff0000u);
            f.z = __uint_as_float(u0.y << 16) + __uint_as_float(u1.y << 16); f.w = __uint_as_float(u0.y & 0xffff0000u) + __uint_as_float(u1.y & 0xffff0000u);
            t[j] = unpk4bf(xa[j]) * DN_ALPHA + mg2[j] * f; s += (t[j].x + t[j].y) + (t[j].z + t[j].w); }
        const float mean = wave_sum(s) * (1.f / D_MODEL); float s2 = 0.f;
#pragma unroll
        for (int j = 0; j < NJ4; ++j) { t[j] = t[j] - mean; s2 += (t[j].x * t[j].x + t[j].y * t[j].y) + (t[j].z * t[j].z + t[j].w * t[j].w); }
        const float rstd = __builtin_amdgcn_rsqf(wave_sum(s2) * (1.f / D_MODEL) + 1e-6f);
#pragma unroll
        for (int j = 0; j < NJ4; j += 2) { const int c = LNC(j);
            const f32x4_t xa2 = t[j] * rstd * lng[j] + lnb[j], xb2 = t[j + 1] * rstd * lng[j + 1] + lnb[j + 1];
            if (l + 1 < DEPTH) { st8bf((bf16_t*)p.XRo + (size_t)r * D_MODEL + c, pk4bf(xa2), pk4bf(xb2));
                st8bf(p.Ho + (size_t)r * D_MODEL + c, pk4bf(xa2 * (1.f + nsc[j]) + nsh[j]), pk4bf(xb2 * (1.f + nsc[j + 1]) + nsh[j + 1])); }
            else if (r < NLAT) { *(f32x4_t*)(p.out + (size_t)r * D_MODEL + c) = xa2; *(f32x4_t*)(p.out + (size_t)r * D_MODEL + c + 4) = xb2; } }
    }
#undef LNF_LOAD
}
constexpr int LCH = 64, CCH = 32;
constexpr int NLCH = SEQ / LCH, NCCH = CTX_LEN / CCH, NSEQC = NCCH + NLCH;
constexpr int LRU_UNITS = BATCH * (NLCH + NCCH);
struct LruChunk { int b, row0, ntok, seg0, seglen, sf, sr; };
__device__ __forceinline__ LruChunk lru_chunk(int u) {
    LruChunk k;
    if (u < BATCH * NLCH) { k.b = u / NLCH; const int c = u % NLCH; k.seg0 = k.b * SEQ; k.seglen = SEQ; k.row0 = k.seg0 + c * LCH; k.ntok = LCH; k.sf = NCCH + c; k.sr = NCCH + (NLCH - 1 - c); }
    else { const int q = u - BATCH * NLCH; k.b = q / NCCH; const int c = q % NCCH; k.seg0 = NLAT + k.b * CTX_LEN; k.seglen = CTX_LEN; k.row0 = k.seg0 + c * CCH; k.ntok = CCH; k.sf = c; k.sr = NCCH - 1 - c; }
    return k;
}
__device__ __forceinline__ float* agg_ptr(float* AGG, int b, int dir, int s) { return AGG + (((size_t)b * 2 + dir) * NSEQC + s) * 2 * LRU_W; }

__device__ __forceinline__ void lru_stage_rows(const float* AX, LAS float* Rw, unsigned rw_lds, int row0, int ntok, int seg0, int seglen, int wave, int lane) {
    const int nr = ntok + 3; asm volatile("" : "+v"(lane));
    for (int rr = wave; rr < nr; rr += 8) { const int r = row0 - 1 + rr;
        if (r >= seg0 && r < seg0 + seglen) attn_body::glds16(AX + (size_t)r * LRU_W + 4 * lane, (unsigned)__builtin_amdgcn_readfirstlane(rw_lds + (unsigned)rr * (LRU_W * 4)));
        else *(LAS f32x4_t*)(Rw + rr * LRU_W + 4 * lane) = (f32x4_t){0.f, 0.f, 0.f, 0.f}; }
}
__device__ __forceinline__ void ph_lru1(const P& p, int l, float* AGG, unsigned char* lds, int vcu, int G, int tid) {
    typedef short bf16x8_t __attribute__((ext_vector_type(8)));
    typedef float f32x16_t __attribute__((ext_vector_type(16)));
    constexpr int UST = LRU_W + 8;
    LAS bf16_t* Ub = (LAS bf16_t*)(LAS unsigned char*)lds;
    const int wave = __builtin_amdgcn_readfirstlane(tid >> 6), lane = tid & 63, col = lane & 31, hi = lane >> 5;
    const int n = wave >> 1, dir = wave & 1;
    LAS float* Rw = (LAS float*)((LAS unsigned char*)lds + LCH * UST * 2);
    const unsigned rw_lds = (unsigned)(uintptr_t)lds + (unsigned)(LCH * UST * 2);
    if (vcu < LRU_UNITS) { const LruChunk k0 = lru_chunk(vcu); lru_stage_rows(p.AX, Rw, rw_lds, k0.row0, k0.ntok, k0.seg0, k0.seglen, wave, lane); }
    bf16x8_t Bf[2][2][4];
    {
#pragma unroll
        for (int g = 0; g < 2; ++g) { const float* Wg = (g ? p.rg_wx : p.rg_wa) + ((size_t)(l * 2 + dir) * 4 + n) * LRU_BLK * LRU_BLK;
            float wv[2][4][8];
#pragma unroll
            for (int dh = 0; dh < 2; ++dh)
#pragma unroll
                for (int ks = 0; ks < 4; ++ks)
#pragma unroll
                    for (int j = 0; j < 8; ++j) wv[dh][ks][j] = Wg[(16 * ks + 8 * hi + j) * LRU_BLK + 32 * dh + col];
            __builtin_amdgcn_sched_barrier(0);
#pragma unroll
            for (int dh = 0; dh < 2; ++dh)
#pragma unroll
                for (int ks = 0; ks < 4; ++ks) Bf[g][dh][ks] = __builtin_bit_cast(bf16x8_t, (u32x4_t){pk2bf(wv[dh][ks][0], wv[dh][ks][1]), pk2bf(wv[dh][ks][2], wv[dh][ks][3]), pk2bf(wv[dh][ks][4], wv[dh][ks][5]), pk2bf(wv[dh][ks][6], wv[dh][ks][7])});
            __builtin_amdgcn_sched_barrier(0); }
    }
    float ba[2], bx[2], nsp8[2];
#pragma unroll
    for (int dh = 0; dh < 2; ++dh) { const int ch = n * LRU_BLK + 32 * dh + col; ba[dh] = -1.4426950408889634f * p.rg_ba[(l * 2 + dir) * LRU_W + ch]; bx[dh] = -1.4426950408889634f * p.rg_bx[(l * 2 + dir) * LRU_W + ch];
        nsp8[dh] = -8.0f * 1.4426950408889634f * __logf(1.f + __expf(-p.rg_lam[(l * 2 + dir) * LRU_W + ch])); }
    const int cch = tid & 255, cpar = tid >> 8;
    const float cw0 = p.conv_w[(l * 4 + 0) * LRU_W + cch], cw1 = p.conv_w[(l * 4 + 1) * LRU_W + cch], cw2 = p.conv_w[(l * 4 + 2) * LRU_W + cch], cw3 = p.conv_w[(l * 4 + 3) * LRU_W + cch], cb = p.conv_b[l * LRU_W + cch];
    for (int u = vcu; u < LRU_UNITS; u += G) {
        const LruChunk k = lru_chunk(u);
        asm volatile("s_waitcnt vmcnt(0)" ::: "memory");
        __syncthreads();
        for (int tt = cpar; tt < k.ntok; tt += 2) { const LAS float* ax = Rw + (tt + 1) * LRU_W + cch;
            Ub[tt * UST + cch] = f2bf(cb + cw0 * ax[-LRU_W] + cw1 * ax[0] + cw2 * ax[LRU_W] + cw3 * ax[2 * LRU_W]); }
        __syncthreads();
        if (u + G < LRU_UNITS) { const LruChunk kn = lru_chunk(u + G); lru_stage_rows(p.AX, Rw, rw_lds, kn.row0, kn.ntok, kn.seg0, kn.seglen, wave, lane); }
        float ap[2] = {1.f, 1.f}, hh[2] = {0.f, 0.f};
        const int nmt = k.ntok / 32;
        for (int im = 0; im < nmt; ++im) { const int mt = dir ? nmt - 1 - im : im;
            f32x16_t acc[2][2];
#pragma unroll
            for (int g = 0; g < 2; ++g)
#pragma unroll
                for (int dh = 0; dh < 2; ++dh) acc[g][dh] = (f32x16_t){0.f, 0.f, 0.f, 0.f, 0.f, 0.f, 0.f, 0.f, 0.f, 0.f, 0.f, 0.f, 0.f, 0.f, 0.f, 0.f};
#pragma unroll
            for (int ks = 0; ks < 4; ++ks) { const bf16x8_t af = *(const LAS bf16x8_t*)(Ub + (mt * 32 + col) * UST + n * LRU_BLK + 16 * ks + 8 * hi);
#pragma unroll
                for (int g = 0; g < 2; ++g)
#pragma unroll
                    for (int dh = 0; dh < 2; ++dh) acc[g][dh] = __builtin_amdgcn_mfma_f32_32x32x16_bf16(af, Bf[g][dh][ks], acc[g][dh], 0, 0, 0); }
#pragma unroll
            for (int dh = 0; dh < 2; ++dh) { const int ch = n * LRU_BLK + 32 * dh + col;
                float GA_[4], GB_[4];
#pragma unroll
                for (int g4 = 0; g4 < 4; ++g4) { float av[4], bv[4];
#pragma unroll
                    for (int i = 0; i < 4; ++i) { const int reg = 4 * g4 + i, tok = mt * 32 + 8 * g4 + 4 * hi + i;
                        const float uc = bf2f(Ub[tok * UST + ch]);
                        const float rg = __builtin_amdgcn_rcpf(1.f + __builtin_amdgcn_exp2f(fmaf(acc[0][dh][reg], -1.4426950408889634f, ba[dh]))), ig = __builtin_amdgcn_rcpf(1.f + __builtin_amdgcn_exp2f(fmaf(acc[1][dh][reg], -1.4426950408889634f, bx[dh])));
                        const float a = __builtin_amdgcn_exp2f(nsp8[dh] * rg); const float mult = __builtin_amdgcn_sqrtf(fmaxf(1.f - a * a, 0.f));
                        const float b = mult * ig * uc; av[i] = a; bv[i] = b;
                        const unsigned go = (unsigned)(((k.row0 + tok) * 2 + dir) * LRU_W + ch) * 4u;
                        *(float*)((char*)p.LA + go) = a; *(float*)((char*)p.LB + go) = b; }
                    float A_, B_;
                    if (dir == 0) { A_ = av[0]; B_ = bv[0];
#pragma unroll
                        for (int i = 1; i < 4; ++i) { B_ = av[i] * B_ + bv[i]; A_ *= av[i]; } }
                    else { A_ = av[3]; B_ = bv[3];
#pragma unroll
                        for (int i = 2; i >= 0; --i) { B_ = av[i] * B_ + bv[i]; A_ *= av[i]; } }
                    GA_[g4] = A_; GB_[g4] = B_; }
#pragma unroll
                for (int s = 0; s < 8; ++s) { const int q = dir ? 7 - s : s; const int g4 = q >> 1, qh = q & 1;
                    const float oa = __shfl_xor(GA_[g4], 32), ob = __shfl_xor(GB_[g4], 32);
                    const float A_ = (qh == hi) ? GA_[g4] : oa, B_ = (qh == hi) ? GB_[g4] : ob;
                    hh[dh] = A_ * hh[dh] + B_; ap[dh] *= A_; } }
        }
        if (hi == 0) { float* ag = agg_ptr(AGG, k.b, dir, dir ? k.sr : k.sf);
#pragma unroll
            for (int dh = 0; dh < 2; ++dh) { const int ch = n * LRU_BLK + 32 * dh + col; ag[ch] = ap[dh]; ag[LRU_W + ch] = hh[dh]; } }
        __syncthreads();
    }
}
__device__ __forceinline__ void ph_lru2(const P& p, const float* AGG, unsigned char* lds, int vcu, int G, int tid, const int nunits) {
    LAS float* HF = (LAS float*)(LAS unsigned char*)lds;
    const int dir = __builtin_amdgcn_readfirstlane(tid >> 8), ch = tid & 255;
    for (int u = vcu; u < nunits; u += G) {
        const LruChunk k = lru_chunk(u);
        const int me = dir ? k.sr : k.sf;
        const float* agu = AGG + (((size_t)k.b * 2 + dir) * NSEQC) * 2 * LRU_W;
        f32x4_t gq[4][2];
#pragma unroll
        for (int i = 0; i < 4; ++i) { const int it = tid + i * NTHR, tt = it >> 5, c8 = (it & 31) * 8;
            if (tt < k.ntok) { const float* gp = p.GA + (size_t)(k.row0 + tt) * LRU_W + c8; gq[i][0] = *(const f32x4_t*)gp; gq[i][1] = *(const f32x4_t*)(gp + 4); }
            else { gq[i][0] = (f32x4_t){0.f, 0.f, 0.f, 0.f}; gq[i][1] = (f32x4_t){0.f, 0.f, 0.f, 0.f}; } }
        float an[8], bn[8];
#pragma unroll
        for (int q = 0; q < 8; ++q) { const int tt = dir ? k.ntok - 1 - q : q; const size_t gu = ((size_t)(k.row0 + tt) * 2 + dir) * LRU_W; an[q] = (p.LA + gu)[ch]; bn[q] = (p.LB + gu)[ch]; }
        float h = 0.f;
        int s = 0;
        for (; s + 16 <= me; s += 16) { float av[16], hv[16];
#pragma unroll
            for (int q = 0; q < 16; ++q) { const float* rowp = agu + (size_t)(s + q) * 2 * LRU_W; av[q] = rowp[ch]; hv[q] = rowp[LRU_W + ch]; }
            __builtin_amdgcn_sched_barrier(0);
#pragma unroll
            for (int q = 0; q < 16; ++q) h = av[q] * h + hv[q]; }
        if (s < me) { float av[16], hv[16];
#pragma unroll
            for (int q = 0; q < 16; ++q) { const int si = s + q < me ? s + q : me - 1; const float* rowp = agu + (size_t)si * 2 * LRU_W; av[q] = rowp[ch]; hv[q] = rowp[LRU_W + ch]; }
            __builtin_amdgcn_sched_barrier(0);
#pragma unroll
            for (int q = 0; q < 16; ++q) { const bool ok = s + q < me; h = (ok ? av[q] : 1.f) * h + (ok ? hv[q] : 0.f); } }
        for (int i0 = 0; i0 < k.ntok; i0 += 8) { float av[8], bv[8];
#pragma unroll
            for (int q = 0; q < 8; ++q) { av[q] = an[q]; bv[q] = bn[q]; }
            if (i0 + 8 < k.ntok) {
#pragma unroll
                for (int q = 0; q < 8; ++q) { const int tt = dir ? k.ntok - 1 - (i0 + 8 + q) : i0 + 8 + q; const size_t gu = ((size_t)(k.row0 + tt) * 2 + dir) * LRU_W; an[q] = (p.LA + gu)[ch]; bn[q] = (p.LB + gu)[ch]; } }
#pragma unroll
            for (int q = 0; q < 8; ++q) { const int tt = dir ? k.ntok - 1 - (i0 + q) : i0 + q; h = av[q] * h + bv[q]; HF[(dir * LCH + tt) * LRU_W + ch] = h; } }
        __syncthreads();
#pragma unroll
        for (int i = 0; i < 4; ++i) { const int it = tid + i * NTHR, tt = it >> 5, c8 = (it & 31) * 8;
            if (tt < k.ntok) { const LAS float* hf = HF + tt * LRU_W + c8; const LAS float* hb = HF + (LCH + tt) * LRU_W + c8;
                const f32x4_t f0 = *(const LAS f32x4_t*)hf, f1 = *(const LAS f32x4_t*)(hf + 4), b0 = *(const LAS f32x4_t*)hb, b1 = *(const LAS f32x4_t*)(hb + 4);
                const f32x4_t y0 = gq[i][0] * (f0 + b0), y1 = gq[i][1] * (f1 + b1);
                u32x4_t w; w.x = pk2bf(y0.x, y0.y); w.y = pk2bf(y0.z, y0.w); w.z = pk2bf(y1.x, y1.y); w.w = pk2bf(y1.z, y1.w);
                *(u32x4_t*)(p.Y + (size_t)(k.row0 + tt) * MIX_W + c8) = w; } }
        __syncthreads();
    }
}
__device__ __forceinline__ void ph_diffcomb(const P& p, int l, int gw, int NGW, int lane) {
    static_assert(DIFF_H == 4, "lane mapping assumes 4 diff heads (8 branch outputs of 64)");
    const float lam = diff_lam(p, l), lam_init = 0.8f - 0.6f * expf(-0.3f * (float)l);
    const int hb = lane >> 3, sub = lane & 7, head = hb >> 1;
    float g[8];
#pragma unroll
    for (int j = 0; j < 8; ++j) g[j] = p.diff_subln_g[l * 64 + sub * 8 + j] * (1.f - lam_init);
    for (int r = gw; r < NROW; r += NGW) {
        const u32x4_t v = *(const u32x4_t*)(p.OD + (size_t)r * ODP + hb * 64 + sub * 8);
        float o[8]; o[0] = __uint_as_float(v.x << 16); o[1] = __uint_as_float(v.x & 0xffff0000u); o[2] = __uint_as_float(v.y << 16); o[3] = __uint_as_float(v.y & 0xffff0000u);
        o[4] = __uint_as_float(v.z << 16); o[5] = __uint_as_float(v.z & 0xffff0000u); o[6] = __uint_as_float(v.w << 16); o[7] = __uint_as_float(v.w & 0xffff0000u);
        float ss = 0.f;
#pragma unroll
        for (int j = 0; j < 8; ++j) { const float o2 = __shfl_down(o[j], 8); o[j] = o[j] - lam * o2; ss += o[j] * o[j]; }
        ss += __shfl_xor(ss, 1); ss += __shfl_xor(ss, 2); ss += __shfl_xor(ss, 4);
        const float rs = 1.0f / sqrtf(ss * (1.f / 64.f) + 1e-6f);
        if ((hb & 1) == 0) { u32x4_t w; w.x = pk2bf(o[0] * rs * g[0], o[1] * rs * g[1]); w.y = pk2bf(o[2] * rs * g[2], o[3] * rs * g[3]); w.z = pk2bf(o[4] * rs * g[4], o[5] * rs * g[5]); w.w = pk2bf(o[6] * rs * g[6], o[7] * rs * g[7]);
            *(u32x4_t*)(p.Y + (size_t)r * MIX_W + LRU_W + GQA_H * 64 + head * 64 + sub * 8) = w; }
    }
}
#define FOR_GID(n) for (long gid = (long)blockIdx.x * NTHR + tid_; gid < (long)(n); gid += (long)gridDim.x * NTHR)
#define GRID_SYNC() do { XcdBarrier b2_ = bar; asm volatile("" : "+s"(b2_.bar), "+s"(b2_.x)); xcd_barrier(b2_); } while (0)
#define CTL_NB_WORD 16384
#define PHASE_P() int tid_ = threadIdx.x; asm volatile("" : "+v"(tid_)); const P& q = p

struct AttnWork { const attn_body::bf16* Qu; const attn_body::bf16* Kh; const attn_body::bf16* Vh; attn_body::bf16* Ou; int nt; };
__device__ __forceinline__ AttnWork attn_decode(const P& p, int b, int vh, int row0, int nt) {
    AttnWork w;
    const int kh = vh < GQA_H ? vh / (GQA_H / GQA_KV) : GQA_KV + (vh - GQA_H);
    const int vv = vh < GQA_H ? vh / (GQA_H / GQA_KV) : GQA_KV + (vh - GQA_H) / 2;
    w.Qu = (const attn_body::bf16*)(p.ZQ + (size_t)row0 * QP + vh * 64);
    w.Kh = (const attn_body::bf16*)(p.ZK + (size_t)b * SKEY * KP + kh * 64);
    w.Vh = (const attn_body::bf16*)(p.ZV + (size_t)b * SKEY * VP + vv * 64);
    if (vh < GQA_H) { w.Ou = (attn_body::bf16*)(p.Y + (size_t)row0 * MIX_W + LRU_W + vh * 64); }
    else { w.Ou = (attn_body::bf16*)(p.OD + (size_t)row0 * ODP + (vh - GQA_H) * 64); }
    w.nt = nt; return w;
}
__device__ __forceinline__ void diffcomb_wave(const P& p, int l, float lam, int row_first, int h, int lane) {
    asm volatile("s_waitcnt vmcnt(0)" ::: "memory");
    const float lam_init = 0.8f - 0.6f * expf(-0.3f * (float)l);
    const int rs = lane >> 5, dp = lane & 31;
    unsigned u1[16], u2[16];
#pragma unroll
    for (int it = 0; it < 16; ++it) { const size_t r = (size_t)(row_first + 2 * it + rs);
        u1[it] = __hip_atomic_load((const unsigned*)(p.OD + r * ODP + (2 * h) * 64 + 2 * dp), __ATOMIC_RELAXED, __HIP_MEMORY_SCOPE_AGENT);
        u2[it] = __hip_atomic_load((const unsigned*)(p.OD + r * ODP + (2 * h + 1) * 64 + 2 * dp), __ATOMIC_RELAXED, __HIP_MEMORY_SCOPE_AGENT); }
    const float g0 = p.diff_subln_g[l * 64 + 2 * dp] * (1.f - lam_init), g1 = p.diff_subln_g[l * 64 + 2 * dp + 1] * (1.f - lam_init);
#pragma unroll
    for (int it = 0; it < 16; ++it) { const size_t r = (size_t)(row_first + 2 * it + rs);
        const float a0 = __uint_as_float(u1[it] << 16) - lam * __uint_as_float(u2[it] << 16), a1 = __uint_as_float(u1[it] & 0xffff0000u) - lam * __uint_as_float(u2[it] & 0xffff0000u);
        const float ss = half32_sum(a0 * a0 + a1 * a1);
        const float rsq = __builtin_amdgcn_rsqf(ss * (1.f / 64.f) + 1e-6f);
        *(unsigned*)(p.Y + r * MIX_W + LRU_W + GQA_H * 64 + h * 64 + 2 * dp) = pk2bf(a0 * rsq * g0, a1 * rsq * g1); }
}
__device__ __forceinline__ void attn_one(const P& p, int l, float lam, char* lds, int b, int vh, int row0, int nt, int wid, int lane, const attn_body::bf16* knext = nullptr, const bool kpre = false) {
    const AttnWork w = attn_decode(p, b, vh, row0, nt);
    if (vh < GQA_H) attn_body::attn_unit<8, QP, KP, VP, MIX_W, false, true>(w.Qu, w.Kh, w.Vh, w.Ou, w.nt, lds, knext, kpre);
    else {
        const int* nb = (const int*)p.ctl + CTL_NB_WORD + 64 * l + b * 16 + (vh - GQA_H);
        const int nbq = nb[0], nbk = nb[8]; __builtin_amdgcn_sched_barrier(0);
        const float q2 = __int_as_float(__builtin_amdgcn_readfirstlane(nbq)), k2 = __int_as_float(__builtin_amdgcn_readfirstlane(nbk));
        if (sqrtf(q2 * k2) * 1.05f < 64.f) attn_body::attn_unit<8, QP, KP, VP, MIX_W, true, true>(w.Qu, w.Kh, w.Vh, w.Ou, w.nt, lds, knext, kpre);
        else attn_body::attn_unit<8, QP, KP, VP, MIX_W, true, false>(w.Qu, w.Kh, w.Vh, w.Ou, w.nt, lds, knext, kpre);
        if ((vh - GQA_H) & 1) diffcomb_wave(p, l, lam, row0 + wid * 32, (vh - GQA_H) >> 1, lane); }
}
__device__ __forceinline__ void attn_phase_all(const P& p, int l, char* lds, int vcu, int G, int tid, const bool need_ctx) {
    constexpr int NQB = SEQ / 256, NLU = BATCH * NVH * NQB;
    static_assert(NLU % 256 == 0 && NVH == 16 && CTX_LEN == 256, "unit deal");
    const int wid = __builtin_amdgcn_readfirstlane(tid >> 6), lane = tid & 63;
    const float lam = diff_lam(p, l);
    bool kpre = false;
    for (int u = vcu; u < NLU; u += G) { const int i = u / 256, v = u % 256, x = v / 32, j = v % 32; const int b = x / 4, g = x % 4; const int vh = (i == 0) ? 2 * g : (i == 1) ? GQA_H + 2 * g : (i == 2) ? GQA_H + 2 * g + 1 : 2 * g + 1;
        const attn_body::bf16* knext = nullptr;
        if (u + G < NLU) { const int u2 = u + G, i2 = u2 / 256, v2 = u2 % 256, x2 = v2 / 32; const int b2 = x2 / 4, g2 = x2 % 4; const int vh2 = (i2 == 0) ? 2 * g2 : (i2 == 1) ? GQA_H + 2 * g2 : (i2 == 2) ? GQA_H + 2 * g2 + 1 : 2 * g2 + 1;
            knext = attn_decode(p, b2, vh2, b2 * SEQ, SKEY / 64).Kh; }
        attn_one(p, l, lam, lds, b, vh, b * SEQ + j * 256, SKEY / 64, wid, lane, knext, kpre); kpre = knext != nullptr; }
    if (need_ctx) for (int k = 0; k < BATCH * NVH / 2; ++k) if ((k * 16 + 8) % G == vcu) {
#pragma unroll 1
        for (int c = 2 * k; c < 2 * k + 2; ++c) { const int b = c / NVH, vh = c % NVH; attn_one(p, l, lam, lds, b, vh, NLAT + b * CTX_LEN, CTX_LEN / 64, wid, lane); } }
}

__global__ void __launch_bounds__(NTHR, 2) k_mega(P p) {
    extern __shared__ __attribute__((aligned(16))) unsigned char lds[];
    if (threadIdx.x < 4) ((volatile LAS unsigned*)(lds + LDS_MISC))[threadIdx.x] = 0u;
    __syncthreads();
    XcdBarrier bar = xcd_barrier_post(p.ctl, (volatile LAS unsigned*)(lds + LDS_MISC));
    const int G = gridDim.x; const int vcu = (G % 8 == 0) ? ((int)blockIdx.x % 8) * (G / 8) + (int)blockIdx.x / 8 : (int)blockIdx.x;
    const int wave_ = __builtin_amdgcn_readfirstlane((int)threadIdx.x >> 6);
    { PHASE_P(); ph_ada(q, lds, vcu, G, wave_, tid_ & 63); }
    GRID_SYNC();
    { PHASE_P(); ph_mod0(q, vcu * 8 + wave_, G * 8, tid_ & 63); }
    for (int l = 0; l < DEPTH; ++l) {
        const bool need_ctx = l + 1 < DEPTH; const int nrow = need_ctx ? NROW : NLAT;
        { PHASE_P(); ph_cvt(q, l, lds, vcu, G, tid_); }
        GRID_SYNC();
        {
            pg8::DenseOrder S; S.init(p.H, WB_WIN(p.WB[l & 1]), NROW, IN_W, D_MODEL, G, (int)blockIdx.x);
            pg8::EpiInProj E{p.AX, p.GA, p.ZQ, p.ZK, p.ZV, p.q_norm_g + l * 64, p.k_norm_g + l * 64, (int*)p.ctl + CTL_NB_WORD + 64 * l};
            pg8::gemm_phase<pg8::EpiInProj, pg8::DenseOrder, true, true>((LAS unsigned char*)lds, D_MODEL, S, E); }
        GRID_SYNC();
        { PHASE_P(); ph_lru1(q, l, q.HS, lds, vcu, G, tid_); }
        GRID_SYNC();
        { PHASE_P(); ph_lru2(q, q.HS, lds, vcu, G, tid_, need_ctx ? LRU_UNITS : BATCH * NLCH); __syncthreads(); }
        { PHASE_P(); attn_phase_all(q, l, (char*)lds, vcu, G, tid_, need_ctx); }
        GRID_SYNC();
        {
            pg8::DenseOrder S; S.init(p.Y, WB_WOUT(p.WB[l & 1]), nrow, D_MODEL, MIX_W, G, (int)blockIdx.x);
            pg8::EpiBf16Plain E{(bf16_t*)p.YO, D_MODEL};
            pg8::gemm_phase<pg8::EpiBf16Plain, pg8::DenseOrder, true, true>((LAS unsigned char*)lds, MIX_W, S, E); }
        GRID_SYNC();
        { PHASE_P(); ph_lnroute(q, l, lds, vcu * 8 + wave_, G * 8, tid_, tid_ & 63, nrow); }
        GRID_SYNC();
        {
            pg8::MoeOrder S; S.init(p.H, WB_WGU(p.WB[l & 1]), p.cnt + CNT_IDX(l, 0), p.SLOTTOK, 2 * EXP_FF, D_MODEL, true, G, (int)blockIdx.x);
            pg8::EpiSwiGLU E{p.HM};
            pg8::gemm_phase<pg8::EpiSwiGLU, pg8::MoeOrder, true, true>((LAS unsigned char*)lds, D_MODEL, S, E); }
        GRID_SYNC();
        {
            pg8::MoeOrder S; S.init(p.HM, WB_WD(p.WB[l & 1]), p.cnt + CNT_IDX(l, 0), p.SLOTTOK, D_MODEL, EXP_FF, false, G, (int)blockIdx.x);
            pg8::moe_down_epi_fill(S, p.TG, p.SLOTTOK, (LAS int*)(lds + LDS_EPI)); __syncthreads();
            pg8::EpiMoeDown E{p.FO, (const LAS int*)(lds + LDS_EPI)};
            pg8::gemm_phase<pg8::EpiMoeDown, pg8::MoeOrder, true, true>((LAS unsigned char*)lds, EXP_FF, S, E); }
        GRID_SYNC();
        { PHASE_P(); ph_lnfinal(q, l, vcu * 8 + wave_, G * 8, tid_ & 63, nrow); }
    }
}
extern "C" void kernel_launch(void* const* d_in, const int* in_sizes, int n_in, void* d_out, int out_size, void* d_ws, size_t ws_size, hipStream_t stream) {
    (void)in_sizes; (void)n_in; (void)out_size;
    WsMap m = ws_map();
    if (ws_size < m.total) { fprintf(stderr, "ws too small: %zu < %zu\n", ws_size, m.total); return; }
    static int grid = 0;
    if (!grid) { int dev = 0, cus = 0; (void)hipGetDevice(&dev); (void)hipDeviceGetAttribute(&cus, hipDeviceAttributeMultiprocessorCount, dev);
        if (hipFuncSetAttribute((const void*)k_mega, hipFuncAttributeMaxDynamicSharedMemorySize, LDS_BYTES) != hipSuccess) { fprintf(stderr, "hipFuncSetAttribute failed\n"); grid = -1; return; }
        int per_cu = 0; (void)hipOccupancyMaxActiveBlocksPerMultiprocessor(&per_cu, (const void*)k_mega, NTHR, LDS_BYTES); (void)hipGetLastError();
        if (per_cu < 1) fprintf(stderr, "note: occupancy query says %d\n", per_cu);
        grid = cus; }
    if (grid < 0) return;
    P p; memset(&p, 0, sizeof(p)); fill_inputs(p, d_in, d_out); fill_ws(p, (unsigned char*)d_ws);
    (void)hipMemsetAsync(p.ctl, 0, 1 << 17, stream);
    k_mega<<<dim3(grid), dim3(NTHR), LDS_BYTES, stream>>>(p);
}
```
